# Optimizing an MI355X kernel written in HIP

```python
import math
import jax, jax.numpy as jnp
from jax import lax
import numpy as np

D_MODEL = 1024
BATCH = 8
SEQ = 2048
DEPTH = 2

ATTN_PATTERNS = ((128, 1), (512, 4), (2048, 16))
N_ATTN_GROUPS = len(ATTN_PATTERNS)
ATTN_HEADS = 8
ATTN_HEAD_DIM = 64
ATTN_WIDTH = ATTN_HEADS * ATTN_HEAD_DIM
RET_HEADS = 4
RET_HEAD_DIM = D_MODEL // RET_HEADS
RET_WIDTH = RET_HEADS * RET_HEAD_DIM
RET_CHUNK = 128
N_EXPERTS = 16
EXPERT_FF = 2 * D_MODEL
CAPACITY_FACTOR = 2
EPS = 1e-6
ATTN_IN = N_ATTN_GROUPS * 3 * ATTN_WIDTH
RET_IN = 4 * RET_WIDTH
GATE_IN = 2 * D_MODEL
N_IN = ATTN_IN + RET_IN + GATE_IN
SPLITS = (ATTN_IN,
          ATTN_IN + RET_WIDTH,
          ATTN_IN + 2 * RET_WIDTH,
          ATTN_IN + 3 * RET_WIDTH,
          ATTN_IN + 4 * RET_WIDTH)

kernel_name = "hybrid_dilated_attn_retention_ec_moe"


def rms_norm(x, gain):
    xf = x.astype(jnp.float32)
    y = xf * lax.rsqrt(jnp.mean(xf * xf, axis=-1, keepdims=True) + EPS)
    return (y * gain.astype(jnp.float32)).astype(x.dtype)


def alibi_slopes(n):
    return 2.0 ** (-8.0 * (jnp.arange(n, dtype=jnp.float32) + 1.0) / n)


def dilated_band_attention(q, k, v, dilation, half, slopes):
    B, S, H, Dh = q.shape
    L = S // dilation
    nb = -(-L // half)
    Lp = nb * half

    def to_residue(t):
        return t.reshape(B, L, dilation, H, Dh).transpose(0, 3, 2, 1, 4)

    qr = jnp.pad(to_residue(q), ((0, 0), (0, 0), (0, 0), (0, Lp - L), (0, 0)))
    qr = qr.reshape(B, H, dilation, nb, half, Dh)

    def windows(t):
        t = jnp.pad(to_residue(t), ((0, 0), (0, 0), (0, 0), (half, Lp - L + half), (0, 0)))
        t = t.reshape(B, H, dilation, nb + 2, half, Dh)
        return jnp.concatenate([t[:, :, :, :-2], t[:, :, :, 1:-1], t[:, :, :, 2:]], axis=4)

    kw, vw = windows(k), windows(v)
    qi = jnp.arange(half)
    ki = jnp.arange(3 * half)
    rel = ki[None, :] - half - qi[:, None]
    kpos = jnp.arange(nb)[:, None] * half - half + ki[None, :]
    valid = (jnp.abs(rel) <= half)[None] & ((kpos >= 0) & (kpos < L))[:, None, :]
    dist = (dilation * jnp.abs(rel)).astype(jnp.float32)

    s = jnp.einsum('bhrnqd,bhrnkd->bhrnqk', qr, kw).astype(jnp.float32) * (Dh ** -0.5)
    s = s - slopes[None, :, None, None, None, None] * dist
    s = jnp.where(valid, s, -jnp.inf)
    m = jnp.max(s, axis=-1, keepdims=True)
    p = jnp.exp(s - m)
    den = jnp.sum(p, axis=-1)
    o = jnp.einsum('bhrnqk,bhrnkd->bhrnqd', p, vw.astype(jnp.float32)) / den[..., None]
    lse = m[..., 0] + jnp.log(den)

    o = o.reshape(B, H, dilation, Lp, Dh)[:, :, :, :L]
    o = o.transpose(0, 3, 2, 1, 4).reshape(B, S, H, Dh)
    lse = lse.reshape(B, H, dilation, Lp)[:, :, :, :L]
    lse = lse.transpose(0, 3, 2, 1).reshape(B, S, H)
    return o, lse


def retention_chunkwise(q, k, v, log_gamma, strict):
    B, H, S, Dk = q.shape
    Dv = v.shape[-1]
    N = S // RET_CHUNK
    qc = q.reshape(B, H, N, RET_CHUNK, Dk).astype(jnp.float32) * (Dk ** -0.5)
    kc = k.reshape(B, H, N, RET_CHUNK, Dk).astype(jnp.float32)
    vc = v.reshape(B, H, N, RET_CHUNK, Dv).astype(jnp.float32)
    pos = jnp.arange(RET_CHUNK, dtype=jnp.float32)
    rel = pos[:, None] - pos[None, :]
    mask = (rel > 0) if strict else (rel >= 0)
    lg = log_gamma[:, None, None]
    decay = jnp.where(mask, jnp.exp(lg * jnp.where(mask, rel, 0.0)), 0.0)
    scores = jnp.einsum('bhnqd,bhnkd->bhnqk', qc, kc) * decay[None, :, None]
    y = jnp.einsum('bhnqk,bhnkv->bhnqv', scores, vc)
    zeta = jnp.exp(log_gamma[:, None] * (RET_CHUNK - 1 - pos)[None, :])
    u = jnp.einsum('bhnkd,bhnkv->bhndv', kc * zeta[None, :, None, :, None], vc)
    chunk_decay = jnp.exp(log_gamma * RET_CHUNK)[None, :, None, None]

    def step(state, u_i):
        return state * chunk_decay + u_i, state

    _, s_prev = lax.scan(step, jnp.zeros((B, H, Dk, Dv), jnp.float32), jnp.moveaxis(u, 2, 0))
    s_prev = jnp.moveaxis(s_prev, 0, 2)
    xi = jnp.exp(log_gamma[:, None] * (pos + 1.0)[None, :])
    y = y + jnp.einsum('bhnqd,bhndv->bhnqv', qc, s_prev) * xi[None, :, None, :, None]
    return y.reshape(B, H, S, Dv)


def expert_choice_ffn(h, w_router, w_gate, w_up, w_down):
    B, S, D = h.shape
    cap = CAPACITY_FACTOR * S // N_EXPERTS
    logits = jnp.einsum('bsd,de->bse', h, w_router).astype(jnp.float32)
    aff = jax.nn.softmax(logits, axis=-1)
    g, idx = lax.top_k(jnp.swapaxes(aff, 1, 2), cap)
    xin = jax.vmap(lambda hb, ib: hb[ib])(h, idx)
    a = jnp.einsum('becd,edf->becf', xin, w_gate)
    b = jnp.einsum('becd,edf->becf', xin, w_up)
    y = jnp.einsum('becf,efd->becd', jax.nn.silu(a) * b, w_down)
    y = y * g[..., None].astype(y.dtype)
    return jax.vmap(lambda yb, ib: jnp.zeros((S, D), yb.dtype).at[ib.reshape(-1)].add(yb.reshape(-1, D)))(y, idx)


def setup_inputs(seed: int = 0) -> dict:
    key = jax.random.key(seed)
    ks = jax.random.split(key, 16)
    f32 = jnp.float32
    D = D_MODEL
    x = jax.random.normal(ks[0], (BATCH, SEQ, D), f32)
    w_in = jax.random.normal(ks[1], (DEPTH, D, N_IN), f32) * D ** -0.5
    w_attn_out = jax.random.normal(ks[2], (DEPTH, ATTN_WIDTH, D), f32) * ATTN_WIDTH ** -0.5
    w_ret_out = jax.random.normal(ks[3], (DEPTH, RET_WIDTH, D), f32) * RET_WIDTH ** -0.5
    w_out = jax.random.normal(ks[4], (DEPTH, D, D), f32) * D ** -0.5
    base = jnp.log(2.0 ** (5.0 + jnp.arange(RET_HEADS, dtype=f32)) - 1.0)
    ret_decay_logit = base[None, None, :] + 0.1 * jax.random.normal(ks[5], (DEPTH, 2, RET_HEADS), f32)
    norm_mix = 1.0 + 0.05 * jax.random.normal(ks[6], (DEPTH, D), f32)
    norm_ffn = 1.0 + 0.05 * jax.random.normal(ks[7], (DEPTH, D), f32)
    w_router = jax.random.normal(ks[8], (DEPTH, D, N_EXPERTS), f32) * D ** -0.5
    w_gate = jax.random.normal(ks[9], (DEPTH, N_EXPERTS, D, EXPERT_FF), f32) * D ** -0.5
    w_up = jax.random.normal(ks[10], (DEPTH, N_EXPERTS, D, EXPERT_FF), f32) * D ** -0.5
    w_down = jax.random.normal(ks[11], (DEPTH, N_EXPERTS, EXPERT_FF, D), f32) * EXPERT_FF ** -0.5
    norm_final = 1.0 + 0.05 * jax.random.normal(ks[12], (D,), f32)
    return {"x": x, "w_in": w_in, "w_attn_out": w_attn_out, "w_ret_out": w_ret_out,
            "w_out": w_out, "ret_decay_logit": ret_decay_logit, "norm_mix": norm_mix,
            "norm_ffn": norm_ffn, "w_router": w_router, "w_gate": w_gate, "w_up": w_up,
            "w_down": w_down, "norm_final": norm_final}


def reference(x, w_in, w_attn_out, w_ret_out, w_out, ret_decay_logit, norm_mix, norm_ffn,
              w_router, w_gate, w_up, w_down, norm_final):
    B, S, D = x.shape
    slopes = alibi_slopes(ATTN_HEADS)
    for layer in range(DEPTH):
        h = rms_norm(x, norm_mix[layer])
        proj = jnp.einsum('bsd,dn->bsn', h, w_in[layer])
        a_qkv, r_q, r_k, r_v, r_g, gates = jnp.split(proj, SPLITS, axis=-1)

        a_qkv = a_qkv.reshape(B, S, N_ATTN_GROUPS, 3, ATTN_HEADS, ATTN_HEAD_DIM)
        outs, lses = [], []
        for gi, (window, dilation) in enumerate(ATTN_PATTERNS):
            half = window // (2 * dilation)
            o, lse = dilated_band_attention(a_qkv[:, :, gi, 0], a_qkv[:, :, gi, 1], a_qkv[:, :, gi, 2],
                                            dilation, half, slopes)
            outs.append(o)
            lses.append(lse)
        alpha = jax.nn.softmax(jnp.stack(lses, axis=0), axis=0)
        attn = sum(alpha[gi][..., None] * outs[gi] for gi in range(N_ATTN_GROUPS))
        attn = attn.reshape(B, S, ATTN_WIDTH).astype(x.dtype)

        def heads(t):
            return t.reshape(B, S, RET_HEADS, RET_HEAD_DIM).transpose(0, 2, 1, 3)
        q, k, v = heads(r_q), heads(r_k), heads(r_v)
        log_gamma = jax.nn.log_sigmoid(ret_decay_logit[layer].astype(jnp.float32))
        fwd = retention_chunkwise(q, k, v, log_gamma[0], strict=False)
        bwd = jnp.flip(retention_chunkwise(jnp.flip(q, 2), jnp.flip(k, 2), jnp.flip(v, 2),
                                           log_gamma[1], strict=True), 2)
        r = fwd + bwd
        r = r * lax.rsqrt(jnp.mean(r * r, axis=-1, keepdims=True) + EPS)
        r = r.transpose(0, 2, 1, 3).reshape(B, S, RET_WIDTH)
        ret = (jax.nn.silu(r_g.astype(jnp.float32)) * r).astype(x.dtype)

        g_a, g_r = jnp.split(gates, 2, axis=-1)
        merged = (jax.nn.sigmoid(g_a) * jnp.einsum('bsw,wd->bsd', attn, w_attn_out[layer])
                  + jax.nn.sigmoid(g_r) * jnp.einsum('bsw,wd->bsd', ret, w_ret_out[layer]))
        x = x + jnp.einsum('bsd,de->bse', merged, w_out[layer])

        h2 = rms_norm(x, norm_ffn[layer])
        x = x + expert_choice_ffn(h2, w_router[layer], w_gate[layer], w_up[layer], w_down[layer])
    return rms_norm(x, norm_final)
```

```cpp
#include <hip/hip_runtime.h>
#include <cstdio>
#include <cstdint>

typedef unsigned short bf16;
typedef short bf16x8 __attribute__((ext_vector_type(8)));
typedef float f32x4 __attribute__((ext_vector_type(4)));
typedef unsigned u32x4 __attribute__((ext_vector_type(4)));
typedef unsigned u32x2 __attribute__((ext_vector_type(2)));

constexpr int NB = 8, SEQ = 2048, DM = 1024, T = NB * SEQ, DEPTH = 2;
constexpr int NIN = 10752, ATTN_IN = 4608, AW = 512, RW = 1024;
constexpr int OFF_RQ = 4608, OFF_RK = 5632, OFF_RV = 6656, OFF_RG = 7680, OFF_GA = 8704, OFF_GR = 9728;
constexpr int NE = 16, FF = 2048, CAP = 256, NROWS_E = NB * NE * CAP;
constexpr float EPS = 1e-6f;

constexpr size_t MiB = 1u << 20;
constexpr size_t WS_CTL = 0;
constexpr size_t WS_WIN = 1 * MiB;
constexpr size_t WS_WAO = WS_WIN + 42 * MiB;
constexpr size_t WS_WRO = WS_WAO + 2 * MiB;
constexpr size_t WS_WO  = WS_WRO + 4 * MiB;
constexpr size_t WS_WGU = WS_WO + 4 * MiB;
constexpr size_t WS_WDN = WS_WGU + 256 * MiB;
constexpr size_t WS_H   = WS_WDN + 128 * MiB;
constexpr size_t WS_PROJ = WS_H + 32 * MiB;
constexpr size_t WS_XIN = WS_PROJ;
constexpr size_t WS_ACT = WS_PROJ + 64 * MiB;
constexpr size_t WS_Y   = WS_PROJ + 192 * MiB;
constexpr size_t WS_ATTO = WS_PROJ + 336 * MiB;
constexpr size_t WS_LSE = WS_ATTO + 48 * MiB;
constexpr size_t WS_YF  = WS_LSE + 2 * MiB;
constexpr size_t WS_YB  = WS_YF + 64 * MiB;
constexpr size_t WS_RET = WS_YB + 64 * MiB;
constexpr size_t WS_AFF = WS_RET + 32 * MiB;
constexpr size_t WS_IDX = WS_AFF + 1 * MiB;
constexpr size_t WS_GW  = WS_IDX + 256 * 1024;
constexpr size_t WS_SLOT = WS_GW + 256 * 1024;
constexpr size_t WS_END = WS_SLOT + 1 * MiB;
static_assert(WS_END <= 1024 * MiB, "workspace map");

__device__ __forceinline__ unsigned f2bf(float f) { unsigned u = __builtin_bit_cast(unsigned, f); return (u + 0x7fffu + ((u >> 16) & 1u)) >> 16; }
__device__ __forceinline__ float bf2f(unsigned short h) { return __builtin_bit_cast(float, (unsigned)h << 16); }
__device__ __forceinline__ float sigmoidf_(float v) { return 1.f / (1.f + __expf(-v)); }
__device__ __forceinline__ float siluf_(float v) { return v / (1.f + __expf(-v)); }

__global__ void __launch_bounds__(256) k_transpose_cvt(const float* __restrict__ W, int K, int N, bf16* __restrict__ WT, int mode, size_t in_bstride, size_t out_bstride) {
    __shared__ float tile[32][33];
    const float* Wb = W + (size_t)blockIdx.z * in_bstride; bf16* Ob = WT + (size_t)blockIdx.z * out_bstride;
    const int n0 = blockIdx.x * 32, k0 = blockIdx.y * 32, tx = threadIdx.x & 31, ty = threadIdx.x >> 5;
    for (int i = ty; i < 32; i += 8) tile[i][tx] = Wb[(size_t)(k0 + i) * N + n0 + tx];
    __syncthreads();
    for (int i = ty; i < 32; i += 8) { const int n = n0 + i; int np = n; if (mode == 1) np = (n / 16) * 32 + (n % 16); else if (mode == 2) np = (n / 16) * 32 + 16 + (n % 16);
        Ob[(size_t)np * K + k0 + tx] = (bf16)f2bf(tile[tx][i]); }
}

__device__ __forceinline__ float block_sum_256(float v, float* red) {
    for (int o = 32; o > 0; o >>= 1) v += __shfl_xor(v, o);
    __syncthreads();
    if ((threadIdx.x & 63) == 0) red[threadIdx.x >> 6] = v;
    __syncthreads();
    return red[0] + red[1] + red[2] + red[3];
}
__global__ void __launch_bounds__(256) k_rmsnorm_bf16(const float* __restrict__ x, const float* __restrict__ gain, bf16* __restrict__ out) {
    __shared__ float red[4];
    const int t = blockIdx.x, c = threadIdx.x * 4;
    const f32x4 v = *(const f32x4*)(x + (size_t)t * DM + c);
    const float ss = block_sum_256(v.x * v.x + v.y * v.y + v.z * v.z + v.w * v.w, red);
    const float rstd = rsqrtf(ss * (1.f / DM) + EPS);
    const f32x4 g = *(const f32x4*)(gain + c);
    u32x2 o; o.x = f2bf(v.x * rstd * g.x) | (f2bf(v.y * rstd * g.y) << 16); o.y = f2bf(v.z * rstd * g.z) | (f2bf(v.w * rstd * g.w) << 16);
    *(u32x2*)(out + (size_t)t * DM + c) = o;
}

struct GemmArgs {
    const bf16* A; const bf16* Bt; int M, N, K; int lda, ldb; size_t strideA, strideB;
    int mode;
    bf16* Cb; float* Cf; const float* Rf; const bf16* proj; const float* gw; int ldc; size_t strideC; int pad;
};
__global__ void __launch_bounds__(256) k_gemm(GemmArgs g) {
    __shared__ __attribute__((aligned(16))) bf16 sA[64][40];
    __shared__ __attribute__((aligned(16))) bf16 sB[64][40];
    const int tid = threadIdx.x, lane = tid & 63, wid = tid >> 6, wr = wid >> 1, wc = wid & 1, fr = lane & 15, fq = lane >> 4;
    const int m0 = blockIdx.y * 64, n0 = blockIdx.x * 64;
    const bf16* A = g.A + (size_t)blockIdx.z * g.strideA; const bf16* Bt = g.Bt + (size_t)blockIdx.z * g.strideB;
    f32x4 acc[2][2];
#pragma unroll
    for (int i = 0; i < 2; ++i)
#pragma unroll
        for (int j = 0; j < 2; ++j) acc[i][j] = (f32x4){0.f, 0.f, 0.f, 0.f};
    const int lr = tid >> 2, lc = (tid & 3) * 8;
    for (int k0 = 0; k0 < g.K; k0 += 32) {
        const u32x4 va = *(const u32x4*)(A + (size_t)(m0 + lr) * g.lda + k0 + lc);
        const u32x4 vb = *(const u32x4*)(Bt + (size_t)(n0 + lr) * g.ldb + k0 + lc);
        __syncthreads();
        *(u32x4*)&sA[lr][lc] = va; *(u32x4*)&sB[lr][lc] = vb;
        __syncthreads();
        bf16x8 af[2], bfr[2];
        for (int i = 0; i < 2; ++i) af[i] = *(const bf16x8*)&sA[wr * 32 + i * 16 + fr][fq * 8];
        for (int j = 0; j < 2; ++j) bfr[j] = *(const bf16x8*)&sB[wc * 32 + j * 16 + fr][fq * 8];
        for (int i = 0; i < 2; ++i) for (int j = 0; j < 2; ++j) acc[i][j] = __builtin_amdgcn_mfma_f32_16x16x32_bf16(af[i], bfr[j], acc[i][j], 0, 0, 0);
    }
    const size_t cb = (size_t)blockIdx.z * g.strideC;
    for (int i = 0; i < 2; ++i) for (int r = 0; r < 4; ++r) {
        const int m = m0 + wr * 32 + i * 16 + fq * 4 + r;
        if (g.mode == 4) {
            const int f = (n0 + wc * 32) / 2 + fr; const float a = acc[i][0][r], b = acc[i][1][r];
            g.Cb[cb + (size_t)m * g.ldc + f] = (bf16)f2bf(siluf_(a) * b);
        } else for (int j = 0; j < 2; ++j) {
            const int n = n0 + wc * 32 + j * 16 + fr; const float v = acc[i][j][r]; const size_t o = cb + (size_t)m * g.ldc + n;
            if (g.mode == 0) g.Cb[o] = (bf16)f2bf(v);
            else if (g.mode == 1) g.Cf[o] = sigmoidf_(bf2f(g.proj[(size_t)m * NIN + OFF_GA + n])) * v;
            else if (g.mode == 2) g.Cb[o] = (bf16)f2bf(g.Cf[o] + sigmoidf_(bf2f(g.proj[(size_t)m * NIN + OFF_GR + n])) * v);
            else if (g.mode == 3) g.Cf[o] = g.Rf[o] + v;
            else if (g.mode == 5) g.Cb[o] = (bf16)f2bf(v * g.gw[blockIdx.z * 2048 + m]);
        }
    }
}

__global__ void __launch_bounds__(64) k_attn_naive(const bf16* __restrict__ proj, bf16* __restrict__ atto, float* __restrict__ lse) {
    const int gid = blockIdx.x * 64 + threadIdx.x;
    const int h = gid & 7, t = (gid >> 3) % T, g = gid / (8 * T);
    const int d = (g == 0) ? 1 : (g == 1 ? 4 : 16);
    const int b = t / SEQ, s = t % SEQ;
    const float slope = exp2f(-(float)(h + 1));
    const bf16* qp = proj + (size_t)t * NIN + g * 1536 + h * 64;
    float q[64], o[64];
#pragma unroll
    for (int i = 0; i < 64; ++i) { q[i] = bf2f(qp[i]) * 0.125f; o[i] = 0.f; }
    float mx = -INFINITY, den = 0.f;
    for (int j = -64; j <= 64; ++j) {
        const int sk = s + j * d; if (sk < 0 || sk >= SEQ) continue;
        const bf16* kp = proj + (size_t)(b * SEQ + sk) * NIN + g * 1536 + 512 + h * 64; const bf16* vp = kp + 512;
        float sc = 0.f;
#pragma unroll
        for (int i = 0; i < 64; i += 8) { const u32x4 kv = *(const u32x4*)(kp + i);
            sc += q[i] * __builtin_bit_cast(float, kv.x << 16) + q[i + 1] * __builtin_bit_cast(float, kv.x & 0xffff0000u) + q[i + 2] * __builtin_bit_cast(float, kv.y << 16) + q[i + 3] * __builtin_bit_cast(float, kv.y & 0xffff0000u)
                + q[i + 4] * __builtin_bit_cast(float, kv.z << 16) + q[i + 5] * __builtin_bit_cast(float, kv.z & 0xffff0000u) + q[i + 6] * __builtin_bit_cast(float, kv.w << 16) + q[i + 7] * __builtin_bit_cast(float, kv.w & 0xffff0000u); }
        sc -= slope * (float)(d * (j < 0 ? -j : j));
        const float mn = fmaxf(mx, sc), f = __expf(mx - mn), p = __expf(sc - mn);
        den = den * f + p; mx = mn;
#pragma unroll
        for (int i = 0; i < 64; i += 8) { const u32x4 vv = *(const u32x4*)(vp + i);
            o[i] = o[i] * f + p * __builtin_bit_cast(float, vv.x << 16); o[i + 1] = o[i + 1] * f + p * __builtin_bit_cast(float, vv.x & 0xffff0000u);
            o[i + 2] = o[i + 2] * f + p * __builtin_bit_cast(float, vv.y << 16); o[i + 3] = o[i + 3] * f + p * __builtin_bit_cast(float, vv.y & 0xffff0000u);
            o[i + 4] = o[i + 4] * f + p * __builtin_bit_cast(float, vv.z << 16); o[i + 5] = o[i + 5] * f + p * __builtin_bit_cast(float, vv.z & 0xffff0000u);
            o[i + 6] = o[i + 6] * f + p * __builtin_bit_cast(float, vv.w << 16); o[i + 7] = o[i + 7] * f + p * __builtin_bit_cast(float, vv.w & 0xffff0000u); }
    }
    const float inv = 1.f / den;
    bf16* op = atto + ((size_t)g * T + t) * AW + h * 64;
#pragma unroll
    for (int i = 0; i < 64; i += 2) *(unsigned*)(op + i) = f2bf(o[i] * inv) | (f2bf(o[i + 1] * inv) << 16);
    lse[((size_t)g * T + t) * 8 + h] = mx + __logf(den);
}

__global__ void __launch_bounds__(256) k_ret_naive(const bf16* __restrict__ proj, const float* __restrict__ decay_logit  , float* __restrict__ yf, float* __restrict__ yb) {
    __shared__ float qs[16][257];
    __shared__ float ks[32][257];
    __shared__ float sc[16][33];
    const int tid = threadIdx.x, nt = blockIdx.x & 127, h = (blockIdx.x >> 7) & 3, b = blockIdx.x >> 9;
    const int n0 = nt * 16;
    const float lgf = -log1pf(expf(-decay_logit[h])), lgb = -log1pf(expf(-decay_logit[4 + h]));
    for (int i = 0; i < 16; ++i) qs[i][tid] = bf2f(proj[(size_t)(b * SEQ + n0 + i) * NIN + OFF_RQ + h * 256 + tid]) * 0.0625f;
    float acc[16];
#pragma unroll
    for (int i = 0; i < 16; ++i) acc[i] = 0.f;
    for (int m0 = 0; m0 < SEQ; m0 += 32) {
        __syncthreads();
        for (int i = 0; i < 32; ++i) ks[i][tid] = bf2f(proj[(size_t)(b * SEQ + m0 + i) * NIN + OFF_RK + h * 256 + tid]);
        __syncthreads();
        for (int e = tid; e < 512; e += 256) { const int n = e >> 5, m = e & 31; float s = 0.f;
            for (int k = 0; k < 256; ++k) s += qs[n][k] * ks[m][k];
            const int gn = n0 + n, gm = m0 + m; const float dec = (gm <= gn) ? __expf(lgf * (float)(gn - gm)) : __expf(lgb * (float)(gm - gn));
            sc[n][m] = s * dec; }
        __syncthreads();
        for (int m = 0; m < 32; ++m) { const float v = bf2f(proj[(size_t)(b * SEQ + m0 + m) * NIN + OFF_RV + h * 256 + tid]);
#pragma unroll
            for (int n = 0; n < 16; ++n) acc[n] += sc[n][m] * v; }
    }
#pragma unroll
    for (int n = 0; n < 16; ++n) { const size_t o = (size_t)(b * SEQ + n0 + n) * RW + h * 256 + tid; yf[o] = acc[n]; yb[o] = 0.f; }
}

__global__ void __launch_bounds__(256) k_finalize(const bf16* __restrict__ proj, const float* __restrict__ yf, const float* __restrict__ yb, bf16* __restrict__ ret, bf16* __restrict__ atto, const float* __restrict__ lse) {
    const int t = blockIdx.x, tid = threadIdx.x, c = tid * 4;
    const f32x4 a = *(const f32x4*)(yf + (size_t)t * RW + c), bq = *(const f32x4*)(yb + (size_t)t * RW + c);
    const f32x4 r = a + bq;
    float ss = r.x * r.x + r.y * r.y + r.z * r.z + r.w * r.w;
    for (int o = 32; o > 0; o >>= 1) ss += __shfl_xor(ss, o);
    const float rstd = rsqrtf(ss * (1.f / 256.f) + EPS);
    const u32x2 gq = *(const u32x2*)(proj + (size_t)t * NIN + OFF_RG + c);
    const float g0 = __builtin_bit_cast(float, gq.x << 16), g1 = __builtin_bit_cast(float, gq.x & 0xffff0000u), g2 = __builtin_bit_cast(float, gq.y << 16), g3 = __builtin_bit_cast(float, gq.y & 0xffff0000u);
    u32x2 o; o.x = f2bf(siluf_(g0) * r.x * rstd) | (f2bf(siluf_(g1) * r.y * rstd) << 16); o.y = f2bf(siluf_(g2) * r.z * rstd) | (f2bf(siluf_(g3) * r.w * rstd) << 16);
    *(u32x2*)(ret + (size_t)t * RW + c) = o;
    const int hh = tid >> 5;
    const float l0 = lse[((size_t)0 * T + t) * 8 + hh], l1 = lse[((size_t)1 * T + t) * 8 + hh], l2 = lse[((size_t)2 * T + t) * 8 + hh];
    const float mx = fmaxf(l0, fmaxf(l1, l2)); const float w0 = __expf(l0 - mx), w1 = __expf(l1 - mx), w2 = __expf(l2 - mx); const float inv = 1.f / (w0 + w1 + w2);
    const unsigned p0 = *(const unsigned*)(atto + ((size_t)0 * T + t) * AW + 2 * tid), p1 = *(const unsigned*)(atto + ((size_t)1 * T + t) * AW + 2 * tid), p2 = *(const unsigned*)(atto + ((size_t)2 * T + t) * AW + 2 * tid);
    const float lo = (w0 * __builtin_bit_cast(float, p0 << 16) + w1 * __builtin_bit_cast(float, p1 << 16) + w2 * __builtin_bit_cast(float, p2 << 16)) * inv;
    const float hi = (w0 * __builtin_bit_cast(float, p0 & 0xffff0000u) + w1 * __builtin_bit_cast(float, p1 & 0xffff0000u) + w2 * __builtin_bit_cast(float, p2 & 0xffff0000u)) * inv;
    *(unsigned*)(atto + (size_t)t * AW + 2 * tid) = f2bf(lo) | (f2bf(hi) << 16);
}

__global__ void __launch_bounds__(256) k_norm_router(const float* __restrict__ x, const float* __restrict__ gain, const float* __restrict__ wr  , bf16* __restrict__ out, float* __restrict__ aff) {
    __shared__ float red[4];
    __shared__ float part[4][16];
    const int t = blockIdx.x, tid = threadIdx.x, c = tid * 4;
    const f32x4 v = *(const f32x4*)(x + (size_t)t * DM + c);
    const float ss = block_sum_256(v.x * v.x + v.y * v.y + v.z * v.z + v.w * v.w, red);
    const float rstd = rsqrtf(ss * (1.f / DM) + EPS);
    const f32x4 g = *(const f32x4*)(gain + c);
    const float h0 = v.x * rstd * g.x, h1 = v.y * rstd * g.y, h2 = v.z * rstd * g.z, h3 = v.w * rstd * g.w;
    u32x2 o; o.x = f2bf(h0) | (f2bf(h1) << 16); o.y = f2bf(h2) | (f2bf(h3) << 16);
    *(u32x2*)(out + (size_t)t * DM + c) = o;
    float lg[16];
#pragma unroll
    for (int e = 0; e < 16; ++e) lg[e] = h0 * wr[(c + 0) * 16 + e] + h1 * wr[(c + 1) * 16 + e] + h2 * wr[(c + 2) * 16 + e] + h3 * wr[(c + 3) * 16 + e];
#pragma unroll
    for (int e = 0; e < 16; ++e) { float s = lg[e]; for (int of = 32; of > 0; of >>= 1) s += __shfl_xor(s, of); lg[e] = s; }
    if ((tid & 63) == 0) {
#pragma unroll
        for (int e = 0; e < 16; ++e) part[tid >> 6][e] = lg[e]; }
    __syncthreads();
    if (tid < 16) { const float l = part[0][tid] + part[1][tid] + part[2][tid] + part[3][tid];
        float mx = l; for (int of = 8; of > 0; of >>= 1) mx = fmaxf(mx, __shfl_xor(mx, of));
        const float p = __expf(l - mx); float s = p; for (int of = 8; of > 0; of >>= 1) s += __shfl_xor(s, of);
        aff[(size_t)t * 16 + tid] = p / s; }
}

__global__ void __launch_bounds__(256) k_topk(const float* __restrict__ aff, int* __restrict__ idx, float* __restrict__ gw, int* __restrict__ slot) {
    __shared__ float a[SEQ];
    const int b = blockIdx.x >> 4, e = blockIdx.x & 15, tid = threadIdx.x;
    for (int s = tid; s < SEQ; s += 256) a[s] = aff[(size_t)(b * SEQ + s) * 16 + e];
    __syncthreads();
    for (int s = tid; s < SEQ; s += 256) { const float v = a[s]; int rank = 0;
        for (int j = 0; j < SEQ; ++j) { const float w = a[j]; rank += (w > v || (w == v && j < s)) ? 1 : 0; }
        if (rank < CAP) { const int row = (e * NB + b) * CAP + rank; idx[row] = b * SEQ + s; gw[row] = v; slot[(b * NE + e) * SEQ + s] = rank; }
        else slot[(b * NE + e) * SEQ + s] = -1; }
}
__global__ void __launch_bounds__(128) k_gather(const bf16* __restrict__ H, const int* __restrict__ idx, bf16* __restrict__ xin) {
    const int row = blockIdx.x; const int t = idx[row];
    *(u32x4*)(xin + (size_t)row * DM + threadIdx.x * 8) = *(const u32x4*)(H + (size_t)t * DM + threadIdx.x * 8);
}
__global__ void __launch_bounds__(256) k_moe_combine_norm(float* __restrict__ x, const bf16* __restrict__ Y, const int* __restrict__ slot, const float* __restrict__ gain, bf16* __restrict__ Hout, int mode) {
    __shared__ float red[4];
    const int t = blockIdx.x, tid = threadIdx.x, c = tid * 4, b = t / SEQ, s = t % SEQ;
    f32x4 v = *(const f32x4*)(x + (size_t)t * DM + c);
    for (int e = 0; e < NE; ++e) { const int sl = slot[(b * NE + e) * SEQ + s];
        if (sl >= 0) { const u32x2 y = *(const u32x2*)(Y + ((size_t)(e * NB + b) * CAP + sl) * DM + c);
            v.x += __builtin_bit_cast(float, y.x << 16); v.y += __builtin_bit_cast(float, y.x & 0xffff0000u); v.z += __builtin_bit_cast(float, y.y << 16); v.w += __builtin_bit_cast(float, y.y & 0xffff0000u); } }
    const float ss = block_sum_256(v.x * v.x + v.y * v.y + v.z * v.z + v.w * v.w, red);
    const float rstd = rsqrtf(ss * (1.f / DM) + EPS);
    const f32x4 g = *(const f32x4*)(gain + c);
    if (mode == 0) { *(f32x4*)(x + (size_t)t * DM + c) = v;
        u32x2 o; o.x = f2bf(v.x * rstd * g.x) | (f2bf(v.y * rstd * g.y) << 16); o.y = f2bf(v.z * rstd * g.z) | (f2bf(v.w * rstd * g.w) << 16);
        *(u32x2*)(Hout + (size_t)t * DM + c) = o; }
    else { f32x4 o; o.x = v.x * rstd * g.x; o.y = v.y * rstd * g.y; o.z = v.z * rstd * g.z; o.w = v.w * rstd * g.w; *(f32x4*)(x + (size_t)t * DM + c) = o; }
}

static void launch_gemm(hipStream_t st, const bf16* A, int lda, size_t sA, const bf16* Bt, int ldb, size_t sB, int M, int N, int K, int nbatch, int mode,
                        bf16* Cb, float* Cf, const float* Rf, const bf16* proj, const float* gw, int ldc, size_t sC) {
    GemmArgs g{}; g.A = A; g.Bt = Bt; g.M = M; g.N = N; g.K = K; g.lda = lda; g.ldb = ldb; g.strideA = sA; g.strideB = sB; g.mode = mode;
    g.Cb = Cb; g.Cf = Cf; g.Rf = Rf; g.proj = proj; g.gw = gw; g.ldc = ldc; g.strideC = sC; g.pad = 0;
    hipLaunchKernelGGL(k_gemm, dim3(N / 64, M / 64, nbatch), dim3(256), 0, st, g);
}

extern "C" void kernel_launch(void* const* d_in, const int* in_sizes, int n_in, void* d_out, int out_size, void* d_ws, size_t ws_size, hipStream_t stream) {
    if (n_in != 13 || in_sizes[0] != T * DM || out_size != T * DM || ws_size < WS_END) { fprintf(stderr, "kernel_launch: unexpected shapes (n_in %d, ws %zu)\n", n_in, ws_size); return; }
    const float* x_in = (const float*)d_in[0]; const float* w_in = (const float*)d_in[1]; const float* w_ao = (const float*)d_in[2]; const float* w_ro = (const float*)d_in[3];
    const float* w_o = (const float*)d_in[4]; const float* dlog = (const float*)d_in[5]; const float* nmix = (const float*)d_in[6]; const float* nffn = (const float*)d_in[7];
    const float* w_rt = (const float*)d_in[8]; const float* w_g = (const float*)d_in[9]; const float* w_u = (const float*)d_in[10]; const float* w_d = (const float*)d_in[11]; const float* nfin = (const float*)d_in[12];
    unsigned char* ws = (unsigned char*)d_ws; float* xres = (float*)d_out;
    bf16* WIN = (bf16*)(ws + WS_WIN); bf16* WAO = (bf16*)(ws + WS_WAO); bf16* WRO = (bf16*)(ws + WS_WRO); bf16* WO = (bf16*)(ws + WS_WO); bf16* WGU = (bf16*)(ws + WS_WGU); bf16* WDN = (bf16*)(ws + WS_WDN);
    bf16* H = (bf16*)(ws + WS_H); bf16* PROJ = (bf16*)(ws + WS_PROJ); bf16* XIN = (bf16*)(ws + WS_XIN); bf16* ACT = (bf16*)(ws + WS_ACT); bf16* Y = (bf16*)(ws + WS_Y);
    bf16* ATTO = (bf16*)(ws + WS_ATTO); float* LSE = (float*)(ws + WS_LSE); float* YF = (float*)(ws + WS_YF); float* YB = (float*)(ws + WS_YB); bf16* RET = (bf16*)(ws + WS_RET);
    float* TMP = YF; bf16* MERGED = (bf16*)YB;
    float* AFF = (float*)(ws + WS_AFF); int* IDX = (int*)(ws + WS_IDX); float* GW = (float*)(ws + WS_GW); int* SLOT = (int*)(ws + WS_SLOT);
    hipLaunchKernelGGL(k_transpose_cvt, dim3(NIN / 32, DM / 32, DEPTH), dim3(256), 0, stream, w_in, DM, NIN, WIN, 0, (size_t)DM * NIN, (size_t)DM * NIN);
    hipLaunchKernelGGL(k_transpose_cvt, dim3(DM / 32, AW / 32, DEPTH), dim3(256), 0, stream, w_ao, AW, DM, WAO, 0, (size_t)AW * DM, (size_t)AW * DM);
    hipLaunchKernelGGL(k_transpose_cvt, dim3(DM / 32, RW / 32, DEPTH), dim3(256), 0, stream, w_ro, RW, DM, WRO, 0, (size_t)RW * DM, (size_t)RW * DM);
    hipLaunchKernelGGL(k_transpose_cvt, dim3(DM / 32, DM / 32, DEPTH), dim3(256), 0, stream, w_o, DM, DM, WO, 0, (size_t)DM * DM, (size_t)DM * DM);
    hipLaunchKernelGGL(k_transpose_cvt, dim3(FF / 32, DM / 32, DEPTH * NE), dim3(256), 0, stream, w_g, DM, FF, WGU, 1, (size_t)DM * FF, (size_t)2 * FF * DM);
    hipLaunchKernelGGL(k_transpose_cvt, dim3(FF / 32, DM / 32, DEPTH * NE), dim3(256), 0, stream, w_u, DM, FF, WGU, 2, (size_t)DM * FF, (size_t)2 * FF * DM);
    hipLaunchKernelGGL(k_transpose_cvt, dim3(DM / 32, FF / 32, DEPTH * NE), dim3(256), 0, stream, w_d, FF, DM, WDN, 0, (size_t)FF * DM, (size_t)FF * DM);
    hipLaunchKernelGGL(k_rmsnorm_bf16, dim3(T), dim3(256), 0, stream, x_in, nmix, H);
    for (int l = 0; l < DEPTH; ++l) {
        const float* xsrc = (l == 0) ? x_in : xres;
        launch_gemm(stream, H, DM, 0, WIN + (size_t)l * NIN * DM, DM, 0, T, NIN, DM, 1, 0, PROJ, nullptr, nullptr, nullptr, nullptr, NIN, 0);
        hipLaunchKernelGGL(k_attn_naive, dim3(3 * T * 8 / 64), dim3(64), 0, stream, PROJ, ATTO, LSE);
        hipLaunchKernelGGL(k_ret_naive, dim3(NB * 4 * 128), dim3(256), 0, stream, PROJ, dlog + l * 8, YF, YB);
        hipLaunchKernelGGL(k_finalize, dim3(T), dim3(256), 0, stream, PROJ, YF, YB, RET, ATTO, LSE);
        launch_gemm(stream, ATTO, AW, 0, WAO + (size_t)l * DM * AW, AW, 0, T, DM, AW, 1, 1, nullptr, TMP, nullptr, PROJ, nullptr, DM, 0);
        launch_gemm(stream, RET, RW, 0, WRO + (size_t)l * DM * RW, RW, 0, T, DM, RW, 1, 2, MERGED, TMP, nullptr, PROJ, nullptr, DM, 0);
        launch_gemm(stream, MERGED, DM, 0, WO + (size_t)l * DM * DM, DM, 0, T, DM, DM, 1, 3, nullptr, xres, xsrc, nullptr, nullptr, DM, 0);
        hipLaunchKernelGGL(k_norm_router, dim3(T), dim3(256), 0, stream, xres, nffn + l * DM, w_rt + (size_t)l * DM * NE, H, AFF);
        hipLaunchKernelGGL(k_topk, dim3(NB * NE), dim3(256), 0, stream, AFF, IDX, GW, SLOT);
        hipLaunchKernelGGL(k_gather, dim3(NROWS_E), dim3(128), 0, stream, H, IDX, XIN);
        launch_gemm(stream, XIN, DM, (size_t)2048 * DM, WGU + (size_t)l * NE * 2 * FF * DM, DM, (size_t)2 * FF * DM, 2048, 2 * FF, DM, NE, 4, ACT, nullptr, nullptr, nullptr, nullptr, FF, (size_t)2048 * FF);
        launch_gemm(stream, ACT, FF, (size_t)2048 * FF, WDN + (size_t)l * NE * DM * FF, FF, (size_t)DM * FF, 2048, DM, FF, NE, 5, Y, nullptr, nullptr, nullptr, GW, DM, (size_t)2048 * DM);
        if (l + 1 < DEPTH) hipLaunchKernelGGL(k_moe_combine_norm, dim3(T), dim3(256), 0, stream, xres, Y, SLOT, nmix + (l + 1) * DM, H, 0);
        else hipLaunchKernelGGL(k_moe_combine_norm, dim3(T), dim3(256), 0, stream, xres, Y, SLOT, nfin, H, 1);
    }
}
```

```cpp
#include <hip/hip_runtime.h>
#include <cstdio>
#include <cstdint>

constexpr int NB = 8, SEQ = 2048, DM = 1024, T = NB * SEQ, DEPTH = 2;
constexpr int NIN = 10752, ATTN_IN = 4608, AW = 512, RW = 1024, CATW = AW + RW;
constexpr int OFF_RQ = 4608, OFF_RK = 5632, OFF_RV = 6656, OFF_RG = 7680, OFF_GA = 8704, OFF_GR = 9728;
constexpr int NE = 16, FF = 2048, CAP = 256, NROWS_E = NB * NE * CAP;
constexpr float EPS = 1e-6f;

constexpr size_t MiB = 1u << 20;
constexpr size_t WS_CTL = 0;
constexpr size_t WS_WIN = 1 * MiB;
constexpr size_t WS_WCAT = WS_WIN + 42 * MiB;
constexpr size_t WS_WO  = WS_WCAT + 6 * MiB;
constexpr size_t WS_WGU = WS_WO + 4 * MiB;
constexpr size_t WS_WDN = WS_WGU + 256 * MiB;
constexpr size_t WS_H   = WS_WDN + 128 * MiB;
constexpr size_t WS_PROJ = WS_H + 32 * MiB;
constexpr size_t WS_XIN = WS_PROJ;
constexpr size_t WS_ACT = WS_PROJ + 64 * MiB;
constexpr size_t WS_Y   = WS_PROJ + 192 * MiB;
constexpr size_t WS_ATTO = WS_PROJ + 336 * MiB;
constexpr size_t WS_LSE = WS_ATTO + 48 * MiB;
constexpr size_t WS_YF  = WS_LSE + 2 * MiB;
constexpr size_t WS_MERGED = WS_YF;
constexpr size_t WS_YB  = WS_YF + 32 * MiB;
constexpr size_t WS_CAT = WS_YB + 32 * MiB;
constexpr size_t WS_AFF = WS_CAT + 48 * MiB;
constexpr size_t WS_IDX = WS_AFF + 1 * MiB;
constexpr size_t WS_GW  = WS_IDX + 256 * 1024;
constexpr size_t WS_SLOT = WS_GW + 256 * 1024;
constexpr size_t WS_END = WS_SLOT + 1 * MiB;
static_assert(WS_END <= 1024 * MiB, "workspace map");

#define GAS __attribute__((address_space(1)))
#define LAS __attribute__((address_space(3)))
typedef unsigned short bf16;
typedef unsigned v4u __attribute__((ext_vector_type(4)));
typedef float f32x4 __attribute__((ext_vector_type(4)));
typedef short bf16x8 __attribute__((ext_vector_type(8)));
typedef GAS unsigned gu32;
typedef GAS unsigned long long gu64;
#define RLX_AGENT __ATOMIC_RELAXED, __HIP_MEMORY_SCOPE_AGENT
#define LDS_WAIT() asm volatile("s_waitcnt lgkmcnt(0)" ::: "memory")
#define VM_WAIT() asm volatile("s_waitcnt vmcnt(0)" ::: "memory")
__device__ __forceinline__ unsigned long long rt() { return __builtin_amdgcn_s_memrealtime(); }
__device__ __forceinline__ unsigned f2bf(float f) { unsigned u = __builtin_bit_cast(unsigned, f); return (u + 0x7fffu + ((u >> 16) & 1u)) >> 16; }
__device__ __forceinline__ unsigned pk2(float lo, float hi) { return f2bf(lo) | (f2bf(hi) << 16); }

#define XB_TMO      128
#define XB_XCNT(j)  (256  + 64 * (j))
#define XB_XSUB(j)  (1280 + 64 * (j))
#define XB_XGEN(j)  (2304 + 64 * (j))
#define XB_TOP      3328
#define XB_TOPGEN   3392
#define XCD_BAR_WORDS 3456
#define XB_SPIN_CAP (1u << 18)

__device__ __forceinline__ unsigned xb_ld(unsigned* p)              { return __hip_atomic_load(p, __ATOMIC_RELAXED, __HIP_MEMORY_SCOPE_AGENT); }
__device__ __forceinline__ unsigned xb_add(unsigned* p, unsigned v) { return __hip_atomic_fetch_add(p, v, __ATOMIC_RELAXED, __HIP_MEMORY_SCOPE_AGENT); }
__device__ __forceinline__ unsigned xb_xcc_id() { return (unsigned)__builtin_amdgcn_s_getreg((3 << 11) | 20) & 0xFu; }
#define XB_SPIN(cond, bar) do { unsigned _sp = 0; while (cond) { __builtin_amdgcn_s_sleep(1); \
    if ((++_sp & 255u) == 0u) { if (xb_ld(&(bar)[XB_TMO])) break; if (_sp > XB_SPIN_CAP) { atomicAdd(&(bar)[XB_TMO], 1u); break; } } } } while (0)

struct XcdBarrier {
    unsigned* bar; unsigned x;
    volatile LAS unsigned* st;
};

__device__ __forceinline__ XcdBarrier xcd_barrier_post(unsigned* bar, volatile LAS unsigned* st) {
    XcdBarrier b; b.bar = bar; b.x = xb_xcc_id(); b.st = st;
    if (threadIdx.x == 0) (void)xb_add(&bar[XB_XCNT(b.x)], 1u);
    return b;
}
__device__ __forceinline__ void xcd_barrier_complete(unsigned* bar, unsigned x, unsigned& nloc, unsigned& nx) {
    const unsigned G = gridDim.x * gridDim.y * gridDim.z;
    unsigned sum, cnt, mine, sp = 0u;
    for (;;) {
        sum = 0u; cnt = 0u; mine = 0u;
#pragma unroll
        for (unsigned j = 0; j < 16; ++j) { const unsigned c = xb_ld(&bar[XB_XCNT(j)]); sum += c; cnt += (c > 0u) ? 1u : 0u; mine = (j == x) ? c : mine; }
        if (sum == G) break;
        __builtin_amdgcn_s_sleep(1);
        if ((++sp & 255u) == 0u) { if (xb_ld(&bar[XB_TMO])) break; if (sp > XB_SPIN_CAP) { atomicAdd(&bar[XB_TMO], 1u); break; } }
    }
    nloc = mine > 0u ? mine : 1u; nx = cnt > 0u ? cnt : 1u;
}

__device__ __forceinline__ void xcd_barrier(const XcdBarrier& b) {
    asm volatile("s_waitcnt vmcnt(0)" ::: "memory");
    __syncthreads();
    if (threadIdx.x == 0) {
        unsigned* bar = b.bar;
        __builtin_amdgcn_s_waitcnt(0);
        unsigned nloc = b.st[0], nx = b.st[1];
        if (nloc == 0u) { xcd_barrier_complete(bar, b.x, nloc, nx); b.st[0] = nloc; b.st[1] = nx; }
        const unsigned old = xb_add(&bar[XB_XSUB(b.x)], 1u);
        const unsigned gen = old / nloc;
        if (old + 1u == (gen + 1u) * nloc) {
            __builtin_amdgcn_fence(__ATOMIC_RELEASE, "agent");
            asm volatile("s_waitcnt vmcnt(0)" ::: "memory");
            const unsigned og = xb_add(&bar[XB_TOP], 1u);
            const unsigned tg = og / nx;
            if (og + 1u == (tg + 1u) * nx) xb_add(&bar[XB_TOPGEN], 1u);
            else XB_SPIN(xb_ld(&bar[XB_TOPGEN]) == tg, bar);
            __builtin_amdgcn_fence(__ATOMIC_ACQUIRE, "agent");
            xb_add(&bar[XB_XGEN(b.x)], 1u);
            asm volatile("s_waitcnt vmcnt(0)" ::: "memory");
        } else {
            XB_SPIN(xb_ld(&bar[XB_XGEN(b.x)]) == gen, bar);
            __builtin_amdgcn_fence(__ATOMIC_ACQUIRE, "agent");
            asm volatile("s_waitcnt vmcnt(0)" ::: "memory");
        }
    }
    __syncthreads();
}


typedef unsigned u32x2 __attribute__((ext_vector_type(2)));
typedef unsigned u32x4 __attribute__((ext_vector_type(4)));
__device__ __forceinline__ float bf2f(unsigned short h) { return __builtin_bit_cast(float, (unsigned)h << 16); }
__device__ __forceinline__ float sigmoidf_(float v) { return 1.f / (1.f + __expf(-v)); }
__device__ __forceinline__ float siluf_(float v) { return v / (1.f + __expf(-v)); }
namespace pg8 {
#define PG8_LAS __attribute__((address_space(3)))
typedef unsigned short bf16_t;
typedef short bf16x8 __attribute__((ext_vector_type(8)));
typedef float f32x4 __attribute__((ext_vector_type(4)));
typedef unsigned u32x4 __attribute__((ext_vector_type(4)));
constexpr int BM = 256, BK = 64, HALF = 128, HTB = HALF * BK * 2  , STAGE_BYTES = 8 * HTB, NXCD = 8, WGM = 8;

__host__ __device__ __forceinline__ int lds_byte(int r, int c) { const int st = (r >> 4) * 2 + (c >> 5), rr = r & 15, cc = c & 31, ob = rr * 64 + cc * 2; return st * 1024 + (ob ^ (((ob >> 9) & 1) << 5)); }
__host__ __device__ __forceinline__ void stage_rc(int b, int& R, int& C) { const int st = b / 1024, sb = b % 1024, swz = sb ^ (((sb >> 9) & 1) << 5); R = (st >> 1) * 16 + swz / 64; C = (st & 1) * 32 + (swz % 64) / 2; }
__host__ __device__ __forceinline__ int perm32(int rho) { const int n = rho >> 4, i = rho & 15; return 8 * (i >> 2) + 4 * n + (i & 3); }

struct Unit { int pm, pn; };
struct Gemm { const bf16_t* A; const bf16_t* Bt; int M, N, K; int gshift; size_t gstrideB; };

struct StaticOrder {
    int nM, nN, nwg, G, c;
    __host__ __device__ void init(int M, int N, int G_, int c_) { nM = M / BM; nN = N / BM; nwg = nM * nN; G = G_; c = c_; }
    __host__ __device__ bool next(int i, Unit& u) const {
        const long L = (long)i * G + c; if (L >= nwg) return false;
        int wgid = (int)L; { const int q = nwg / NXCD, r = nwg % NXCD, xcd = wgid % NXCD, off = wgid / NXCD; wgid = (xcd < r ? xcd * (q + 1) : r * (q + 1) + (xcd - r) * q) + off; }
        const int nig = WGM * nN, gid = wgid / nig, fm = gid * WGM, gsz = (nM - fm) < WGM ? (nM - fm) : WGM;
        u.pm = fm + ((wgid % nig) % gsz); u.pn = (wgid % nig) / gsz; return true;
    }
    __device__ __forceinline__ void a_ready(const Unit&) const {}
    __device__ __forceinline__ void done(const Unit&) const {}
};

__device__ __forceinline__ unsigned cvt_pk_bf16(float lo, float hi) { unsigned r; asm volatile("v_cvt_pk_bf16_f32 %0, %1, %2" : "=v"(r) : "v"(lo), "v"(hi)); return r; }
typedef float f32x2 __attribute__((ext_vector_type(2)));
typedef unsigned u32x2 __attribute__((ext_vector_type(2)));
constexpr int P_NIN = 10752, P_OFF_GA = 8704, P_OFF_GR = 9728, P_FF = 2048;
__device__ __forceinline__ float bflo(unsigned w) { return __builtin_bit_cast(float, w << 16); }
__device__ __forceinline__ float bfhi(unsigned w) { return __builtin_bit_cast(float, w & 0xffff0000u); }
__device__ __forceinline__ float fsig(float v) { return __builtin_amdgcn_rcpf(1.f + __expf(-v)); }
struct EpiStore {
    static constexpr bool PERM = true, AFTER_DRAIN = false; static constexpr int MID_T = 0;
    bf16_t* O; int ldc;
    __device__ __forceinline__ void operator()(const f32x4 (&acc)[2][2][4][2], const Unit& u, int wr, int wc, int fr, int fq) const {
        int row0 = u.pm * BM + wr * 64 + fr, col0 = u.pn * BM + wc * 32 + 8 * fq; asm volatile("" : "+v"(row0));
#pragma unroll
        for (int ai = 0; ai < 2; ++ai)
#pragma unroll
            for (int m = 0; m < 4; ++m) { bf16_t* rowp = O + (size_t)(row0 + ai * HALF + m * 16) * ldc + col0;
#pragma unroll
                for (int bj = 0; bj < 2; ++bj) { const f32x4 v0 = acc[ai][bj][m][0], v1 = acc[ai][bj][m][1];
                    u32x4 w; w.x = cvt_pk_bf16(v0[0], v0[1]); w.y = cvt_pk_bf16(v0[2], v0[3]); w.z = cvt_pk_bf16(v1[0], v1[1]); w.w = cvt_pk_bf16(v1[2], v1[3]);
                    *(u32x4*)(rowp + bj * HALF) = w; } }
    }
};
struct EpiMerge {
    static constexpr bool PERM = true, AFTER_DRAIN = false; static constexpr int MID_T = 8;
    const bf16_t* proj; bf16_t* O;
    __device__ __forceinline__ void mid(f32x4 (&acc)[2][2][4][2], const Unit& u, int wr, int wc, int fr, int fq) const {
        int row0 = u.pm * BM + wr * 64 + fr, col0 = u.pn * BM + wc * 32 + 8 * fq; asm volatile("" : "+v"(row0));
#pragma unroll
        for (int ai = 0; ai < 2; ++ai)
#pragma unroll
            for (int m = 0; m < 4; ++m) { const bf16_t* pr = proj + (size_t)(row0 + ai * HALF + m * 16) * P_NIN + col0;
#pragma unroll
                for (int bj = 0; bj < 2; ++bj) { const u32x4 ga = *(const u32x4*)(pr + P_OFF_GA + bj * HALF), gr = *(const u32x4*)(pr + P_OFF_GR + bj * HALF);
                    f32x4 r0, r1;
                    r0[0] = (1.f + __expf(-bflo(gr.x))) * __builtin_amdgcn_rcpf(1.f + __expf(-bflo(ga.x))); r0[1] = (1.f + __expf(-bfhi(gr.x))) * __builtin_amdgcn_rcpf(1.f + __expf(-bfhi(ga.x)));
                    r0[2] = (1.f + __expf(-bflo(gr.y))) * __builtin_amdgcn_rcpf(1.f + __expf(-bflo(ga.y))); r0[3] = (1.f + __expf(-bfhi(gr.y))) * __builtin_amdgcn_rcpf(1.f + __expf(-bfhi(ga.y)));
                    r1[0] = (1.f + __expf(-bflo(gr.z))) * __builtin_amdgcn_rcpf(1.f + __expf(-bflo(ga.z))); r1[1] = (1.f + __expf(-bfhi(gr.z))) * __builtin_amdgcn_rcpf(1.f + __expf(-bfhi(ga.z)));
                    r1[2] = (1.f + __expf(-bflo(gr.w))) * __builtin_amdgcn_rcpf(1.f + __expf(-bflo(ga.w))); r1[3] = (1.f + __expf(-bfhi(gr.w))) * __builtin_amdgcn_rcpf(1.f + __expf(-bfhi(ga.w)));
                    acc[ai][bj][m][0] *= r0; acc[ai][bj][m][1] *= r1; } }
    }
    __device__ __forceinline__ void operator()(const f32x4 (&acc)[2][2][4][2], const Unit& u, int wr, int wc, int fr, int fq) const {
        int row0 = u.pm * BM + wr * 64 + fr, col0 = u.pn * BM + wc * 32 + 8 * fq; asm volatile("" : "+v"(row0));
#pragma unroll
        for (int ai = 0; ai < 2; ++ai)
#pragma unroll
            for (int m = 0; m < 4; ++m) { const size_t r = (size_t)(row0 + ai * HALF + m * 16); const bf16_t* pr = proj + r * P_NIN + P_OFF_GR + col0; bf16_t* rowp = O + r * 1024 + col0;
#pragma unroll
                for (int bj = 0; bj < 2; ++bj) { const u32x4 gr = *(const u32x4*)(pr + bj * HALF); const f32x4 v0 = acc[ai][bj][m][0], v1 = acc[ai][bj][m][1];
                    u32x4 w; w.x = cvt_pk_bf16(v0[0] * fsig(bflo(gr.x)), v0[1] * fsig(bfhi(gr.x))); w.y = cvt_pk_bf16(v0[2] * fsig(bflo(gr.y)), v0[3] * fsig(bfhi(gr.y)));
                    w.z = cvt_pk_bf16(v1[0] * fsig(bflo(gr.z)), v1[1] * fsig(bfhi(gr.z))); w.w = cvt_pk_bf16(v1[2] * fsig(bflo(gr.w)), v1[3] * fsig(bfhi(gr.w)));
                    *(u32x4*)(rowp + bj * HALF) = w; } }
    }
};
struct EpiResid {
    static constexpr bool PERM = false, AFTER_DRAIN = false; static constexpr int MID_T = 0;
    const float* src; float* out;
    __device__ __forceinline__ void operator()(const f32x4 (&acc)[2][2][4][2], const Unit& u, int wr, int wc, int fr, int fq) const {
        int row0 = u.pm * BM + wr * 64 + fr, col0 = u.pn * BM + wc * 32 + 4 * fq; asm volatile("" : "+v"(row0));
#pragma unroll
        for (int ai = 0; ai < 2; ++ai)
#pragma unroll
            for (int m = 0; m < 4; ++m) { const size_t off = (size_t)(row0 + ai * HALF + m * 16) * 1024 + col0;
#pragma unroll
                for (int bj = 0; bj < 2; ++bj)
#pragma unroll
                    for (int n = 0; n < 2; ++n) { const size_t o = off + bj * HALF + n * 16; *(f32x4*)(out + o) = *(const f32x4*)(src + o) + acc[ai][bj][m][n]; } }
    }
};
struct EpiSwiglu {
    static constexpr bool PERM = false, AFTER_DRAIN = false; static constexpr int MID_T = 0;
    bf16_t* O;
    __device__ __forceinline__ void operator()(const f32x4 (&acc)[2][2][4][2], const Unit& u, int wr, int wc, int fr, int fq) const {
        int row0 = u.pm * BM + wr * 64 + fr, f0 = (u.pn * BM + wc * 32) / 2 + 4 * fq; asm volatile("" : "+v"(row0));
#pragma unroll
        for (int ai = 0; ai < 2; ++ai)
#pragma unroll
            for (int m = 0; m < 4; ++m) { bf16_t* rowp = O + (size_t)(row0 + ai * HALF + m * 16) * P_FF + f0;
#pragma unroll
                for (int bj = 0; bj < 2; ++bj) { const f32x4 a = acc[ai][bj][m][0], b = acc[ai][bj][m][1];
                    u32x2 w; w.x = cvt_pk_bf16(a[0] * fsig(a[0]) * b[0], a[1] * fsig(a[1]) * b[1]); w.y = cvt_pk_bf16(a[2] * fsig(a[2]) * b[2], a[3] * fsig(a[3]) * b[3]);
                    *(u32x2*)(rowp + bj * (HALF / 2)) = w; } }
    }
};
struct EpiDown {
    static constexpr bool PERM = true, AFTER_DRAIN = false; static constexpr int MID_T = 0;
    const float* gw; bf16_t* O;
    __device__ __forceinline__ void operator()(const f32x4 (&acc)[2][2][4][2], const Unit& u, int wr, int wc, int fr, int fq) const {
        int row0 = u.pm * BM + wr * 64 + fr, col0 = u.pn * BM + wc * 32 + 8 * fq; asm volatile("" : "+v"(row0));
#pragma unroll
        for (int ai = 0; ai < 2; ++ai)
#pragma unroll
            for (int m = 0; m < 4; ++m) { const size_t r = (size_t)(row0 + ai * HALF + m * 16); const float s = gw[r]; bf16_t* rowp = O + r * 1024 + col0;
#pragma unroll
                for (int bj = 0; bj < 2; ++bj) { const f32x4 v0 = acc[ai][bj][m][0] * s, v1 = acc[ai][bj][m][1] * s;
                    u32x4 w; w.x = cvt_pk_bf16(v0[0], v0[1]); w.y = cvt_pk_bf16(v0[2], v0[3]); w.z = cvt_pk_bf16(v1[0], v1[1]); w.w = cvt_pk_bf16(v1[2], v1[3]);
                    *(u32x4*)(rowp + bj * HALF) = w; } }
    }
};
template <class Epi, class Sched, bool ALIGN_EPI = false, bool SP2 = false>
__device__ __forceinline__ void gemm_phase(PG8_LAS unsigned char* lds, const Gemm g, const Sched& S, const Epi& E, const int tid) {
    const int wid = __builtin_amdgcn_readfirstlane(tid >> 6), lane = tid & 63, wr = wid >> 2, wc = wid & 3, fr = lane & 15, fq = lane >> 4;
    const int K = g.K, nt = K / BK;
    unsigned voffA[2], voffB[2];
#pragma unroll
    for (int i = 0; i < 2; ++i) { int R, C; stage_rc(tid * 16 + i * 8192, R, C); const int Rb = Epi::PERM ? ((R & ~31) + perm32(R & 31)) : R;
        voffA[i] = (unsigned)(R * K + C) * 2u; voffB[i] = (unsigned)(Rb * K + C) * 2u; }
    const size_t kstep = (size_t)(BK * 2);
    const size_t hstep = (size_t)HALF * K * 2;
    const size_t tstep = 2 * hstep;
    const unsigned ldsw = (unsigned)wid * 1024u;
    const int aoff = lds_byte(wr * 64 + fr, fq * 8), boff = lds_byte(wc * 32 + fr, fq * 8);
#define PG8_SA(b, h) (((b) * 2 + (h)) * HTB)
#define PG8_SB(b, h) ((4 + (b) * 2 + (h)) * HTB)
#define PG8_STAGE(bufoff, gbase, voff) do { _Pragma("unroll") for (int _i = 0; _i < 2; ++_i) \
        __builtin_amdgcn_global_load_lds((const unsigned*)((const char*)(gbase) + (voff)[_i]), (PG8_LAS unsigned*)(lds + (bufoff) + ldsw + _i * 8192), 16, 0, 0); } while (0)
#define PG8_LDA(dst, b, h) do { _Pragma("unroll") for (int m = 0; m < 4; ++m) _Pragma("unroll") for (int k = 0; k < 2; ++k) dst[m][k] = *(const PG8_LAS bf16x8*)(lds + PG8_SA(b, h) + aoff + m * 2048 + k * 1024); } while (0)
#define PG8_LDB(dst, b, h) do { _Pragma("unroll") for (int n = 0; n < 2; ++n) _Pragma("unroll") for (int k = 0; k < 2; ++k) dst[n][k] = *(const PG8_LAS bf16x8*)(lds + PG8_SB(b, h) + boff + n * 2048 + k * 1024); } while (0)
#define PG8_MMA(ai, bj, At, Bt) do { __builtin_amdgcn_s_setprio(1); _Pragma("unroll") for (int m = 0; m < 4; ++m) _Pragma("unroll") for (int n = 0; n < 2; ++n) _Pragma("unroll") for (int k = 0; k < 2; ++k) \
        acc[ai][bj][m][n] = __builtin_amdgcn_mfma_f32_16x16x32_bf16(Bt[n][k], At[m][k], acc[ai][bj][m][n], 0, 0, 0); __builtin_amdgcn_s_setprio(0); } while (0)
#define PG8_WAIT_V(n) asm volatile("s_waitcnt vmcnt(" #n ")" ::: "memory")
#define PG8_WAIT_L(n) asm volatile("s_waitcnt lgkmcnt(" #n ")" ::: "memory")
#define PG8_BAR __builtin_amdgcn_s_barrier()
#define PG8_SCHED __builtin_amdgcn_sched_barrier(0)
    Unit cur, nxt; int ui = 0;
    if (!S.next(0, cur)) return;
    f32x4 acc[2][2][4][2];
#pragma unroll
    for (int a = 0; a < 2; ++a)
#pragma unroll
        for (int b = 0; b < 2; ++b)
#pragma unroll
            for (int m = 0; m < 4; ++m)
#pragma unroll
                for (int n = 0; n < 2; ++n) acc[a][b][m][n] = (f32x4){0.f, 0.f, 0.f, 0.f};
    bf16x8 At[4][2], B0[2][2], B1[2][2];
    const char* cA = (const char*)g.A + (size_t)cur.pm * tstep; const char* cB = (const char*)g.Bt + (size_t)(cur.pm >> g.gshift) * g.gstrideB + (size_t)cur.pn * tstep;
    S.a_ready(cur);
    if constexpr (SP2) {
        PG8_STAGE(PG8_SB(0, 0), cB, voffB); PG8_STAGE(PG8_SB(0, 1), cB + hstep, voffB); PG8_STAGE(PG8_SA(0, 0), cA, voffA); PG8_STAGE(PG8_SA(0, 1), cA + hstep, voffA);
        if (wr == 1) PG8_BAR;
        PG8_WAIT_V(2); PG8_BAR;
        PG8_STAGE(PG8_SB(1, 0), cB + kstep, voffB); PG8_STAGE(PG8_SA(1, 0), cA + kstep, voffA); PG8_STAGE(PG8_SB(1, 1), cB + hstep + kstep, voffB);
        PG8_WAIT_V(6); PG8_BAR;
    } else {
        PG8_STAGE(PG8_SB(0, 0), cB, voffB); PG8_STAGE(PG8_SA(0, 0), cA, voffA); PG8_STAGE(PG8_SB(0, 1), cB + hstep, voffB); PG8_STAGE(PG8_SA(0, 1), cA + hstep, voffA);
        if (wr == 1) PG8_BAR;
        PG8_WAIT_V(4); PG8_BAR;
        PG8_STAGE(PG8_SB(1, 0), cB + kstep, voffB); PG8_STAGE(PG8_SA(1, 0), cA + kstep, voffA); PG8_STAGE(PG8_SB(1, 1), cB + hstep + kstep, voffB);
        PG8_WAIT_V(6); PG8_BAR;
    }
    for (;;) {
        const bool has_next = S.next(ui + 1, nxt);
        const char* nA = has_next ? (const char*)g.A + (size_t)nxt.pm * tstep : cA; const char* nB = has_next ? (const char*)g.Bt + (size_t)(nxt.pm >> g.gshift) * g.gstrideB + (size_t)nxt.pn * tstep : cB;
        for (int t = 0; t < nt; t += 2) {
            const bool last = (t == nt - 2);
            if constexpr (Epi::MID_T > 0) { if (t == Epi::MID_T) E.mid(acc, cur, wr, wc, fr, fq); }
            const char* a1 = cA + (size_t)(t + 1) * kstep;
            const char* a2 = last ? nA : cA + (size_t)(t + 2) * kstep; const char* b2 = last ? nB : cB + (size_t)(t + 2) * kstep;
            const char* a3 = a2 + kstep; const char* b3 = b2 + kstep;
            if (last && has_next) S.a_ready(nxt);
            if constexpr (SP2) {
            PG8_LDB(B0, 0, 0); PG8_LDB(B1, 0, 1); PG8_SCHED; PG8_LDA(At, 0, 0); PG8_STAGE(PG8_SA(1, 1), a1 + hstep, voffA);
            PG8_WAIT_V(8); PG8_WAIT_L(0); PG8_BAR; PG8_MMA(0, 0, At, B0); PG8_MMA(0, 1, At, B1); PG8_BAR; PG8_SCHED;
            PG8_LDA(At, 0, 1); PG8_STAGE(PG8_SB(0, 0), b2, voffB); PG8_STAGE(PG8_SB(0, 1), b2 + hstep, voffB); PG8_STAGE(PG8_SA(0, 0), a2, voffA);
            PG8_WAIT_V(8); PG8_WAIT_L(0); PG8_BAR; PG8_MMA(1, 0, At, B0); PG8_MMA(1, 1, At, B1); PG8_BAR; PG8_SCHED;
            PG8_LDB(B0, 1, 0); PG8_LDB(B1, 1, 1); PG8_SCHED; PG8_LDA(At, 1, 0); PG8_STAGE(PG8_SA(0, 1), a2 + hstep, voffA);
            PG8_WAIT_V(8); PG8_WAIT_L(0); PG8_BAR; PG8_MMA(0, 0, At, B0); PG8_MMA(0, 1, At, B1); PG8_BAR; PG8_SCHED;
            PG8_LDA(At, 1, 1); PG8_STAGE(PG8_SB(1, 0), b3, voffB); PG8_STAGE(PG8_SB(1, 1), b3 + hstep, voffB); PG8_STAGE(PG8_SA(1, 0), a3, voffA);
            PG8_WAIT_V(8); PG8_WAIT_L(0); PG8_BAR; PG8_MMA(1, 0, At, B0); PG8_MMA(1, 1, At, B1); PG8_BAR; PG8_SCHED;
            } else {
            PG8_LDB(B0, 0, 0); PG8_SCHED; PG8_LDA(At, 0, 0); PG8_STAGE(PG8_SA(1, 1), a1 + hstep, voffA);
            PG8_WAIT_L(8); PG8_BAR; PG8_WAIT_L(0); PG8_MMA(0, 0, At, B0); PG8_BAR; PG8_SCHED;
            PG8_LDB(B1, 0, 1); PG8_STAGE(PG8_SB(0, 0), b2, voffB);
            PG8_BAR; PG8_WAIT_L(0); PG8_MMA(0, 1, At, B1); PG8_BAR;
            PG8_LDA(At, 0, 1); PG8_STAGE(PG8_SA(0, 0), a2, voffA);
            PG8_BAR; PG8_WAIT_L(0); PG8_MMA(1, 0, At, B0); PG8_BAR; PG8_SCHED;
            PG8_STAGE(PG8_SB(0, 1), b2 + hstep, voffB);
            PG8_WAIT_V(6); PG8_BAR; PG8_MMA(1, 1, At, B1); PG8_BAR;
            PG8_LDB(B0, 1, 0); PG8_SCHED; PG8_LDA(At, 1, 0); PG8_STAGE(PG8_SA(0, 1), a2 + hstep, voffA);
            PG8_WAIT_L(8); PG8_BAR; PG8_WAIT_L(0); PG8_MMA(0, 0, At, B0); PG8_BAR; PG8_SCHED;
            PG8_LDB(B1, 1, 1); PG8_STAGE(PG8_SB(1, 0), b3, voffB);
            PG8_BAR; PG8_WAIT_L(0); PG8_MMA(0, 1, At, B1); PG8_BAR;
            PG8_LDA(At, 1, 1); PG8_STAGE(PG8_SA(1, 0), a3, voffA);
            PG8_BAR; PG8_WAIT_L(0); PG8_MMA(1, 0, At, B0); PG8_BAR; PG8_SCHED;
            PG8_STAGE(PG8_SB(1, 1), b3 + hstep, voffB);
            PG8_WAIT_V(6); PG8_BAR; PG8_MMA(1, 1, At, B1); PG8_BAR;
            }
        }
        if constexpr (ALIGN_EPI) { if (wr == 0) PG8_BAR; }
        if constexpr (!Epi::AFTER_DRAIN) { E(acc, cur, wr, wc, fr, fq); S.done(cur); }
        if (!has_next) break;
#pragma unroll
        for (int a = 0; a < 2; ++a)
#pragma unroll
            for (int b = 0; b < 2; ++b)
#pragma unroll
                for (int m = 0; m < 4; ++m)
#pragma unroll
                    for (int n = 0; n < 2; ++n) acc[a][b][m][n] = (f32x4){0.f, 0.f, 0.f, 0.f};
        cur = nxt; cA = nA; cB = nB; ++ui;
        if constexpr (ALIGN_EPI) { if (wr == 1) PG8_BAR; }
    }
    PG8_WAIT_V(0);
    if constexpr (!ALIGN_EPI) { if (wr == 0) PG8_BAR; }
    PG8_BAR;
    if constexpr (Epi::AFTER_DRAIN) { E.fused(acc, cur, wr, wc, fr, fq, lds, wid, lane); S.done(cur); }
#undef PG8_SA
#undef PG8_SB
#undef PG8_STAGE
#undef PG8_LDA
#undef PG8_LDB
#undef PG8_MMA
#undef PG8_WAIT_V
#undef PG8_WAIT_L
#undef PG8_BAR
#undef PG8_SCHED
}
}


constexpr int NWAVES = 8;
constexpr int RING_OFF = 0, RING_BYTES = 131072;
constexpr int LDSCTL_OFF = RING_BYTES, MISC_OFF = LDSCTL_OFF + 320;
constexpr int LDS_BYTES = 147456;
constexpr int CW_BAR = 4096;
constexpr size_t CTL_ZERO_BYTES = 64 * 1024;
constexpr int NPH_LAYER = 10, NPHASES = 1 + DEPTH * NPH_LAYER;

struct Frame {
    LAS unsigned char* lds; volatile LAS unsigned* MISC; unsigned* ctl;
    int tid, lane, wave, G, vcu;
};
struct Args { const float* in[13]; float* out; unsigned char* ws; int ph_lo, ph_hi; };

__device__ __forceinline__ float wave_sum(float v) {
#pragma unroll
    for (int o = 1; o < 64; o <<= 1) v += __shfl_xor(v, o);
    return v;
}
__device__ __forceinline__ float bflo(unsigned w) { return __builtin_bit_cast(float, w << 16); }
__device__ __forceinline__ float bfhi(unsigned w) { return __builtin_bit_cast(float, w & 0xffff0000u); }

__device__ __forceinline__ void p0_transpose_item(const float* W, int K, int N, bf16* WT, int ldo, int koff, int mode, LAS float* scr, int item, int lane) {
    const int nblk = N / 32, kb = item / nblk, nb = item % nblk, k0 = 64 * kb, n0 = 32 * nb;
#pragma unroll 8
    for (int i = 0; i < 32; ++i) { const int kk = 2 * i + (lane >> 5); scr[kk * 33 + (lane & 31)] = W[(size_t)(k0 + kk) * N + n0 + (lane & 31)]; }
    LDS_WAIT(); asm volatile("" ::: "memory");
    const int c = lane & 7;
#pragma unroll
    for (int j = 0; j < 4; ++j) { const int n = (lane >> 3) + 8 * j; const LAS float* s = scr + (8 * c) * 33 + n;
        v4u o; o.x = pk2(s[0 * 33], s[1 * 33]); o.y = pk2(s[2 * 33], s[3 * 33]); o.z = pk2(s[4 * 33], s[5 * 33]); o.w = pk2(s[6 * 33], s[7 * 33]);
        const int ng = n0 + n; const int np = (mode == 0) ? ng : ((ng >> 4) * 32 + (ng & 15) + (mode == 2 ? 16 : 0));
        *(v4u*)(WT + (size_t)np * ldo + koff + k0 + 8 * c) = o; }
    LDS_WAIT(); asm volatile("" ::: "memory");
}
__device__ __forceinline__ void rms_row_to_bf16(const float* xrow, const float* gain, bf16* orow, int lane) {
    const f32x4* xr = (const f32x4*)xrow + lane; const f32x4* gr = (const f32x4*)gain + lane;
    f32x4 v[4]; float s = 0.f;
#pragma unroll
    for (int j = 0; j < 4; ++j) { v[j] = xr[64 * j]; s += (v[j].x * v[j].x + v[j].y * v[j].y) + (v[j].z * v[j].z + v[j].w * v[j].w); }
    const float rstd = rsqrtf(wave_sum(s) * (1.f / DM) + EPS);
    unsigned long long* o8 = (unsigned long long*)orow + lane;
#pragma unroll
    for (int j = 0; j < 4; ++j) { const f32x4 g = gr[64 * j];
        o8[64 * j] = (unsigned long long)pk2(v[j].x * rstd * g.x, v[j].y * rstd * g.y) | ((unsigned long long)pk2(v[j].z * rstd * g.z, v[j].w * rstd * g.w) << 32); }
}
__device__ __forceinline__ void phase_p0(Frame& F, const Args& a) {
    LAS float* scr = (LAS float*)(F.lds + RING_OFF + F.wave * 16384);
    const int gw = F.vcu * NWAVES + F.wave, NGW = F.G * NWAVES;
    constexpr int I_IN = (DM / 64) * (NIN / 32), I_AO = (AW / 64) * (DM / 32), I_RO = (RW / 64) * (DM / 32), I_O = (DM / 64) * (DM / 32);
    constexpr int I_G = (DM / 64) * (FF / 32), I_D = (FF / 64) * (DM / 32);
    constexpr int PER_LAYER = I_IN + I_AO + I_RO + I_O + NE * (2 * I_G + I_D);
    unsigned char* ws = a.ws;
    for (int it = gw; it < DEPTH * PER_LAYER; it += NGW) {
        const int l = it / PER_LAYER; int r = it % PER_LAYER;
        if (r < I_IN) { p0_transpose_item(a.in[1] + (size_t)l * DM * NIN, DM, NIN, (bf16*)(ws + WS_WIN) + (size_t)l * NIN * DM, DM, 0, 0, scr, r, F.lane); continue; } r -= I_IN;
        if (r < I_AO) { p0_transpose_item(a.in[2] + (size_t)l * AW * DM, AW, DM, (bf16*)(ws + WS_WCAT) + (size_t)l * DM * CATW, CATW, 0, 0, scr, r, F.lane); continue; } r -= I_AO;
        if (r < I_RO) { p0_transpose_item(a.in[3] + (size_t)l * RW * DM, RW, DM, (bf16*)(ws + WS_WCAT) + (size_t)l * DM * CATW, CATW, AW, 0, scr, r, F.lane); continue; } r -= I_RO;
        if (r < I_O) { p0_transpose_item(a.in[4] + (size_t)l * DM * DM, DM, DM, (bf16*)(ws + WS_WO) + (size_t)l * DM * DM, DM, 0, 0, scr, r, F.lane); continue; } r -= I_O;
        const int e = r / (2 * I_G + I_D); r %= (2 * I_G + I_D); const size_t le = (size_t)l * NE + e;
        if (r < I_G) { p0_transpose_item(a.in[9] + le * DM * FF, DM, FF, (bf16*)(ws + WS_WGU) + le * 2 * FF * DM, DM, 0, 1, scr, r, F.lane); continue; } r -= I_G;
        if (r < I_G) { p0_transpose_item(a.in[10] + le * DM * FF, DM, FF, (bf16*)(ws + WS_WGU) + le * 2 * FF * DM, DM, 0, 2, scr, r, F.lane); continue; } r -= I_G;
        p0_transpose_item(a.in[11] + le * FF * DM, FF, DM, (bf16*)(ws + WS_WDN) + le * DM * FF, FF, 0, 0, scr, r, F.lane);
    }
    bf16* H = (bf16*)(ws + WS_H);
    for (int m = gw; m < T; m += NGW) rms_row_to_bf16(a.in[0] + (size_t)m * DM, a.in[6], H + (size_t)m * DM, F.lane);
}

__device__ __forceinline__ void phase_finalize(Frame& F, const Args& a) {
    unsigned char* ws = a.ws; const bf16* PROJ = (const bf16*)(ws + WS_PROJ); const bf16* YF = (const bf16*)(ws + WS_YF); const bf16* YB = (const bf16*)(ws + WS_YB);
    const bf16* ATTO = (const bf16*)(ws + WS_ATTO); const float* LSE = (const float*)(ws + WS_LSE); bf16* CAT = (bf16*)(ws + WS_CAT);
    const int gw = F.vcu * NWAVES + F.wave, NGW = F.G * NWAVES, lane = F.lane;
    for (int t = gw; t < T; t += NGW) {
        bf16* crow = CAT + (size_t)t * CATW;
#pragma unroll
        for (int j = 0; j < 4; ++j) {
            const int c = 256 * j + 4 * lane;
            const u32x2 yf = *(const u32x2*)(YF + (size_t)t * RW + c), yb = *(const u32x2*)(YB + (size_t)t * RW + c), gq = *(const u32x2*)(PROJ + (size_t)t * NIN + OFF_RG + c);
            const float r0 = bflo(yf.x) + bflo(yb.x), r1 = bfhi(yf.x) + bfhi(yb.x), r2 = bflo(yf.y) + bflo(yb.y), r3 = bfhi(yf.y) + bfhi(yb.y);
            const float rstd = rsqrtf(wave_sum((r0 * r0 + r1 * r1) + (r2 * r2 + r3 * r3)) * (1.f / 256.f) + EPS);
            const float g0 = bflo(gq.x), g1 = bfhi(gq.x), g2 = bflo(gq.y), g3 = bfhi(gq.y);
            u32x2 o; o.x = pk2(siluf_(g0) * r0 * rstd, siluf_(g1) * r1 * rstd); o.y = pk2(siluf_(g2) * r2 * rstd, siluf_(g3) * r3 * rstd);
            *(u32x2*)(crow + AW + c) = o;
        }
        {
            const int hh = lane >> 3, c = 8 * lane;
            const float l0 = LSE[((size_t)0 * T + t) * 8 + hh], l1 = LSE[((size_t)1 * T + t) * 8 + hh], l2 = LSE[((size_t)2 * T + t) * 8 + hh];
            const float mx = fmaxf(l0, fmaxf(l1, l2)); float w0 = __expf(l0 - mx), w1 = __expf(l1 - mx), w2 = __expf(l2 - mx); const float inv = 1.f / (w0 + w1 + w2); w0 *= inv; w1 *= inv; w2 *= inv;
            const v4u p0 = *(const v4u*)(ATTO + ((size_t)0 * T + t) * AW + c), p1 = *(const v4u*)(ATTO + ((size_t)1 * T + t) * AW + c), p2 = *(const v4u*)(ATTO + ((size_t)2 * T + t) * AW + c);
            v4u o;
            o.x = pk2(w0 * bflo(p0.x) + w1 * bflo(p1.x) + w2 * bflo(p2.x), w0 * bfhi(p0.x) + w1 * bfhi(p1.x) + w2 * bfhi(p2.x));
            o.y = pk2(w0 * bflo(p0.y) + w1 * bflo(p1.y) + w2 * bflo(p2.y), w0 * bfhi(p0.y) + w1 * bfhi(p1.y) + w2 * bfhi(p2.y));
            o.z = pk2(w0 * bflo(p0.z) + w1 * bflo(p1.z) + w2 * bflo(p2.z), w0 * bfhi(p0.z) + w1 * bfhi(p1.z) + w2 * bfhi(p2.z));
            o.w = pk2(w0 * bflo(p0.w) + w1 * bflo(p1.w) + w2 * bflo(p2.w), w0 * bfhi(p0.w) + w1 * bfhi(p1.w) + w2 * bfhi(p2.w));
            *(v4u*)(crow + c) = o;
        }
    }
}

__device__ __forceinline__ void phase_norm_router(Frame& F, const Args& a, int layer) {
    unsigned char* ws = a.ws; const float* x = a.out; const float* gain = a.in[7] + (size_t)layer * DM; const float* wr = a.in[8] + (size_t)layer * DM * NE;
    bf16* H = (bf16*)(ws + WS_H); float* AFF = (float*)(ws + WS_AFF);
    LAS float* wl = (LAS float*)(F.lds + RING_OFF);
    for (int i = F.tid; i < DM * NE; i += NWAVES * 64) wl[(i & 15) * DM + (i >> 4)] = wr[i];
    __syncthreads();
    const int gw = F.vcu * NWAVES + F.wave, NGW = F.G * NWAVES, lane = F.lane;
    for (int t = gw; t < T; t += NGW) {
        int lo4 = 4 * lane; asm volatile("" : "+v"(lo4));
        const f32x4* xr = (const f32x4*)(x + (size_t)t * DM) + lane; const f32x4* gr = (const f32x4*)gain + lane;
        f32x4 v[4]; float s = 0.f;
#pragma unroll
        for (int j = 0; j < 4; ++j) { v[j] = xr[64 * j]; s += (v[j].x * v[j].x + v[j].y * v[j].y) + (v[j].z * v[j].z + v[j].w * v[j].w); }
        const float rstd = rsqrtf(wave_sum(s) * (1.f / DM) + EPS);
        unsigned long long* o8 = (unsigned long long*)(H + (size_t)t * DM) + lane;
        float lg[16];
#pragma unroll
        for (int e = 0; e < 16; ++e) lg[e] = 0.f;
#pragma unroll
        for (int j = 0; j < 4; ++j) { const f32x4 g = gr[64 * j]; const float h0 = v[j].x * rstd * g.x, h1 = v[j].y * rstd * g.y, h2 = v[j].z * rstd * g.z, h3 = v[j].w * rstd * g.w;
            o8[64 * j] = (unsigned long long)pk2(h0, h1) | ((unsigned long long)pk2(h2, h3) << 32);
#pragma unroll
            for (int e = 0; e < 16; ++e) { const f32x4 w = *(const LAS f32x4*)(wl + e * DM + 256 * j + lo4); lg[e] += (h0 * w[0] + h1 * w[1]) + (h2 * w[2] + h3 * w[3]); } }
#pragma unroll
        for (int e = 0; e < 16; ++e) lg[e] = wave_sum(lg[e]);
        float mx = lg[0];
#pragma unroll
        for (int e = 1; e < 16; ++e) mx = fmaxf(mx, lg[e]);
        float den = 0.f;
#pragma unroll
        for (int e = 0; e < 16; ++e) { lg[e] = __expf(lg[e] - mx); den += lg[e]; }
        const float inv = 1.f / den;
        float mine = 0.f;
#pragma unroll
        for (int e = 0; e < 16; ++e) mine = (lane == e) ? lg[e] * inv : mine;
        if (lane < 16) AFF[(size_t)t * 16 + lane] = mine;
    }
    __syncthreads();
}

__device__ __forceinline__ void phase_topk(Frame& F, const Args& a) {
    unsigned char* ws = a.ws; const float* AFF = (const float*)(ws + WS_AFF); const bf16* H = (const bf16*)(ws + WS_H);
    int* IDX = (int*)(ws + WS_IDX); float* GW = (float*)(ws + WS_GW); int* SLOT = (int*)(ws + WS_SLOT); bf16* XIN = (bf16*)(ws + WS_XIN);
    LAS float* av = (LAS float*)(F.lds + RING_OFF);
    LAS int* selt = (LAS int*)(F.lds + RING_OFF + 8192);
    LAS int* selr = (LAS int*)(F.lds + RING_OFF + 8192 + 1024);
    LAS int* cnt = (LAS int*)(F.lds + RING_OFF + 8192 + 2048);
    for (int u = F.vcu; u < NB * NE * 2; u += F.G) {
        const int half = u & 1, be = u >> 1, b = be >> 4, e = be & 15;
        __syncthreads();
        for (int s = F.tid; s < SEQ; s += NWAVES * 64) av[s] = AFF[(size_t)(b * SEQ + s) * 16 + e];
        if (F.tid == 0) cnt[0] = 0;
        __syncthreads();
#pragma unroll 1
        for (int k = 0; k < 2; ++k) { const int s = half * 1024 + k * 512 + F.tid; const float v = av[s]; int rank = 0;
            for (int j = 0; j < SEQ; j += 4) { const f32x4 w = *(const LAS f32x4*)(av + j);
                rank += (w[0] > v || (w[0] == v && j < s)) ? 1 : 0; rank += (w[1] > v || (w[1] == v && j + 1 < s)) ? 1 : 0;
                rank += (w[2] > v || (w[2] == v && j + 2 < s)) ? 1 : 0; rank += (w[3] > v || (w[3] == v && j + 3 < s)) ? 1 : 0; }
            int sl = -1;
            if (rank < CAP) { sl = rank; const int row = (e * NB + b) * CAP + rank; IDX[row] = b * SEQ + s; GW[row] = v; const int p = __hip_atomic_fetch_add(cnt, 1, __ATOMIC_RELAXED, __HIP_MEMORY_SCOPE_WORKGROUP); selt[p] = b * SEQ + s; selr[p] = row; }
            SLOT[(b * NE + e) * SEQ + s] = sl; }
        __syncthreads();
        const int n = cnt[0];
        for (int i = F.wave; i < n; i += NWAVES) { const int t = selt[i], row = selr[i];
            const v4u* src = (const v4u*)(H + (size_t)t * DM); v4u* dst = (v4u*)(XIN + (size_t)row * DM);
            dst[F.lane] = src[F.lane]; dst[64 + F.lane] = src[64 + F.lane]; }
    }
    __syncthreads();
}

__device__ __forceinline__ void phase_combine_norm(Frame& F, const Args& a, int layer) {
    unsigned char* ws = a.ws; float* x = a.out; const bf16* Y = (const bf16*)(ws + WS_Y); const int* SLOT = (const int*)(ws + WS_SLOT); bf16* H = (bf16*)(ws + WS_H);
    const bool final_ = (layer + 1 == DEPTH); const float* gain = final_ ? a.in[12] : a.in[6] + (size_t)(layer + 1) * DM;
    const int gw = F.vcu * NWAVES + F.wave, NGW = F.G * NWAVES, lane = F.lane;
    for (int t = gw; t < T; t += NGW) {
        const int b = t / SEQ, s = t % SEQ;
        f32x4* xr = (f32x4*)(x + (size_t)t * DM) + lane; const f32x4* gr = (const f32x4*)gain + lane;
        f32x4 v[4];
#pragma unroll
        for (int j = 0; j < 4; ++j) v[j] = xr[64 * j];
#pragma unroll 1
        for (int e = 0; e < NE; ++e) { const int sl = __builtin_amdgcn_readfirstlane(SLOT[(b * NE + e) * SEQ + s]);
            if (sl >= 0) { const u32x2* yr = (const u32x2*)(Y + ((size_t)(e * NB + b) * CAP + sl) * DM) + lane;
#pragma unroll
                for (int j = 0; j < 4; ++j) { const u32x2 y = yr[64 * j]; v[j].x += bflo(y.x); v[j].y += bfhi(y.x); v[j].z += bflo(y.y); v[j].w += bfhi(y.y); } } }
        float ss = 0.f;
#pragma unroll
        for (int j = 0; j < 4; ++j) ss += (v[j].x * v[j].x + v[j].y * v[j].y) + (v[j].z * v[j].z + v[j].w * v[j].w);
        const float rstd = rsqrtf(wave_sum(ss) * (1.f / DM) + EPS);
        if (!final_) { unsigned long long* o8 = (unsigned long long*)(H + (size_t)t * DM) + lane;
#pragma unroll
            for (int j = 0; j < 4; ++j) { const f32x4 g = gr[64 * j]; xr[64 * j] = v[j];
                o8[64 * j] = (unsigned long long)pk2(v[j].x * rstd * g.x, v[j].y * rstd * g.y) | ((unsigned long long)pk2(v[j].z * rstd * g.z, v[j].w * rstd * g.w) << 32); } }
        else {
#pragma unroll
            for (int j = 0; j < 4; ++j) { const f32x4 g = gr[64 * j]; f32x4 o; o.x = v[j].x * rstd * g.x; o.y = v[j].y * rstd * g.y; o.z = v[j].z * rstd * g.z; o.w = v[j].w * rstd * g.w; xr[64 * j] = o; } }
    }
}

__global__ void __launch_bounds__(NWAVES * 64, 2) mega(Args args) {
    extern __shared__ __attribute__((aligned(16))) unsigned char lds[];
    Frame F;
    F.lds = (LAS unsigned char*)lds; F.MISC = (volatile LAS unsigned*)(F.lds + MISC_OFF);
    F.tid = threadIdx.x; F.lane = F.tid & 63; F.wave = __builtin_amdgcn_readfirstlane(F.tid >> 6);
    F.G = gridDim.x; { const int bx = blockIdx.x; F.vcu = (F.G % 8 == 0) ? (bx % 8) * (F.G / 8) + bx / 8 : bx; }
    unsigned char* ws = args.ws; F.ctl = (unsigned*)(ws + WS_CTL);
    for (int u = F.tid; u < (LDS_BYTES - LDSCTL_OFF) / 4; u += NWAVES * 64) ((LAS unsigned*)(F.lds + LDSCTL_OFF))[u] = 0u;
    __syncthreads();
    const bool multi = (args.ph_hi - args.ph_lo) > 1;
    XcdBarrier bar; bar.bar = F.ctl + CW_BAR; bar.x = 0; bar.st = nullptr;
    if (multi) bar = xcd_barrier_post(F.ctl + CW_BAR, F.MISC + 8);
    const pg8::bf16_t* H = (const pg8::bf16_t*)(ws + WS_H);
#pragma unroll 1
    for (int ph = args.ph_lo; ph < args.ph_hi; ++ph) {
        { int tid_ = threadIdx.x; asm volatile("" : "+v"(tid_)); F.tid = tid_; F.lane = tid_ & 63; F.wave = __builtin_amdgcn_readfirstlane(tid_ >> 6); }
        if (ph == 0) phase_p0(F, args);
        else {
            const int layer = (ph - 1) / NPH_LAYER, k = (ph - 1) % NPH_LAYER;
            if (k == 0) {
                pg8::Gemm g{H, (const pg8::bf16_t*)(ws + WS_WIN) + (size_t)layer * NIN * DM, T, NIN, DM, 30, 0}; pg8::StaticOrder S; S.init(T, NIN, F.G, (int)blockIdx.x);
                pg8::EpiStore E{(pg8::bf16_t*)(ws + WS_PROJ), NIN};
                pg8::gemm_phase<pg8::EpiStore, pg8::StaticOrder, true, true>(F.lds + RING_OFF, g, S, E, F.tid);
            } else if (k == 1) {
            } else if (k == 2) phase_finalize(F, args);
            else if (k == 3) {
                pg8::Gemm g{(const pg8::bf16_t*)(ws + WS_CAT), (const pg8::bf16_t*)(ws + WS_WCAT) + (size_t)layer * DM * CATW, T, DM, CATW, 30, 0}; pg8::StaticOrder S; S.init(T, DM, F.G, (int)blockIdx.x);
                pg8::EpiMerge E{(const pg8::bf16_t*)(ws + WS_PROJ), (pg8::bf16_t*)(ws + WS_MERGED)};
                pg8::gemm_phase<pg8::EpiMerge, pg8::StaticOrder, true, true>(F.lds + RING_OFF, g, S, E, F.tid);
            } else if (k == 4) {
                pg8::Gemm g{(const pg8::bf16_t*)(ws + WS_MERGED), (const pg8::bf16_t*)(ws + WS_WO) + (size_t)layer * DM * DM, T, DM, DM, 30, 0}; pg8::StaticOrder S; S.init(T, DM, F.G, (int)blockIdx.x);
                pg8::EpiResid E{layer == 0 ? args.in[0] : (const float*)args.out, args.out};
                pg8::gemm_phase<pg8::EpiResid, pg8::StaticOrder, true, true>(F.lds + RING_OFF, g, S, E, F.tid);
            } else if (k == 5) phase_norm_router(F, args, layer);
            else if (k == 6) phase_topk(F, args);
            else if (k == 7) {
                pg8::Gemm g{(const pg8::bf16_t*)(ws + WS_XIN), (const pg8::bf16_t*)(ws + WS_WGU) + (size_t)layer * NE * 2 * FF * DM, NROWS_E, 2 * FF, DM, 3, (size_t)2 * FF * DM * 2}; pg8::StaticOrder S; S.init(NROWS_E, 2 * FF, F.G, (int)blockIdx.x);
                pg8::EpiSwiglu E{(pg8::bf16_t*)(ws + WS_ACT)};
                pg8::gemm_phase<pg8::EpiSwiglu, pg8::StaticOrder, true, true>(F.lds + RING_OFF, g, S, E, F.tid);
            } else if (k == 8) {
                pg8::Gemm g{(const pg8::bf16_t*)(ws + WS_ACT), (const pg8::bf16_t*)(ws + WS_WDN) + (size_t)layer * NE * DM * FF, NROWS_E, DM, FF, 3, (size_t)DM * FF * 2}; pg8::StaticOrder S; S.init(NROWS_E, DM, F.G, (int)blockIdx.x);
                pg8::EpiDown E{(const float*)(ws + WS_GW), (pg8::bf16_t*)(ws + WS_Y)};
                pg8::gemm_phase<pg8::EpiDown, pg8::StaticOrder, true, true>(F.lds + RING_OFF, g, S, E, F.tid);
            } else phase_combine_norm(F, args, layer);
        }
        if (ph + 1 < args.ph_hi) xcd_barrier(bar);
    }
}

__global__ void __launch_bounds__(64) k_attn_naive(const bf16* __restrict__ proj, bf16* __restrict__ atto, float* __restrict__ lse) {
    const int gid = blockIdx.x * 64 + threadIdx.x;
    const int h = gid & 7, t = (gid >> 3) % T, g = gid / (8 * T);
    const int d = (g == 0) ? 1 : (g == 1 ? 4 : 16);
    const int b = t / SEQ, s = t % SEQ;
    const float slope = exp2f(-(float)(h + 1));
    const bf16* qp = proj + (size_t)t * NIN + g * 1536 + h * 64;
    float q[64], o[64];
#pragma unroll
    for (int i = 0; i < 64; ++i) { q[i] = bf2f(qp[i]) * 0.125f; o[i] = 0.f; }
    float mx = -INFINITY, den = 0.f;
    for (int j = -64; j <= 64; ++j) {
        const int sk = s + j * d; if (sk < 0 || sk >= SEQ) continue;
        const bf16* kp = proj + (size_t)(b * SEQ + sk) * NIN + g * 1536 + 512 + h * 64; const bf16* vp = kp + 512;
        float sc = 0.f;
#pragma unroll
        for (int i = 0; i < 64; i += 8) { const u32x4 kv = *(const u32x4*)(kp + i);
            sc += q[i] * __builtin_bit_cast(float, kv.x << 16) + q[i + 1] * __builtin_bit_cast(float, kv.x & 0xffff0000u) + q[i + 2] * __builtin_bit_cast(float, kv.y << 16) + q[i + 3] * __builtin_bit_cast(float, kv.y & 0xffff0000u)
                + q[i + 4] * __builtin_bit_cast(float, kv.z << 16) + q[i + 5] * __builtin_bit_cast(float, kv.z & 0xffff0000u) + q[i + 6] * __builtin_bit_cast(float, kv.w << 16) + q[i + 7] * __builtin_bit_cast(float, kv.w & 0xffff0000u); }
        sc -= slope * (float)(d * (j < 0 ? -j : j));
        const float mn = fmaxf(mx, sc), f = __expf(mx - mn), p = __expf(sc - mn);
        den = den * f + p; mx = mn;
#pragma unroll
        for (int i = 0; i < 64; i += 8) { const u32x4 vv = *(const u32x4*)(vp + i);
            o[i] = o[i] * f + p * __builtin_bit_cast(float, vv.x << 16); o[i + 1] = o[i + 1] * f + p * __builtin_bit_cast(float, vv.x & 0xffff0000u);
            o[i + 2] = o[i + 2] * f + p * __builtin_bit_cast(float, vv.y << 16); o[i + 3] = o[i + 3] * f + p * __builtin_bit_cast(float, vv.y & 0xffff0000u);
            o[i + 4] = o[i + 4] * f + p * __builtin_bit_cast(float, vv.z << 16); o[i + 5] = o[i + 5] * f + p * __builtin_bit_cast(float, vv.z & 0xffff0000u);
            o[i + 6] = o[i + 6] * f + p * __builtin_bit_cast(float, vv.w << 16); o[i + 7] = o[i + 7] * f + p * __builtin_bit_cast(float, vv.w & 0xffff0000u); }
    }
    const float inv = 1.f / den;
    bf16* op = atto + ((size_t)g * T + t) * AW + h * 64;
#pragma unroll
    for (int i = 0; i < 64; i += 2) *(unsigned*)(op + i) = f2bf(o[i] * inv) | (f2bf(o[i + 1] * inv) << 16);
    lse[((size_t)g * T + t) * 8 + h] = mx + __logf(den);
}

__global__ void __launch_bounds__(256) k_ret_naive(const bf16* __restrict__ proj, const float* __restrict__ decay_logit  , bf16* __restrict__ yf, bf16* __restrict__ yb) {
    __shared__ float qs[16][257];
    __shared__ float ks[32][257];
    __shared__ float sc[16][33];
    const int tid = threadIdx.x, nt = blockIdx.x & 127, h = (blockIdx.x >> 7) & 3, b = blockIdx.x >> 9;
    const int n0 = nt * 16;
    const float lgf = -log1pf(expf(-decay_logit[h])), lgb = -log1pf(expf(-decay_logit[4 + h]));
    for (int i = 0; i < 16; ++i) qs[i][tid] = bf2f(proj[(size_t)(b * SEQ + n0 + i) * NIN + OFF_RQ + h * 256 + tid]) * 0.0625f;
    float acc[16];
#pragma unroll
    for (int i = 0; i < 16; ++i) acc[i] = 0.f;
    for (int m0 = 0; m0 < SEQ; m0 += 32) {
        __syncthreads();
        for (int i = 0; i < 32; ++i) ks[i][tid] = bf2f(proj[(size_t)(b * SEQ + m0 + i) * NIN + OFF_RK + h * 256 + tid]);
        __syncthreads();
        for (int e = tid; e < 512; e += 256) { const int n = e >> 5, m = e & 31; float s = 0.f;
            for (int k = 0; k < 256; ++k) s += qs[n][k] * ks[m][k];
            const int gn = n0 + n, gm = m0 + m; const float dec = (gm <= gn) ? __expf(lgf * (float)(gn - gm)) : __expf(lgb * (float)(gm - gn));
            sc[n][m] = s * dec; }
        __syncthreads();
        for (int m = 0; m < 32; ++m) { const float v = bf2f(proj[(size_t)(b * SEQ + m0 + m) * NIN + OFF_RV + h * 256 + tid]);
#pragma unroll
            for (int n = 0; n < 16; ++n) acc[n] += sc[n][m] * v; }
    }
#pragma unroll
    for (int n = 0; n < 16; ++n) { const size_t o = (size_t)(b * SEQ + n0 + n) * RW + h * 256 + tid; yf[o] = (bf16)f2bf(acc[n]); yb[o] = 0; }
}


extern "C" void kernel_launch(void* const* d_in, const int* in_sizes, int n_in, void* d_out, int out_size, void* d_ws, size_t ws_size, hipStream_t stream) {
    static int grid = 0;
    if (grid == 0) {
        if (n_in != 13 || in_sizes[0] != T * DM || out_size != T * DM || ws_size < WS_END) { fprintf(stderr, "kernel_launch: unexpected shapes (n_in %d, ws %zu)\n", n_in, ws_size); grid = -1; return; }
        if (hipFuncSetAttribute((const void*)mega, hipFuncAttributeMaxDynamicSharedMemorySize, LDS_BYTES) != hipSuccess) { fprintf(stderr, "kernel_launch: hipFuncSetAttribute failed\n"); grid = -1; return; }
        int dev = 0, cus = 0, per_cu = 0;
        hipGetDevice(&dev); hipDeviceGetAttribute(&cus, hipDeviceAttributeMultiprocessorCount, dev);
        hipOccupancyMaxActiveBlocksPerMultiprocessor(&per_cu, (const void*)mega, NWAVES * 64, LDS_BYTES);
        if (per_cu < 1) { fprintf(stderr, "kernel_launch: occupancy query says %d blocks per CU\n", per_cu); }
        (void)hipGetLastError();
        grid = cus;
    }
    if (grid < 0) return;
    unsigned char* ws = (unsigned char*)d_ws;
    hipMemsetAsync(ws + WS_CTL, 0, CTL_ZERO_BYTES, stream);
    Args a{};
    for (int i = 0; i < 13; ++i) a.in[i] = (const float*)d_in[i];
    a.out = (float*)d_out; a.ws = ws;
    const bf16* PROJ = (const bf16*)(ws + WS_PROJ);
    auto run = [&](int lo, int hi) { a.ph_lo = lo; a.ph_hi = hi; hipLaunchKernelGGL(mega, dim3(grid), dim3(NWAVES * 64), LDS_BYTES, stream, a); };
    run(0, 1);
    for (int l = 0; l < DEPTH; ++l) {
        const int p = 1 + l * NPH_LAYER;
        run(p + 0, p + 1);
        hipLaunchKernelGGL(k_attn_naive, dim3(3 * T * 8 / 64), dim3(64), 0, stream, PROJ, (bf16*)(ws + WS_ATTO), (float*)(ws + WS_LSE));
        hipLaunchKernelGGL(k_ret_naive, dim3(NB * 4 * 128), dim3(256), 0, stream, PROJ, (const float*)d_in[5] + l * 8, (bf16*)(ws + WS_YF), (bf16*)(ws + WS_YB));
        for (int k = 2; k < NPH_LAYER; ++k) run(p + k, p + k + 1);
    }
}
```

```cpp
#include <hip/hip_runtime.h>
#include <hip/hip_cooperative_groups.h>
#include <cstdio>
#include <cstdint>

constexpr int NB = 8, SEQ = 2048, DM = 1024, T = NB * SEQ, DEPTH = 2;
constexpr int NIN = 10752, ATTN_IN = 4608, AW = 512, RW = 1024, CATW = AW + RW;
constexpr int OFF_RQ = 4608, OFF_RK = 5632, OFF_RV = 6656, OFF_RG = 7680, OFF_GA = 8704, OFF_GR = 9728;
constexpr int NE = 16, FF = 2048, CAP = 256, NROWS_E = NB * NE * CAP;
constexpr float EPS = 1e-6f;

constexpr size_t PO_ATT = 0, PO_RQK = (size_t)9 * T * AW, PO_RV = PO_RQK + (size_t)2 * T * RW, PO_RG = PO_RV + (size_t)T * RW, PO_GATE = PO_RG + (size_t)T * RW, PO_END = PO_GATE + (size_t)2 * T * DM;
static_assert(PO_END == (size_t)T * NIN, "split projection layout covers the PROJ region exactly");
struct ProjCol { size_t base; unsigned bstride, pitch; int dsh; };
__host__ __device__ __forceinline__ ProjCol proj_col(int c) {
    ProjCol p;
    if (c < 4608) { const int g = c / 1536, r = c - g * 1536, which = r >> 9, h = (r >> 6) & 7, dc = r & 63; p.base = PO_ATT + (((size_t)(g * 3 + which) * 64 + h) * 2048) * 64 + dc; p.bstride = 8u * 2048u * 64u; p.pitch = 64; p.dsh = 2 * g; }
    else if (c < 6656) { const int r = c - 4608, which = r >> 10, h = (r >> 8) & 3, dk = r & 255; p.base = PO_RQK + (((size_t)which * 32 + h) * 2048) * 256 + dk; p.bstride = 4u * 2048u * 256u; p.pitch = 256; p.dsh = 0; }
    else if (c < 7680) { const int r = c - 6656, h = r >> 8, dvs = (r >> 6) & 3, dv = r & 63; p.base = PO_RV + (((size_t)h * 4 + dvs) * 2048) * 64 + dv; p.bstride = 16u * 2048u * 64u; p.pitch = 64; p.dsh = 0; }
    else if (c < 8704) { p.base = PO_RG + (c - 7680); p.bstride = 2048u * 1024u; p.pitch = 1024; p.dsh = 0; }
    else { p.base = PO_GATE + (c - 8704); p.bstride = 2048u * 2048u; p.pitch = 2048; p.dsh = 0; }
    return p;
}
__host__ __device__ __forceinline__ size_t proj_row(const ProjCol& p, int t) {
    const unsigned b = (unsigned)t >> 11, s = (unsigned)t & 2047u, sp = ((s & ((1u << p.dsh) - 1u)) << (11 - p.dsh)) | (s >> p.dsh);
    return p.base + (size_t)b * p.bstride + (size_t)sp * p.pitch;
}
__host__ __device__ __forceinline__ size_t proj_off(int t, int c) {
    const int b = t >> 11, s = t & 2047;
    if (c < 4608) { const int g = c / 1536, r = c - g * 1536, which = r >> 9, h = (r >> 6) & 7, dc = r & 63, dsh = 2 * g;
        const int perm = ((s & ((1 << dsh) - 1)) << (11 - dsh)) | (s >> dsh);
        return PO_ATT + ((((size_t)(g * 3 + which) * 8 + b) * 8 + h) * 2048 + perm) * 64 + dc; }
    if (c < 6656) { const int r = c - 4608, which = r >> 10, h = (r >> 8) & 3, dk = r & 255; return PO_RQK + ((((size_t)which * 8 + b) * 4 + h) * 2048 + s) * 256 + dk; }
    if (c < 7680) { const int r = c - 6656, h = r >> 8, dvs = (r >> 6) & 3, dv = r & 63; return PO_RV + ((((size_t)b * 4 + h) * 4 + dvs) * 2048 + s) * 64 + dv; }
    if (c < 8704) return PO_RG + (size_t)t * 1024 + (c - 7680);
    return PO_GATE + (size_t)t * 2048 + (c - 8704);
}

constexpr size_t MiB = 1u << 20;
constexpr size_t WS_CTL = 0;
constexpr size_t WS_WIN = 1 * MiB;
constexpr size_t WS_WCAT = WS_WIN + 42 * MiB;
constexpr size_t WS_WO  = WS_WCAT + 6 * MiB;
constexpr size_t WS_WGU = WS_WO + 4 * MiB;
constexpr size_t WS_WDN = WS_WGU + 256 * MiB;
constexpr size_t WS_XB  = WS_WDN + 64 * MiB;
constexpr size_t WS_H   = WS_WDN + 128 * MiB;
constexpr size_t WS_PROJ = WS_H + 32 * MiB;
constexpr size_t WS_XIN = WS_PROJ;
constexpr size_t WS_ACT = WS_PROJ + 64 * MiB;
constexpr size_t WS_Y   = WS_PROJ + 192 * MiB;
constexpr size_t WS_ATTO = WS_PROJ + 336 * MiB;
constexpr size_t WS_LSE = WS_ATTO + 48 * MiB;
constexpr size_t WS_YF  = WS_LSE + 2 * MiB;
constexpr size_t WS_MERGED = WS_YF;
constexpr size_t WS_YB  = WS_YF + 32 * MiB;
constexpr size_t WS_CAT = WS_YB + 32 * MiB;
constexpr size_t WS_AFF = WS_CAT + 48 * MiB;
constexpr size_t WS_IDX = WS_AFF + 1 * MiB;
constexpr size_t WS_GW  = WS_IDX + 256 * 1024;
constexpr size_t WS_SLOT = WS_GW + 256 * 1024;
constexpr size_t WS_SC  = WS_SLOT + 1 * MiB;
constexpr size_t WS_WINS = WS_SC, WS_WGUS = WS_SC + 128 * 1024, WS_HS = WS_SC + 640 * 1024, WS_XS = WS_SC + 704 * 1024;
constexpr size_t WS_END = WS_SC + 1 * MiB;
constexpr size_t WS_WMAX = 64 * 1024;
constexpr int WMAX_IN = 0, WMAX_G = DEPTH * NIN, WMAX_U = WMAX_G + DEPTH * NE * FF, NWMAX = WMAX_U + DEPTH * NE * FF;
static_assert(WS_WMAX + (size_t)NWMAX * 4 <= 1 * MiB, "WMAX inside the CTL MiB");
static_assert(WS_END <= 1024 * MiB, "workspace map");

#define GAS __attribute__((address_space(1)))
#define LAS __attribute__((address_space(3)))
typedef unsigned short bf16;
typedef unsigned v4u __attribute__((ext_vector_type(4)));
typedef float f32x4 __attribute__((ext_vector_type(4)));
typedef short bf16x8 __attribute__((ext_vector_type(8)));
typedef GAS unsigned gu32;
typedef GAS unsigned long long gu64;
#define RLX_AGENT __ATOMIC_RELAXED, __HIP_MEMORY_SCOPE_AGENT
#define LDS_WAIT() asm volatile("s_waitcnt lgkmcnt(0)" ::: "memory")
#define VM_WAIT() asm volatile("s_waitcnt vmcnt(0)" ::: "memory")
__device__ __forceinline__ unsigned long long rt() { return __builtin_amdgcn_s_memrealtime(); }
__device__ __forceinline__ unsigned f2bf(float f) { unsigned u = __builtin_bit_cast(unsigned, f); return (u + 0x7fffu + ((u >> 16) & 1u)) >> 16; }
typedef float f32x2_t __attribute__((ext_vector_type(2))); typedef __bf16 bf16x2_t __attribute__((ext_vector_type(2)));
__device__ __forceinline__ unsigned pk2(float lo, float hi) { const f32x2_t v = {lo, hi}; return __builtin_bit_cast(unsigned, __builtin_convertvector(v, bf16x2_t)); }

__device__ __forceinline__ float fp8_lim() { float l = 448.f; asm volatile("" : "+v"(l)); return l; }
__device__ __forceinline__ unsigned fp8x4(float a, float b, float c, float d, float lim) { int p = 0; p = __builtin_amdgcn_cvt_pk_fp8_f32(__builtin_amdgcn_fmed3f(a, -lim, lim), __builtin_amdgcn_fmed3f(b, -lim, lim), p, false); p = __builtin_amdgcn_cvt_pk_fp8_f32(__builtin_amdgcn_fmed3f(c, -lim, lim), __builtin_amdgcn_fmed3f(d, -lim, lim), p, true); return (unsigned)p; }

#define XB_TMO      128
#define XB_XCNT(j)  (256  + 64 * (j))
#define XB_XSUB(j)  (1280 + 64 * (j))
#define XB_XGEN(j)  (2304 + 64 * (j))
#define XB_TOP      3328
#define XB_TOPGEN   3392
#define XCD_BAR_WORDS 3456
#define XB_SPIN_CAP (1u << 18)

__device__ __forceinline__ unsigned xb_ld(unsigned* p)              { return __hip_atomic_load(p, __ATOMIC_RELAXED, __HIP_MEMORY_SCOPE_AGENT); }
__device__ __forceinline__ unsigned xb_add(unsigned* p, unsigned v) { return __hip_atomic_fetch_add(p, v, __ATOMIC_RELAXED, __HIP_MEMORY_SCOPE_AGENT); }
__device__ __forceinline__ unsigned xb_xcc_id() { return (unsigned)__builtin_amdgcn_s_getreg((3 << 11) | 20) & 0xFu; }
#define XB_SPIN(cond, bar) do { unsigned _sp = 0; while (cond) { __builtin_amdgcn_s_sleep(1); \
    if ((++_sp & 255u) == 0u) { if (xb_ld(&(bar)[XB_TMO])) break; if (_sp > XB_SPIN_CAP) { atomicAdd(&(bar)[XB_TMO], 1u); break; } } } } while (0)

struct XcdBarrier {
    unsigned* bar; unsigned x;
    volatile LAS unsigned* st;
};

__device__ __forceinline__ XcdBarrier xcd_barrier_post(unsigned* bar, volatile LAS unsigned* st) {
    XcdBarrier b; b.bar = bar; b.x = xb_xcc_id(); b.st = st;
    if (threadIdx.x == 0) (void)xb_add(&bar[XB_XCNT(b.x)], 1u);
    return b;
}
__device__ __forceinline__ void xcd_barrier_complete(unsigned* bar, unsigned x, unsigned& nloc, unsigned& nx) {
    const unsigned G = gridDim.x * gridDim.y * gridDim.z;
    unsigned sum, cnt, mine, sp = 0u;
    for (;;) {
        sum = 0u; cnt = 0u; mine = 0u;
#pragma unroll
        for (unsigned j = 0; j < 16; ++j) { const unsigned c = xb_ld(&bar[XB_XCNT(j)]); sum += c; cnt += (c > 0u) ? 1u : 0u; mine = (j == x) ? c : mine; }
        if (sum == G) break;
        __builtin_amdgcn_s_sleep(1);
        if ((++sp & 255u) == 0u) { if (xb_ld(&bar[XB_TMO])) break; if (sp > XB_SPIN_CAP) { atomicAdd(&bar[XB_TMO], 1u); break; } }
    }
    nloc = mine > 0u ? mine : 1u; nx = cnt > 0u ? cnt : 1u;
}

__device__ __forceinline__ void xcd_barrier(const XcdBarrier& b) {
    asm volatile("s_waitcnt vmcnt(0)" ::: "memory");
    __syncthreads();
    if (threadIdx.x == 0) {
        unsigned* bar = b.bar;
        __builtin_amdgcn_s_waitcnt(0);
        unsigned nloc = b.st[0], nx = b.st[1];
        if (nloc == 0u) { xcd_barrier_complete(bar, b.x, nloc, nx); b.st[0] = nloc; b.st[1] = nx; }
        const unsigned old = xb_add(&bar[XB_XSUB(b.x)], 1u);
        const unsigned gen = old / nloc;
        if (old + 1u == (gen + 1u) * nloc) {
            __builtin_amdgcn_fence(__ATOMIC_RELEASE, "agent");
            asm volatile("s_waitcnt vmcnt(0)" ::: "memory");
            const unsigned og = xb_add(&bar[XB_TOP], 1u);
            const unsigned tg = og / nx;
            if (og + 1u == (tg + 1u) * nx) xb_add(&bar[XB_TOPGEN], 1u);
            else XB_SPIN(xb_ld(&bar[XB_TOPGEN]) == tg, bar);
            __builtin_amdgcn_fence(__ATOMIC_ACQUIRE, "agent");
            xb_add(&bar[XB_XGEN(b.x)], 1u);
            asm volatile("s_waitcnt vmcnt(0)" ::: "memory");
        } else {
            XB_SPIN(xb_ld(&bar[XB_XGEN(b.x)]) == gen, bar);
            __builtin_amdgcn_fence(__ATOMIC_ACQUIRE, "agent");
            asm volatile("s_waitcnt vmcnt(0)" ::: "memory");
        }
    }
    __syncthreads();
}


#define CW_LBAR 8192
__device__ __forceinline__ void xcc_local_barrier(unsigned* ctl, const unsigned x, const unsigned nloc, unsigned* tmo_bar) {
    asm volatile("s_waitcnt vmcnt(0)" ::: "memory");
    __syncthreads();
    if (threadIdx.x == 0) {
        unsigned* w = ctl + CW_LBAR + 64 * x;
        const unsigned old = xb_add(w, 1u); const unsigned target = (old / nloc + 1u) * nloc;
        XB_SPIN(xb_ld(w) < target, tmo_bar);
        __builtin_amdgcn_fence(__ATOMIC_ACQUIRE, "agent");
        asm volatile("s_waitcnt vmcnt(0)" ::: "memory");
    }
    __syncthreads();
}

typedef unsigned u32x2 __attribute__((ext_vector_type(2)));
typedef unsigned u32x4 __attribute__((ext_vector_type(4)));
__device__ __forceinline__ float bf2f(unsigned short h) { return __builtin_bit_cast(float, (unsigned)h << 16); }
__device__ __forceinline__ float sigmoidf_(float v) { return 1.f / (1.f + __expf(-v)); }
__device__ __forceinline__ float siluf_(float v) { return v / (1.f + __expf(-v)); }
namespace pg8 {
#define PG8_LAS __attribute__((address_space(3)))
typedef unsigned short bf16_t;
typedef short bf16x8 __attribute__((ext_vector_type(8)));
typedef float f32x4 __attribute__((ext_vector_type(4)));
typedef unsigned u32x4 __attribute__((ext_vector_type(4)));
constexpr int BM = 256, BK = 64, HALF = 128, HTB = HALF * BK * 2  , STAGE_BYTES = 8 * HTB, NXCD = 8, WGM = 8;

__host__ __device__ __forceinline__ int lds_byte(int r, int c) { const int st = r >> 3, rr = r & 7, ch = c >> 3; return st * 1024 + rr * 128 + ((ch ^ rr) << 4) + (c & 7) * 2; }
__host__ __device__ __forceinline__ void stage_rc(int b, int& R, int& C) { const int st = b / 1024, sb = b % 1024, rr = sb >> 7, slot = (sb >> 4) & 7; R = st * 8 + rr; C = ((slot ^ rr) << 3) + ((sb & 15) >> 1); }
__host__ __device__ __forceinline__ int perm32(int rho) { const int n = rho >> 4, i = rho & 15; return 8 * (i >> 2) + 4 * n + (i & 3); }

struct Unit { int pm, pn; };
struct Gemm { const bf16_t* A; const bf16_t* Bt; int M, N, K; int gshift; size_t gstrideB; };

struct StaticOrder {
    int nM, nN, nwg, G, c;
    __host__ __device__ void init(int M, int N, int G_, int c_) { nM = M / BM; nN = N / BM; nwg = nM * nN; G = G_; c = c_; }
    __host__ __device__ bool next(int i, Unit& u) const {
        const long L = (long)i * G + c; if (L >= nwg) return false;
        int wgid = (int)L; { const int q = nwg / NXCD, r = nwg % NXCD, xcd = wgid % NXCD, off = wgid / NXCD; wgid = (xcd < r ? xcd * (q + 1) : r * (q + 1) + (xcd - r) * q) + off; }
        const int nig = WGM * nN, gid = wgid / nig, fm = gid * WGM, gsz = (nM - fm) < WGM ? (nM - fm) : WGM;
        u.pm = fm + ((wgid % nig) % gsz); u.pn = (wgid % nig) / gsz; return true;
    }
    __device__ __forceinline__ void a_ready(const Unit&) const {}
    __device__ __forceinline__ void done(const Unit&) const {}
};

__device__ __forceinline__ unsigned cvt_pk_bf16(float lo, float hi) { unsigned r; asm volatile("v_cvt_pk_bf16_f32 %0, %1, %2" : "=v"(r) : "v"(lo), "v"(hi)); return r; }
typedef float f32x2 __attribute__((ext_vector_type(2)));
typedef unsigned u32x2 __attribute__((ext_vector_type(2)));
constexpr int P_NIN = 10752, P_OFF_GA = 8704, P_OFF_GR = 9728, P_FF = 2048;
__device__ __forceinline__ float bflo(unsigned w) { return __builtin_bit_cast(float, w << 16); }
__device__ __forceinline__ float bfhi(unsigned w) { return __builtin_bit_cast(float, w & 0xffff0000u); }
__device__ __forceinline__ float fsig(float v) { return __builtin_amdgcn_rcpf(1.f + __expf(-v)); }
struct EpiStore {
    static constexpr bool PERM = true, AFTER_DRAIN = false; static constexpr int MID_T = 0;
    bf16_t* O; int ldc;
    __device__ __forceinline__ void operator()(const f32x4 (&acc)[2][2][4][2], const Unit& u, int wr, int wc, int fr, int fq) const {
        int row0 = u.pm * BM + wr * 64 + fr, col0 = u.pn * BM + wc * 64 + 8 * fq; asm volatile("" : "+v"(row0));
#pragma unroll
        for (int ai = 0; ai < 2; ++ai)
#pragma unroll
            for (int m = 0; m < 4; ++m) { bf16_t* rowp = O + (size_t)(row0 + ai * HALF + m * 16) * ldc + col0;
#pragma unroll
                for (int bj = 0; bj < 2; ++bj) { const f32x4 v0 = acc[ai][bj][m][0], v1 = acc[ai][bj][m][1];
                    u32x4 w; w.x = cvt_pk_bf16(v0[0], v0[1]); w.y = cvt_pk_bf16(v0[2], v0[3]); w.z = cvt_pk_bf16(v1[0], v1[1]); w.w = cvt_pk_bf16(v1[2], v1[3]);
                    *(u32x4*)(rowp + bj * 32) = w; } }
    }
};
struct EpiMerge {
    static constexpr bool PERM = true, AFTER_DRAIN = false; static constexpr int MID_T = 4;
    const bf16_t* proj; bf16_t* O; float post;
    __device__ __forceinline__ void mid(f32x4 (&acc)[2][2][4][2], const Unit& u, int wr, int wc, int fr, int fq) const {
        int row0 = u.pm * BM + wr * 64 + fr, col0 = u.pn * BM + wc * 64 + 8 * fq; asm volatile("" : "+v"(row0));
#pragma unroll
        for (int ai = 0; ai < 2; ++ai) { u32x4 ga[4][2], gr[4][2];
#pragma unroll
            for (int m = 0; m < 4; ++m) { const bf16_t* pr = proj + PO_GATE + (size_t)(row0 + ai * HALF + m * 16) * 2048 + col0;
#pragma unroll
                for (int bj = 0; bj < 2; ++bj) { ga[m][bj] = *(const u32x4*)(pr + bj * 32); gr[m][bj] = *(const u32x4*)(pr + 1024 + bj * 32); } }
#pragma unroll
            for (int m = 0; m < 4; ++m)
#pragma unroll
                for (int bj = 0; bj < 2; ++bj) { const u32x4 a = ga[m][bj], r = gr[m][bj]; f32x4 r0, r1;
                    r0[0] = (1.f + __expf(-bflo(r.x))) * __builtin_amdgcn_rcpf(1.f + __expf(-bflo(a.x))); r0[1] = (1.f + __expf(-bfhi(r.x))) * __builtin_amdgcn_rcpf(1.f + __expf(-bfhi(a.x)));
                    r0[2] = (1.f + __expf(-bflo(r.y))) * __builtin_amdgcn_rcpf(1.f + __expf(-bflo(a.y))); r0[3] = (1.f + __expf(-bfhi(r.y))) * __builtin_amdgcn_rcpf(1.f + __expf(-bfhi(a.y)));
                    r1[0] = (1.f + __expf(-bflo(r.z))) * __builtin_amdgcn_rcpf(1.f + __expf(-bflo(a.z))); r1[1] = (1.f + __expf(-bfhi(r.z))) * __builtin_amdgcn_rcpf(1.f + __expf(-bfhi(a.z)));
                    r1[2] = (1.f + __expf(-bflo(r.w))) * __builtin_amdgcn_rcpf(1.f + __expf(-bflo(a.w))); r1[3] = (1.f + __expf(-bfhi(r.w))) * __builtin_amdgcn_rcpf(1.f + __expf(-bfhi(a.w)));
                    acc[ai][bj][m][0] *= r0; acc[ai][bj][m][1] *= r1; } }
    }
    __device__ __forceinline__ void operator()(const f32x4 (&acc)[2][2][4][2], const Unit& u, int wr, int wc, int fr, int fq) const {
        int row0 = u.pm * BM + wr * 64 + fr, col0 = u.pn * BM + wc * 64 + 8 * fq; asm volatile("" : "+v"(row0));
#pragma unroll
        for (int ai = 0; ai < 2; ++ai) { u32x4 gr[4][2];
#pragma unroll
            for (int m = 0; m < 4; ++m)
#pragma unroll
                for (int bj = 0; bj < 2; ++bj) gr[m][bj] = *(const u32x4*)(proj + PO_GATE + (size_t)(row0 + ai * HALF + m * 16) * 2048 + 1024 + col0 + bj * 32);
#pragma unroll
            for (int m = 0; m < 4; ++m) { bf16_t* rowp = O + (size_t)(row0 + ai * HALF + m * 16) * 1024 + col0;
#pragma unroll
                for (int bj = 0; bj < 2; ++bj) { const u32x4 g = gr[m][bj]; const f32x4 v0 = acc[ai][bj][m][0] * post, v1 = acc[ai][bj][m][1] * post;
                    u32x4 w; w.x = cvt_pk_bf16(v0[0] * fsig(bflo(g.x)), v0[1] * fsig(bfhi(g.x))); w.y = cvt_pk_bf16(v0[2] * fsig(bflo(g.y)), v0[3] * fsig(bfhi(g.y)));
                    w.z = cvt_pk_bf16(v1[0] * fsig(bflo(g.z)), v1[1] * fsig(bfhi(g.z))); w.w = cvt_pk_bf16(v1[2] * fsig(bflo(g.w)), v1[3] * fsig(bfhi(g.w)));
                    *(u32x4*)(rowp + bj * 32) = w; } } }
    }
};
__device__ __forceinline__ float i2f(float bits) { return (float)__builtin_bit_cast(int, bits); }
struct EpiStoreI8 {
    static constexpr bool PERM = true, AFTER_DRAIN = false; static constexpr int MID_T = 0;
    bf16_t* O; int ldc; const float* rs; const float* cs;
    __device__ __forceinline__ void operator()(const f32x4 (&acc)[2][2][4][2], const Unit& u, int wr, int wc, int fr, int fq) const {
        int row0 = u.pm * BM + wr * 64 + fr, col0 = u.pn * BM + wc * 64 + 8 * fq; asm volatile("" : "+v"(row0), "+v"(col0));
        const bool odd = fr & 1; const int rowe = row0 & ~1;
        f32x4 c[2][2];
#pragma unroll
        for (int bj = 0; bj < 2; ++bj) { c[bj][0] = *(const f32x4*)(cs + col0 + bj * 32); c[bj][1] = *(const f32x4*)(cs + col0 + bj * 32 + 4); }
        const ProjCol pc = proj_col(col0 + (odd ? 32 : 0));
        bf16_t* const base0 = O + proj_row(pc, rowe); bf16_t* const base1 = O + proj_row(pc, rowe + 1); const unsigned step = (16u * pc.pitch) >> pc.dsh;
        float srv[8];
#pragma unroll
        for (int i = 0; i < 8; ++i) srv[i] = rs[row0 + (i >> 2) * HALF + (i & 3) * 16];
#pragma unroll
        for (int ai = 0; ai < 2; ++ai)
#pragma unroll
            for (int m = 0; m < 4; ++m) { const float sr = srv[ai * 4 + m]; u32x4 w[2];
#pragma unroll
                for (int bj = 0; bj < 2; ++bj) { const f32x4 a0 = acc[ai][bj][m][0], a1 = acc[ai][bj][m][1];
                    const f32x4 v0 = (f32x4){i2f(a0[0]), i2f(a0[1]), i2f(a0[2]), i2f(a0[3])} * (c[bj][0] * sr), v1 = (f32x4){i2f(a1[0]), i2f(a1[1]), i2f(a1[2]), i2f(a1[3])} * (c[bj][1] * sr);
                    w[bj].x = cvt_pk_bf16(v0[0], v0[1]); w[bj].y = cvt_pk_bf16(v0[2], v0[3]); w[bj].z = cvt_pk_bf16(v1[0], v1[1]); w[bj].w = cvt_pk_bf16(v1[2], v1[3]); }
                u32x4 snd, rcv;
                snd.x = odd ? w[0].x : w[1].x; snd.y = odd ? w[0].y : w[1].y; snd.z = odd ? w[0].z : w[1].z; snd.w = odd ? w[0].w : w[1].w;
                rcv.x = (unsigned)__builtin_amdgcn_mov_dpp((int)snd.x, 0xB1, 0xF, 0xF, true); rcv.y = (unsigned)__builtin_amdgcn_mov_dpp((int)snd.y, 0xB1, 0xF, 0xF, true);
                rcv.z = (unsigned)__builtin_amdgcn_mov_dpp((int)snd.z, 0xB1, 0xF, 0xF, true); rcv.w = (unsigned)__builtin_amdgcn_mov_dpp((int)snd.w, 0xB1, 0xF, 0xF, true);
                u32x4 s0, s1;
                s0.x = odd ? rcv.x : w[0].x; s0.y = odd ? rcv.y : w[0].y; s0.z = odd ? rcv.z : w[0].z; s0.w = odd ? rcv.w : w[0].w;
                s1.x = odd ? w[1].x : rcv.x; s1.y = odd ? w[1].y : rcv.y; s1.z = odd ? w[1].z : rcv.z; s1.w = odd ? w[1].w : rcv.w;
                const size_t o = (size_t)((ai * 8 + m) * step);
                *(u32x4*)(base0 + o) = s0; *(u32x4*)(base1 + o) = s1; }
    }
};
struct EpiSwigluI8 {
    static constexpr bool PERM = false, AFTER_DRAIN = false; static constexpr int MID_T = 0;
    bf16_t* O; const float* rs; const float* cs; int fp8;
    __device__ __forceinline__ void operator()(const f32x4 (&acc)[2][2][4][2], const Unit& u, int wr, int wc, int fr, int fq) const {
        int row0 = u.pm * BM + wr * 64 + fr, f0 = u.pn * (BM / 2) + wc * 32 + 8 * fq; asm volatile("" : "+v"(row0));
        int cofs = u.pn * BM + wc * 32 + 4 * fq; asm volatile("" : "+v"(cofs));
        const float* csp = cs + (size_t)(u.pm >> 3) * (2 * P_FF) + cofs;
        f32x4 cg[2], cu[2];
#pragma unroll
        for (int bj = 0; bj < 2; ++bj) { cg[bj] = *(const f32x4*)(csp + bj * HALF); cu[bj] = *(const f32x4*)(csp + bj * HALF + 16); }
        float srv[8];
#pragma unroll
        for (int i = 0; i < 8; ++i) srv[i] = rs[row0 + (i >> 2) * HALF + (i & 3) * 16];
#pragma unroll
        for (int ai = 0; ai < 2; ++ai)
#pragma unroll
            for (int m = 0; m < 4; ++m) { const size_t r = (size_t)(row0 + ai * HALF + m * 16); const float sr = srv[ai * 4 + m];
                float ov[8];
#pragma unroll
                for (int bj = 0; bj < 2; ++bj) { const f32x4 ga = acc[ai][bj][m][0], ua = acc[ai][bj][m][1];
#pragma unroll
                    for (int i = 0; i < 4; ++i) { const float a = i2f(ga[i]) * (cg[bj][i] * sr), b = i2f(ua[i]) * (cu[bj][i] * sr); ov[4 * bj + i] = a * fsig(a) * b; } }
                if (fp8) { const float lim = fp8_lim(); u32x2 w; w.x = fp8x4(ov[0] * 16.f, ov[1] * 16.f, ov[2] * 16.f, ov[3] * 16.f, lim); w.y = fp8x4(ov[4] * 16.f, ov[5] * 16.f, ov[6] * 16.f, ov[7] * 16.f, lim);
                    *(u32x2*)((unsigned char*)O + r * P_FF + f0) = w; }
                else { u32x4 w; w.x = cvt_pk_bf16(ov[0], ov[1]); w.y = cvt_pk_bf16(ov[2], ov[3]); w.z = cvt_pk_bf16(ov[4], ov[5]); w.w = cvt_pk_bf16(ov[6], ov[7]);
                    *(u32x4*)(O + r * P_FF + f0) = w; } }
    }
};

template <bool SRCF32> struct EpiResidB {
    static constexpr bool PERM = true, AFTER_DRAIN = false; static constexpr int MID_T = 0;
    const void* src; bf16_t* out; float post;
    __device__ __forceinline__ void operator()(const f32x4 (&acc)[2][2][4][2], const Unit& u, int wr, int wc, int fr, int fq) const {
        int row0 = u.pm * BM + wr * 64 + fr, col0 = u.pn * BM + wc * 64 + 8 * fq; asm volatile("" : "+v"(row0));
#pragma unroll
        for (int ai = 0; ai < 2; ++ai)
#pragma unroll
            for (int mh = 0; mh < 2; ++mh) {
                u32x4 rb[2][2]; f32x4 rf[2][2][2];
#pragma unroll
                for (int mm = 0; mm < 2; ++mm)
#pragma unroll
                    for (int bj = 0; bj < 2; ++bj) { const size_t o = (size_t)(row0 + ai * HALF + (2 * mh + mm) * 16) * 1024 + col0 + bj * 32;
                        if constexpr (SRCF32) { rf[mm][bj][0] = *(const f32x4*)((const float*)src + o); rf[mm][bj][1] = *(const f32x4*)((const float*)src + o + 4); }
                        else rb[mm][bj] = *(const u32x4*)((const bf16_t*)src + o); }
#pragma unroll
                for (int mm = 0; mm < 2; ++mm)
#pragma unroll
                    for (int bj = 0; bj < 2; ++bj) { const int m = 2 * mh + mm; const size_t o = (size_t)(row0 + ai * HALF + m * 16) * 1024 + col0 + bj * 32;
                        f32x4 s0, s1;
                        if constexpr (SRCF32) { s0 = rf[mm][bj][0]; s1 = rf[mm][bj][1]; }
                        else { const u32x4 r = rb[mm][bj]; s0 = (f32x4){bflo(r.x), bfhi(r.x), bflo(r.y), bfhi(r.y)}; s1 = (f32x4){bflo(r.z), bfhi(r.z), bflo(r.w), bfhi(r.w)}; }
                        const f32x4 v0 = s0 + acc[ai][bj][m][0] * post, v1 = s1 + acc[ai][bj][m][1] * post;
                        u32x4 w; w.x = cvt_pk_bf16(v0[0], v0[1]); w.y = cvt_pk_bf16(v0[2], v0[3]); w.z = cvt_pk_bf16(v1[0], v1[1]); w.w = cvt_pk_bf16(v1[2], v1[3]);
                        *(u32x4*)(out + o) = w; } }
    }
};
struct EpiResid {
    static constexpr bool PERM = false, AFTER_DRAIN = false; static constexpr int MID_T = 0;
    const float* src; float* out;
    __device__ __forceinline__ void operator()(const f32x4 (&acc)[2][2][4][2], const Unit& u, int wr, int wc, int fr, int fq) const {
        int row0 = u.pm * BM + wr * 64 + fr, col0 = u.pn * BM + wc * 32 + 4 * fq; asm volatile("" : "+v"(row0));
#pragma unroll
        for (int ai = 0; ai < 2; ++ai) { f32x4 sv[4][2][2];
#pragma unroll
            for (int m = 0; m < 4; ++m)
#pragma unroll
                for (int bj = 0; bj < 2; ++bj)
#pragma unroll
                    for (int n = 0; n < 2; ++n) sv[m][bj][n] = *(const f32x4*)(src + (size_t)(row0 + ai * HALF + m * 16) * 1024 + col0 + bj * HALF + n * 16);
#pragma unroll
            for (int m = 0; m < 4; ++m)
#pragma unroll
                for (int bj = 0; bj < 2; ++bj)
#pragma unroll
                    for (int n = 0; n < 2; ++n) *(f32x4*)(out + (size_t)(row0 + ai * HALF + m * 16) * 1024 + col0 + bj * HALF + n * 16) = sv[m][bj][n] + acc[ai][bj][m][n]; }
    }
};
struct EpiSwiglu {
    static constexpr bool PERM = false, AFTER_DRAIN = false; static constexpr int MID_T = 0;
    bf16_t* O;
    __device__ __forceinline__ void operator()(const f32x4 (&acc)[2][2][4][2], const Unit& u, int wr, int wc, int fr, int fq) const {
        int row0 = u.pm * BM + wr * 64 + fr, f0 = (u.pn * BM + wc * 32) / 2 + 4 * fq; asm volatile("" : "+v"(row0));
#pragma unroll
        for (int ai = 0; ai < 2; ++ai)
#pragma unroll
            for (int m = 0; m < 4; ++m) { bf16_t* rowp = O + (size_t)(row0 + ai * HALF + m * 16) * P_FF + f0;
#pragma unroll
                for (int bj = 0; bj < 2; ++bj) { const f32x4 a = acc[ai][bj][m][0], b = acc[ai][bj][m][1];
                    u32x2 w; w.x = cvt_pk_bf16(a[0] * fsig(a[0]) * b[0], a[1] * fsig(a[1]) * b[1]); w.y = cvt_pk_bf16(a[2] * fsig(a[2]) * b[2], a[3] * fsig(a[3]) * b[3]);
                    *(u32x2*)(rowp + bj * (HALF / 2)) = w; } }
    }
};
struct EpiDown {
    static constexpr bool PERM = true, AFTER_DRAIN = false; static constexpr int MID_T = 0;
    const float* gw; bf16_t* O; float post;
    __device__ __forceinline__ void operator()(const f32x4 (&acc)[2][2][4][2], const Unit& u, int wr, int wc, int fr, int fq) const {
        int row0 = u.pm * BM + wr * 64 + fr, col0 = u.pn * BM + wc * 64 + 8 * fq; asm volatile("" : "+v"(row0));
        float srv[8];
#pragma unroll
        for (int i = 0; i < 8; ++i) srv[i] = gw[row0 + (i >> 2) * HALF + (i & 3) * 16] * post;
#pragma unroll
        for (int ai = 0; ai < 2; ++ai)
#pragma unroll
            for (int m = 0; m < 4; ++m) { const size_t r = (size_t)(row0 + ai * HALF + m * 16); const float s = srv[ai * 4 + m]; bf16_t* rowp = O + r * 1024 + col0;
#pragma unroll
                for (int bj = 0; bj < 2; ++bj) { const f32x4 v0 = acc[ai][bj][m][0] * s, v1 = acc[ai][bj][m][1] * s;
                    u32x4 w; w.x = cvt_pk_bf16(v0[0], v0[1]); w.y = cvt_pk_bf16(v0[2], v0[3]); w.z = cvt_pk_bf16(v1[0], v1[1]); w.w = cvt_pk_bf16(v1[2], v1[3]);
                    *(u32x4*)(rowp + bj * 32) = w; } }
    }
};
typedef int i32x4 __attribute__((ext_vector_type(4)));
typedef long i64x2 __attribute__((ext_vector_type(2)));
template <int MT> __device__ __forceinline__ f32x4 mma16(const bf16x8 a, const bf16x8 b, const f32x4 c) {
    if constexpr (MT == 1) return __builtin_bit_cast(f32x4, __builtin_amdgcn_mfma_i32_16x16x64_i8(__builtin_bit_cast(i32x4, a), __builtin_bit_cast(i32x4, b), __builtin_bit_cast(i32x4, c), 0, 0, 0));
    else if constexpr (MT == 2) { const i64x2 a2 = __builtin_bit_cast(i64x2, a), b2 = __builtin_bit_cast(i64x2, b);
        return __builtin_amdgcn_mfma_f32_16x16x32_fp8_fp8(a2[1], b2[1], __builtin_amdgcn_mfma_f32_16x16x32_fp8_fp8(a2[0], b2[0], c, 0, 0, 0), 0, 0, 0); }
    else return __builtin_amdgcn_mfma_f32_16x16x32_bf16(a, b, c, 0, 0, 0);
}
typedef int i32x8 __attribute__((ext_vector_type(8))); typedef short bf16x16 __attribute__((ext_vector_type(16)));
__device__ __forceinline__ i32x8 cat8(const bf16x8 lo, const bf16x8 hi) { const i32x4 l = __builtin_bit_cast(i32x4, lo), h = __builtin_bit_cast(i32x4, hi); return __builtin_shufflevector(l, h, 0, 1, 2, 3, 4, 5, 6, 7); }
__device__ __forceinline__ void mma_f8x128(f32x4& c, const i32x8 a, const i32x8 b, const int one) {
    asm volatile("s_nop 1\n\tv_mfma_scale_f32_16x16x128_f8f6f4 %0, %1, %2, %0, %3, %3 op_sel_hi:[0,0,0]" : "+v"(c) : "v"(a), "v"(b), "v"(one));
}
template <class Epi, class Sched, bool ALIGN_EPI = false, bool SP2 = false, int MT = 0>
__device__ __forceinline__ void gemm_phase(PG8_LAS unsigned char* lds, const Gemm g, const Sched& S, const Epi& E, const int tid) {
    const int wid = __builtin_amdgcn_readfirstlane(tid >> 6), lane = tid & 63, wr = wid >> 2, wc = wid & 3, fr = lane & 15, fq = lane >> 4;
    const int K = g.K, nt = K / BK;
    unsigned voffA[2], voffB[2];
#pragma unroll
    for (int i = 0; i < 2; ++i) { int R, C; stage_rc(tid * 16 + i * 8192, R, C); const int Rb = Epi::PERM ? ((R & ~31) * 2 + perm32(R & 31)) : R;
        voffA[i] = (unsigned)(R * K + C) * 2u; voffB[i] = (unsigned)(Rb * K + C) * 2u; }
    const size_t kstep = (size_t)(BK * 2);
    const size_t hstep = (size_t)HALF * K * 2;
    const size_t tstep = 2 * hstep;
    const size_t hstepB = Epi::PERM ? (size_t)32 * K * 2 : hstep;
    const unsigned ldsw = (unsigned)wid * 1024u;
    const int aoff = lds_byte(wr * 64 + fr, fq * 8), boff = lds_byte(wc * 32 + fr, fq * 8);
#define PG8_SA(b, h) (((b) * 2 + (h)) * HTB)
#define PG8_SB(b, h) ((4 + (b) * 2 + (h)) * HTB)
#define PG8_STAGE(bufoff, gbase, voff) do { _Pragma("unroll") for (int _i = 0; _i < 2; ++_i) \
        __builtin_amdgcn_global_load_lds((const unsigned*)((const char*)(gbase) + (voff)[_i]), (PG8_LAS unsigned*)(lds + (bufoff) + ldsw + _i * 8192), 16, 0, 0); } while (0)
#define PG8_LDA(dst, b, h) do { _Pragma("unroll") for (int m = 0; m < 4; ++m) _Pragma("unroll") for (int k = 0; k < 2; ++k) dst[m][k] = *(const PG8_LAS bf16x8*)(lds + PG8_SA(b, h) + (aoff ^ (k * 64)) + m * 2048); } while (0)
#define PG8_LDB(dst, b, h) do { _Pragma("unroll") for (int n = 0; n < 2; ++n) _Pragma("unroll") for (int k = 0; k < 2; ++k) dst[n][k] = *(const PG8_LAS bf16x8*)(lds + PG8_SB(b, h) + (boff ^ (k * 64)) + n * 2048); } while (0)
#define PG8_MMA(ai, bj, At, Bt) do { __builtin_amdgcn_s_setprio(1); _Pragma("unroll") for (int m = 0; m < 4; ++m) _Pragma("unroll") for (int n = 0; n < 2; ++n) { \
        if constexpr (MT == 2) mma_f8x128(acc[ai][bj][m][n], cat8(Bt[n][0], Bt[n][1]), cat8(At[m][0], At[m][1]), mxone); \
        else { _Pragma("unroll") for (int k = 0; k < 2; ++k) acc[ai][bj][m][n] = mma16<MT>(Bt[n][k], At[m][k], acc[ai][bj][m][n]); } } __builtin_amdgcn_s_setprio(0); } while (0)
#define PG8_WAIT_V(n) asm volatile("s_waitcnt vmcnt(" #n ")" ::: "memory")
#define PG8_WAIT_L(n) asm volatile("s_waitcnt lgkmcnt(" #n ")" ::: "memory")
#define PG8_BAR __builtin_amdgcn_s_barrier()
#define PG8_SCHED __builtin_amdgcn_sched_barrier(0)
    Unit cur, nxt; int ui = 0;
    if (!S.next(0, cur)) return;
    f32x4 acc[2][2][4][2];
#pragma unroll
    for (int a = 0; a < 2; ++a)
#pragma unroll
        for (int b = 0; b < 2; ++b)
#pragma unroll
            for (int m = 0; m < 4; ++m)
#pragma unroll
                for (int n = 0; n < 2; ++n) acc[a][b][m][n] = (f32x4){0.f, 0.f, 0.f, 0.f};
    bf16x8 At[4][2], B0[2][2], B1[2][2]; const int mxone = 0x7f7f7f7f;
    const char* cA = (const char*)g.A + (size_t)cur.pm * tstep; const char* cB = (const char*)g.Bt + (size_t)(cur.pm >> g.gshift) * g.gstrideB + (size_t)cur.pn * tstep;
    S.a_ready(cur);
    if constexpr (SP2) {
        PG8_STAGE(PG8_SB(0, 0), cB, voffB); PG8_STAGE(PG8_SB(0, 1), cB + hstepB, voffB); PG8_STAGE(PG8_SA(0, 0), cA, voffA); PG8_STAGE(PG8_SA(0, 1), cA + hstep, voffA);
        if (wr == 1) PG8_BAR;
        PG8_WAIT_V(2); PG8_BAR;
        PG8_STAGE(PG8_SB(1, 0), cB + kstep, voffB); PG8_STAGE(PG8_SA(1, 0), cA + kstep, voffA); PG8_STAGE(PG8_SB(1, 1), cB + hstepB + kstep, voffB);
        PG8_WAIT_V(6); PG8_BAR;
    } else {
        PG8_STAGE(PG8_SB(0, 0), cB, voffB); PG8_STAGE(PG8_SA(0, 0), cA, voffA); PG8_STAGE(PG8_SB(0, 1), cB + hstepB, voffB); PG8_STAGE(PG8_SA(0, 1), cA + hstep, voffA);
        if (wr == 1) PG8_BAR;
        PG8_WAIT_V(4); PG8_BAR;
        PG8_STAGE(PG8_SB(1, 0), cB + kstep, voffB); PG8_STAGE(PG8_SA(1, 0), cA + kstep, voffA); PG8_STAGE(PG8_SB(1, 1), cB + hstepB + kstep, voffB);
        PG8_WAIT_V(6); PG8_BAR;
    }
    for (;;) {
        const bool has_next = S.next(ui + 1, nxt);
        const char* nA = has_next ? (const char*)g.A + (size_t)nxt.pm * tstep : cA; const char* nB = has_next ? (const char*)g.Bt + (size_t)(nxt.pm >> g.gshift) * g.gstrideB + (size_t)nxt.pn * tstep : cB;
        for (int t = 0; t < nt; t += 2) {
            const bool last = (t == nt - 2);
            if constexpr (Epi::MID_T > 0) { if (t == Epi::MID_T) { if constexpr (MT == 2) asm volatile("s_nop 15\n\ts_nop 7" ::: "memory"); E.mid(acc, cur, wr, wc, fr, fq); } }
            const char* a1 = cA + (size_t)(t + 1) * kstep;
            const char* a2 = last ? nA : cA + (size_t)(t + 2) * kstep; const char* b2 = last ? nB : cB + (size_t)(t + 2) * kstep;
            const char* a3 = a2 + kstep; const char* b3 = b2 + kstep;
            if (last && has_next) S.a_ready(nxt);
            if constexpr (SP2) {
            PG8_LDB(B0, 0, 0); PG8_LDB(B1, 0, 1); PG8_SCHED; PG8_LDA(At, 0, 0); PG8_STAGE(PG8_SA(1, 1), a1 + hstep, voffA);
            PG8_WAIT_V(8); PG8_WAIT_L(0); PG8_BAR; PG8_MMA(0, 0, At, B0); PG8_MMA(0, 1, At, B1); PG8_BAR; PG8_SCHED;
            PG8_LDA(At, 0, 1); PG8_STAGE(PG8_SB(0, 0), b2, voffB); PG8_STAGE(PG8_SB(0, 1), b2 + hstepB, voffB); PG8_STAGE(PG8_SA(0, 0), a2, voffA);
            PG8_WAIT_V(8); PG8_WAIT_L(0); PG8_BAR; PG8_MMA(1, 0, At, B0); PG8_MMA(1, 1, At, B1); PG8_BAR; PG8_SCHED;
            PG8_LDB(B0, 1, 0); PG8_LDB(B1, 1, 1); PG8_SCHED; PG8_LDA(At, 1, 0); PG8_STAGE(PG8_SA(0, 1), a2 + hstep, voffA);
            PG8_WAIT_V(8); PG8_WAIT_L(0); PG8_BAR; PG8_MMA(0, 0, At, B0); PG8_MMA(0, 1, At, B1); PG8_BAR; PG8_SCHED;
            PG8_LDA(At, 1, 1); PG8_STAGE(PG8_SB(1, 0), b3, voffB); PG8_STAGE(PG8_SB(1, 1), b3 + hstepB, voffB); PG8_STAGE(PG8_SA(1, 0), a3, voffA);
            PG8_WAIT_V(8); PG8_WAIT_L(0); PG8_BAR; PG8_MMA(1, 0, At, B0); PG8_MMA(1, 1, At, B1); PG8_BAR; PG8_SCHED;
            } else {
            PG8_LDB(B0, 0, 0); PG8_SCHED; PG8_LDA(At, 0, 0); PG8_STAGE(PG8_SA(1, 1), a1 + hstep, voffA);
            PG8_WAIT_L(8); PG8_BAR; PG8_WAIT_L(0); PG8_MMA(0, 0, At, B0); PG8_BAR; PG8_SCHED;
            PG8_LDB(B1, 0, 1); PG8_STAGE(PG8_SB(0, 0), b2, voffB);
            PG8_BAR; PG8_WAIT_L(0); PG8_MMA(0, 1, At, B1); PG8_BAR;
            PG8_LDA(At, 0, 1); PG8_STAGE(PG8_SA(0, 0), a2, voffA);
            PG8_BAR; PG8_WAIT_L(0); PG8_MMA(1, 0, At, B0); PG8_BAR; PG8_SCHED;
            PG8_STAGE(PG8_SB(0, 1), b2 + hstepB, voffB);
            PG8_WAIT_V(6); PG8_BAR; PG8_MMA(1, 1, At, B1); PG8_BAR;
            PG8_LDB(B0, 1, 0); PG8_SCHED; PG8_LDA(At, 1, 0); PG8_STAGE(PG8_SA(0, 1), a2 + hstep, voffA);
            PG8_WAIT_L(8); PG8_BAR; PG8_WAIT_L(0); PG8_MMA(0, 0, At, B0); PG8_BAR; PG8_SCHED;
            PG8_LDB(B1, 1, 1); PG8_STAGE(PG8_SB(1, 0), b3, voffB);
            PG8_BAR; PG8_WAIT_L(0); PG8_MMA(0, 1, At, B1); PG8_BAR;
            PG8_LDA(At, 1, 1); PG8_STAGE(PG8_SA(1, 0), a3, voffA);
            PG8_BAR; PG8_WAIT_L(0); PG8_MMA(1, 0, At, B0); PG8_BAR; PG8_SCHED;
            PG8_STAGE(PG8_SB(1, 1), b3 + hstepB, voffB);
            PG8_WAIT_V(6); PG8_BAR; PG8_MMA(1, 1, At, B1); PG8_BAR;
            }
        }
        if constexpr (MT == 2) asm volatile("s_nop 15\n\ts_nop 7" ::: "memory");
        if constexpr (ALIGN_EPI) { if (wr == 0) PG8_BAR; }
        if constexpr (!Epi::AFTER_DRAIN) { E(acc, cur, wr, wc, fr, fq); S.done(cur); }
        if (!has_next) break;
#pragma unroll
        for (int a = 0; a < 2; ++a)
#pragma unroll
            for (int b = 0; b < 2; ++b)
#pragma unroll
                for (int m = 0; m < 4; ++m)
#pragma unroll
                    for (int n = 0; n < 2; ++n) acc[a][b][m][n] = (f32x4){0.f, 0.f, 0.f, 0.f};
        cur = nxt; cA = nA; cB = nB; ++ui;
        if constexpr (ALIGN_EPI) { if (wr == 1) PG8_BAR; }
    }
    PG8_WAIT_V(0);
    if constexpr (!ALIGN_EPI) { if (wr == 0) PG8_BAR; }
    PG8_BAR;
    if constexpr (Epi::AFTER_DRAIN) { E.fused(acc, cur, wr, wc, fr, fq, lds, wid, lane); S.done(cur); }
#undef PG8_SA
#undef PG8_SB
#undef PG8_STAGE
#undef PG8_LDA
#undef PG8_LDB
#undef PG8_MMA
#undef PG8_WAIT_V
#undef PG8_WAIT_L
#undef PG8_BAR
#undef PG8_SCHED
}
}


constexpr int NWAVES = 8;
constexpr bool USE_CG_SYNC = false;
#ifndef REP_MASK
#define REP_MASK 0
#endif
constexpr int RING_OFF = 0, RING_BYTES = 131072;
constexpr int LDSCTL_OFF = RING_BYTES, MISC_OFF = LDSCTL_OFF + 320;
constexpr int LDS_BYTES = 147456;
constexpr int CW_CENSUS = 1024;
constexpr int CW_BAR = 4096;
constexpr size_t CTL_ZERO_BYTES = 1 * MiB;
constexpr int NPH_LAYER = 10, NPHASES = 1 + DEPTH * NPH_LAYER;

struct Frame {
    LAS unsigned char* lds; volatile LAS unsigned* MISC; unsigned* ctl;
    int tid, lane, wave, G, vcu, cid;
    unsigned char* ws;
};
struct Args { const float* in[13]; float* out; unsigned char* ws; int ph_lo, ph_hi, cg_seams, pad; };

__device__ __forceinline__ float wave_sum(float v) {
#pragma unroll
    for (int o = 1; o < 64; o <<= 1) v += __shfl_xor(v, o);
    return v;
}
__device__ __forceinline__ float bflo(unsigned w) { return __builtin_bit_cast(float, w << 16); }
__device__ __forceinline__ float bfhi(unsigned w) { return __builtin_bit_cast(float, w & 0xffff0000u); }

__device__ __forceinline__ unsigned q8x4(float a, float b, float c, float d) {
    const int ia = (int)__builtin_rintf(a), ib = (int)__builtin_rintf(b), ic = (int)__builtin_rintf(c), id = (int)__builtin_rintf(d);
    return (unsigned)(ia & 0xff) | ((unsigned)(ib & 0xff) << 8) | ((unsigned)(ic & 0xff) << 16) | ((unsigned)id << 24);
}
__device__ __forceinline__ float wave_max(float v) {
#pragma unroll
    for (int o = 1; o < 64; o <<= 1) v = fmaxf(v, __shfl_xor(v, o));
    return v;
}
__device__ __forceinline__ void quant_row_store(const f32x4 (&h)[4], signed char* orow, float* scale_out, int lane) {
    float m = 0.f;
#pragma unroll
    for (int j = 0; j < 4; ++j) m = fmaxf(fmaxf(m, fmaxf(fabsf(h[j].x), fabsf(h[j].y))), fmaxf(fabsf(h[j].z), fabsf(h[j].w)));
    m = wave_max(m);
    const float inv = m > 0.f ? 127.f / m : 0.f;
    unsigned* o4 = (unsigned*)orow + lane;
#pragma unroll
    for (int j = 0; j < 4; ++j) o4[64 * j] = q8x4(h[j].x * inv, h[j].y * inv, h[j].z * inv, h[j].w * inv);
    if (lane == 0) *scale_out = m * (1.f / 127.f);
}
__device__ __forceinline__ void rms_row_to_i8(const float* xrow, const float* gain, signed char* orow, float* scale_out, int lane) {
    const f32x4* xr = (const f32x4*)xrow + lane; const f32x4* gr = (const f32x4*)gain + lane;
    f32x4 v[4]; float s = 0.f;
#pragma unroll
    for (int j = 0; j < 4; ++j) { v[j] = xr[64 * j]; s += (v[j].x * v[j].x + v[j].y * v[j].y) + (v[j].z * v[j].z + v[j].w * v[j].w); }
    const float rstd = rsqrtf(wave_sum(s) * (1.f / DM) + EPS);
#pragma unroll
    for (int j = 0; j < 4; ++j) { const f32x4 g = gr[64 * j]; v[j].x *= rstd * g.x; v[j].y *= rstd * g.y; v[j].z *= rstd * g.z; v[j].w *= rstd * g.w; }
    quant_row_store(v, orow, scale_out, lane);
}
__device__ __forceinline__ void p0_q8_block_item(Frame& F, const float* W, int N, int n0, signed char* WQ, float* wsc, int mode, LAS float* red) {
    const int lane = F.lane, w = F.wave;
    const float* p = W + (size_t)(128 * w) * N + n0 + lane;
    float v[128]; float m = 0.f;
#pragma unroll
    for (int i = 0; i < 128; ++i) v[i] = __builtin_nontemporal_load(p + (size_t)i * N);
#pragma unroll
    for (int i = 0; i < 128; ++i) m = fmaxf(m, fabsf(v[i]));
    red[w * 64 + lane] = m;
    __syncthreads();
    float M = red[lane];
#pragma unroll
    for (int j = 1; j < 8; ++j) M = fmaxf(M, red[j * 64 + lane]);
    const float inv = M > 0.f ? 127.f / M : 0.f;
    const int ng = n0 + lane;
    const int np = (mode == 0) ? ng : ((ng >> 7) * 256 + ((ng >> 2) & 1) * 128 + ((ng >> 5) & 3) * 32 + (mode == 2 ? 16 : 0) + ((ng >> 3) & 3) * 4 + (ng & 3));
    v4u* o = (v4u*)(WQ + (size_t)np * 1024 + 128 * w);
#pragma unroll
    for (int i = 0; i < 8; ++i) { v4u q; q.x = q8x4(v[16 * i] * inv, v[16 * i + 1] * inv, v[16 * i + 2] * inv, v[16 * i + 3] * inv); q.y = q8x4(v[16 * i + 4] * inv, v[16 * i + 5] * inv, v[16 * i + 6] * inv, v[16 * i + 7] * inv);
        q.z = q8x4(v[16 * i + 8] * inv, v[16 * i + 9] * inv, v[16 * i + 10] * inv, v[16 * i + 11] * inv); q.w = q8x4(v[16 * i + 12] * inv, v[16 * i + 13] * inv, v[16 * i + 14] * inv, v[16 * i + 15] * inv); o[i] = q; }
    if (w == 0) wsc[np] = M * (1.f / 127.f);
    __syncthreads();
}
__device__ __forceinline__ void p0_tr16_item(const float* W, int K, int N, bf16* WT, int ldo, int koff, int item, int lane) {
    const int nblk = N / 128, kb = item / nblk, nb = item % nblk, k0 = 32 * kb, n0 = 128 * nb;
    const f32x2_t* p = (const f32x2_t*)(W + (size_t)k0 * N + n0) + lane; const size_t rstep = (size_t)N / 2;
    f32x2_t v[32];
#pragma unroll
    for (int i = 0; i < 32; ++i) v[i] = p[(size_t)i * rstep];
    v4u* o0 = (v4u*)(WT + (size_t)(n0 + 2 * lane) * ldo + koff + k0); v4u* o1 = (v4u*)(WT + (size_t)(n0 + 2 * lane + 1) * ldo + koff + k0);
#pragma unroll
    for (int i = 0; i < 4; ++i) { v4u q0, q1;
        q0.x = pk2(v[8 * i].x, v[8 * i + 1].x); q0.y = pk2(v[8 * i + 2].x, v[8 * i + 3].x); q0.z = pk2(v[8 * i + 4].x, v[8 * i + 5].x); q0.w = pk2(v[8 * i + 6].x, v[8 * i + 7].x);
        q1.x = pk2(v[8 * i].y, v[8 * i + 1].y); q1.y = pk2(v[8 * i + 2].y, v[8 * i + 3].y); q1.z = pk2(v[8 * i + 4].y, v[8 * i + 5].y); q1.w = pk2(v[8 * i + 6].y, v[8 * i + 7].y);
        o0[i] = q0; o1[i] = q1; }
}
struct TrTile { const float* W; bf16* WT; int N, ldo, koff, k0, n0, fp8; };
__device__ __forceinline__ void p0_tr_load(const TrTile& t, f32x4 (&v)[8], const int w, const int lane) {
    const float* p = t.W + (size_t)(t.k0 + 8 * w) * t.N + t.n0 + 4 * lane;
#pragma unroll
    for (int i = 0; i < 8; ++i) v[i] = __builtin_nontemporal_load((const f32x4*)(p + (size_t)i * t.N));
}
__device__ __forceinline__ void p0_tr_store(Frame& F, const TrTile& t, const f32x4 (&v)[8], LAS float* buf) {
    const int w = F.wave, lane = F.lane, tid = F.tid;
#pragma unroll
    for (int i = 0; i < 8; ++i) *(LAS f32x4*)(buf + (8 * w + i) * 256 + 4 * lane) = v[i];
    __syncthreads();
    const int n = tid & 255;
#pragma unroll
    for (int j = 0; j < 4; ++j) { const int kc = (tid >> 8) + 2 * j; const LAS float* sp = buf + (8 * kc) * 256 + n;
        v4u o; o.x = pk2(sp[0], sp[256]); o.y = pk2(sp[2 * 256], sp[3 * 256]); o.z = pk2(sp[4 * 256], sp[5 * 256]); o.w = pk2(sp[6 * 256], sp[7 * 256]);
        *(v4u*)(t.WT + (size_t)(t.n0 + n) * t.ldo + t.koff + t.k0 + 8 * kc) = o; }
}
__device__ __forceinline__ void p0_tr_store_fp8(Frame& F, const TrTile& t, const f32x4 (&v)[8], LAS float* buf) {
    const int w = F.wave, lane = F.lane;
#pragma unroll
    for (int i = 0; i < 8; ++i) *(LAS f32x4*)(buf + (8 * w + i) * 256 + 4 * (lane ^ (4 * (w >> 1)))) = v[i];
    __syncthreads();
    unsigned char* W8 = (unsigned char*)t.WT; const float lim = fp8_lim(); const int kq = lane & 3;
#pragma unroll
    for (int jj = 0; jj < 2; ++jj) { const int n = 32 * w + 16 * jj + (lane >> 2); const LAS float* sp = buf + (16 * kq) * 256 + 4 * ((n >> 2) ^ (4 * kq)) + (n & 3);
        u32x4 o;
        o.x = fp8x4(sp[0] * 64.f, sp[256] * 64.f, sp[2 * 256] * 64.f, sp[3 * 256] * 64.f, lim); o.y = fp8x4(sp[4 * 256] * 64.f, sp[5 * 256] * 64.f, sp[6 * 256] * 64.f, sp[7 * 256] * 64.f, lim);
        o.z = fp8x4(sp[8 * 256] * 64.f, sp[9 * 256] * 64.f, sp[10 * 256] * 64.f, sp[11 * 256] * 64.f, lim); o.w = fp8x4(sp[12 * 256] * 64.f, sp[13 * 256] * 64.f, sp[14 * 256] * 64.f, sp[15 * 256] * 64.f, lim);
        *(u32x4*)(W8 + (size_t)(t.n0 + n) * t.ldo + t.koff + t.k0 + 16 * kq) = o; }
}
__device__ __forceinline__ void phase_p0(Frame& F, const Args& a) {
    const int gw = F.vcu * NWAVES + F.wave, NGW = F.G * NWAVES;
    unsigned char* ws = F.ws;
    {   constexpr int B_IN = NIN / 64, B_G = FF / 64, B_TOT = DEPTH * B_IN + 2 * DEPTH * NE * B_G;
        LAS float* red = (LAS float*)(F.lds + RING_OFF);
        struct Q8Item { const float* W; signed char* WQ; float* wsc; int N, n0, mode; };
        auto decode = [&](int it, Q8Item& q) { int r = it;
            if (r < DEPTH * B_IN) { const int l = r / B_IN; r %= B_IN; q.W = a.in[1] + (size_t)l * DM * NIN; q.N = NIN; q.n0 = 64 * r; q.WQ = (signed char*)(ws + WS_WIN) + (size_t)l * NIN * DM; q.wsc = (float*)(ws + WS_WINS) + l * NIN; q.mode = 0; return; }
            r -= DEPTH * B_IN; const int which = r / (DEPTH * NE * B_G); r %= (DEPTH * NE * B_G); const int le = r / B_G; r %= B_G;
            q.W = a.in[which ? 10 : 9] + (size_t)le * DM * FF; q.N = FF; q.n0 = 64 * r; q.WQ = (signed char*)(ws + WS_WGU) + (size_t)le * 2 * FF * DM; q.wsc = (float*)(ws + WS_WGUS) + (size_t)le * 2 * FF; q.mode = which ? 2 : 1; };
        float v[128]; Q8Item cur, nxt; const int lane = F.lane, w = F.wave;
#define P0_Q8_LOAD(q_) do { const float* p_ = (q_).W + (size_t)(128 * w) * (q_).N + (q_).n0 + lane; _Pragma("unroll") for (int i = 0; i < 128; ++i) v[i] = __builtin_nontemporal_load(p_ + (size_t)i * (q_).N); } while (0)
        int it = F.vcu, par = 0;
        if (it < B_TOT) { decode(it, cur); P0_Q8_LOAD(cur); }
#pragma unroll 1
        for (; it < B_TOT; it += F.G, par ^= 1) {
            const bool more = it + F.G < B_TOT; if (more) decode(it + F.G, nxt);
            float m = 0.f;
#pragma unroll
            for (int i = 0; i < 128; ++i) m = fmaxf(m, fabsf(v[i]));
            red[par * 512 + w * 64 + lane] = m;
            __syncthreads();
            float M = red[par * 512 + lane];
#pragma unroll
            for (int j = 1; j < 8; ++j) M = fmaxf(M, red[par * 512 + j * 64 + lane]);
            const float inv = M > 0.f ? 127.f / M : 0.f;
            v4u q[8];
#pragma unroll
            for (int i = 0; i < 8; ++i) { q[i].x = q8x4(v[16 * i] * inv, v[16 * i + 1] * inv, v[16 * i + 2] * inv, v[16 * i + 3] * inv); q[i].y = q8x4(v[16 * i + 4] * inv, v[16 * i + 5] * inv, v[16 * i + 6] * inv, v[16 * i + 7] * inv);
                q[i].z = q8x4(v[16 * i + 8] * inv, v[16 * i + 9] * inv, v[16 * i + 10] * inv, v[16 * i + 11] * inv); q[i].w = q8x4(v[16 * i + 12] * inv, v[16 * i + 13] * inv, v[16 * i + 14] * inv, v[16 * i + 15] * inv); }
#define P0_NP(ng_) ((cur.mode == 0) ? (ng_) : (((ng_) >> 7) * 256 + (((ng_) >> 2) & 1) * 128 + (((ng_) >> 5) & 3) * 32 + (cur.mode == 2 ? 16 : 0) + (((ng_) >> 3) & 3) * 4 + ((ng_) & 3)))
            {   LAS unsigned char* tb = F.lds + RING_OFF + 8192 + w * (64 * 144);
#pragma unroll
                for (int i = 0; i < 8; ++i) *(LAS v4u*)(tb + lane * 144 + i * 16) = q[i];
                const Q8Item done = cur;
                __builtin_amdgcn_sched_barrier(0);
                if (more) { cur = nxt; P0_Q8_LOAD(cur); }
                __builtin_amdgcn_sched_barrier(0);
                const int g8 = lane >> 3, j8 = lane & 7;
#define P0_NPD(ng_) ((done.mode == 0) ? (ng_) : (((ng_) >> 7) * 256 + (((ng_) >> 2) & 1) * 128 + (((ng_) >> 5) & 3) * 32 + (done.mode == 2 ? 16 : 0) + (((ng_) >> 3) & 3) * 4 + ((ng_) & 3)))
#pragma unroll
                for (int i = 0; i < 8; ++i) { const int c = 8 * g8 + i; const v4u r = *(const LAS v4u*)(tb + c * 144 + j8 * 16); const int ngc = done.n0 + c, npc = P0_NPD(ngc);
                    *(v4u*)(done.WQ + (size_t)npc * 1024 + 128 * w + 16 * j8) = r; }
                if (w == 0) { const int ng = done.n0 + lane; done.wsc[P0_NPD(ng)] = M * (1.f / 127.f); }
#undef P0_NPD
            }
#undef P0_NP
        }
#undef P0_Q8_LOAD
        __syncthreads();
    }
    {   constexpr int T_AO = (AW / 64) * (DM / 256), T_RO = (RW / 64) * (DM / 256), T_O = (DM / 64) * (DM / 256), T_D = (FF / 64) * (DM / 256);
        constexpr int T_LAYER = T_AO + T_RO + T_O + NE * T_D, T_TOT = DEPTH * T_LAYER;
        LAS float* buf = (LAS float*)(F.lds + RING_OFF);
        auto decode = [&](int it, TrTile& t) {
            const int l = it / T_LAYER; int r = it % T_LAYER; t.fp8 = 0;
            if (r < T_AO) { t.W = a.in[2] + (size_t)l * AW * DM; t.N = DM; t.WT = (bf16*)(ws + WS_WCAT + (size_t)l * DM * CATW); t.ldo = CATW; t.koff = 0; t.fp8 = 1; }
            else if ((r -= T_AO) < T_RO) { t.W = a.in[3] + (size_t)l * RW * DM; t.N = DM; t.WT = (bf16*)(ws + WS_WCAT + (size_t)l * DM * CATW); t.ldo = CATW; t.koff = AW; t.fp8 = 1; }
            else if ((r -= T_RO) < T_O) { t.W = a.in[4] + (size_t)l * DM * DM; t.N = DM; t.WT = (bf16*)(ws + WS_WO) + (size_t)l * DM * DM; t.ldo = DM; t.koff = 0; }
            else { r -= T_O; const int e = r / T_D; r %= T_D; const size_t le = (size_t)l * NE + e; t.W = a.in[11] + le * FF * DM; t.N = DM; t.ldo = FF; t.koff = 0;
                t.WT = (bf16*)(ws + WS_WDN + le * DM * FF); t.fp8 = 1; }
            t.k0 = 64 * (r >> 2); t.n0 = 256 * (r & 3);
        };
        TrTile cur, nx1, nx2; f32x4 v[8], v1[8], v2[8];
        int it = F.vcu, tpar = 0;
        if (it < T_TOT) { decode(it, cur); p0_tr_load(cur, v, F.wave, F.lane); }
        if (it + F.G < T_TOT) { decode(it + F.G, nx1); p0_tr_load(nx1, v1, F.wave, F.lane); }
#pragma unroll 1
        for (; it < T_TOT; it += F.G) {
            if (it + 2 * F.G < T_TOT) { decode(it + 2 * F.G, nx2); p0_tr_load(nx2, v2, F.wave, F.lane); }
            if (cur.fp8) p0_tr_store_fp8(F, cur, v, buf + tpar * 16384); else p0_tr_store(F, cur, v, buf + tpar * 16384);
            tpar ^= 1; cur = nx1; nx1 = nx2;
#pragma unroll
            for (int i = 0; i < 8; ++i) { v[i] = v1[i]; v1[i] = v2[i]; }
        }
        __syncthreads();
    }
#pragma unroll 1
    for (int m = gw; m < T; m += 4 * NGW) {
        f32x4 xv[4][4];
#pragma unroll
        for (int r = 0; r < 4; ++r) { const int mr = (m + r * NGW < T) ? m + r * NGW : m; const f32x4* xr = (const f32x4*)(a.in[0] + (size_t)mr * DM) + F.lane;
#pragma unroll
            for (int j = 0; j < 4; ++j) xv[r][j] = xr[64 * j]; }
#pragma unroll
        for (int r = 0; r < 4; ++r) { const int mr = m + r * NGW; if (mr < T) {
            float ss = 0.f;
#pragma unroll
            for (int j = 0; j < 4; ++j) ss += (xv[r][j].x * xv[r][j].x + xv[r][j].y * xv[r][j].y) + (xv[r][j].z * xv[r][j].z + xv[r][j].w * xv[r][j].w);
            const float rstd = rsqrtf(wave_sum(ss) * (1.f / DM) + EPS); const f32x4* gr = (const f32x4*)a.in[6] + F.lane;
#pragma unroll
            for (int j = 0; j < 4; ++j) { const f32x4 g = gr[64 * j]; xv[r][j].x *= rstd * g.x; xv[r][j].y *= rstd * g.y; xv[r][j].z *= rstd * g.z; xv[r][j].w *= rstd * g.w; }
            quant_row_store(xv[r], (signed char*)(ws + WS_H) + (size_t)mr * DM, (float*)(ws + WS_HS) + mr, F.lane); } }
    }
}

struct FinIn { u32x2 yf[4], yb[4], gq[4]; float l0, l1, l2; v4u p0, p1, p2; };
__device__ __forceinline__ void fin_load(FinIn& I, const int t, const int lane, const bf16* PROJ, const bf16* YF, const bf16* YB, const bf16* ATTO, const float* LSE) {
#pragma unroll
    for (int j = 0; j < 4; ++j) { const int c = 256 * j + 4 * lane;
        I.yf[j] = *(const u32x2*)(YF + (size_t)t * RW + c); I.yb[j] = *(const u32x2*)(YB + (size_t)t * RW + c); I.gq[j] = *(const u32x2*)(PROJ + PO_RG + (size_t)t * RW + c); }
    const int hh = lane >> 3, c = 8 * lane;
    I.l0 = LSE[((size_t)0 * T + t) * 8 + hh]; I.l1 = LSE[((size_t)1 * T + t) * 8 + hh]; I.l2 = LSE[((size_t)2 * T + t) * 8 + hh];
    I.p0 = *(const v4u*)(ATTO + ((size_t)0 * T + t) * AW + c); I.p1 = *(const v4u*)(ATTO + ((size_t)1 * T + t) * AW + c); I.p2 = *(const v4u*)(ATTO + ((size_t)2 * T + t) * AW + c);
}
__device__ __forceinline__ void fin_compute(const FinIn& I, const int t, const int lane, unsigned char* CAT) {
    unsigned char* crow = CAT + (size_t)t * CATW; const float lim = fp8_lim();
#pragma unroll
    for (int j = 0; j < 4; ++j) {
        const int c = 256 * j + 4 * lane; const u32x2 yf = I.yf[j], yb = I.yb[j], gq = I.gq[j];
        const float r0 = bflo(yf.x) + bflo(yb.x), r1 = bfhi(yf.x) + bfhi(yb.x), r2 = bflo(yf.y) + bflo(yb.y), r3 = bfhi(yf.y) + bfhi(yb.y);
        const float rstd = rsqrtf(wave_sum((r0 * r0 + r1 * r1) + (r2 * r2 + r3 * r3)) * (1.f / 256.f) + EPS);
        const float g0 = bflo(gq.x), g1 = bfhi(gq.x), g2 = bflo(gq.y), g3 = bfhi(gq.y);
        const float rs16 = rstd * 16.f;
        *(unsigned*)(crow + AW + c) = fp8x4(siluf_(g0) * r0 * rs16, siluf_(g1) * r1 * rs16, siluf_(g2) * r2 * rs16, siluf_(g3) * r3 * rs16, lim);
    }
    {
        const int c = 8 * lane; const float l0 = I.l0, l1 = I.l1, l2 = I.l2; const v4u p0 = I.p0, p1 = I.p1, p2 = I.p2;
        const float mx = fmaxf(l0, fmaxf(l1, l2)); float w0 = __expf(l0 - mx), w1 = __expf(l1 - mx), w2 = __expf(l2 - mx); const float inv = 16.f / (w0 + w1 + w2); w0 *= inv; w1 *= inv; w2 *= inv;
        u32x2 o;
        o.x = fp8x4(w0 * bflo(p0.x) + w1 * bflo(p1.x) + w2 * bflo(p2.x), w0 * bfhi(p0.x) + w1 * bfhi(p1.x) + w2 * bfhi(p2.x), w0 * bflo(p0.y) + w1 * bflo(p1.y) + w2 * bflo(p2.y), w0 * bfhi(p0.y) + w1 * bfhi(p1.y) + w2 * bfhi(p2.y), lim);
        o.y = fp8x4(w0 * bflo(p0.z) + w1 * bflo(p1.z) + w2 * bflo(p2.z), w0 * bfhi(p0.z) + w1 * bfhi(p1.z) + w2 * bfhi(p2.z), w0 * bflo(p0.w) + w1 * bflo(p1.w) + w2 * bflo(p2.w), w0 * bfhi(p0.w) + w1 * bfhi(p1.w) + w2 * bfhi(p2.w), lim);
        *(u32x2*)(crow + c) = o;
    }
}
__device__ __forceinline__ void phase_finalize(Frame& F, const Args& a) {
    unsigned char* ws = F.ws; const bf16* PROJ = (const bf16*)(ws + WS_PROJ); const bf16* YF = (const bf16*)(ws + WS_YF); const bf16* YB = (const bf16*)(ws + WS_YB);
    const bf16* ATTO = (const bf16*)(ws + WS_ATTO); const float* LSE = (const float*)(ws + WS_LSE); unsigned char* CAT = ws + WS_CAT;
    const int gw = F.vcu * NWAVES + F.wave, NGW = F.G * NWAVES, lane = F.lane;
#pragma unroll 1
    for (int t = gw; t < T; t += 2 * NGW) {
        FinIn A, B; const int t2 = t + NGW; const bool two = t2 < T;
        fin_load(A, t, lane, PROJ, YF, YB, ATTO, LSE); fin_load(B, two ? t2 : t, lane, PROJ, YF, YB, ATTO, LSE);
        fin_compute(A, t, lane, CAT); if (two) fin_compute(B, t2, lane, CAT);
    }
}

__device__ __forceinline__ void phase_norm_router(Frame& F, const Args& a, int layer) {
    unsigned char* ws = F.ws; const bf16* x = (const bf16*)(ws + WS_XB); const float* gain = a.in[7] + (size_t)layer * DM; const float* wr = a.in[8] + (size_t)layer * DM * NE;
    signed char* H8 = (signed char*)(ws + WS_H); float* HS = (float*)(ws + WS_HS); float* AFF = (float*)(ws + WS_AFF);
    LAS unsigned short* WH = (LAS unsigned short*)(F.lds + RING_OFF);
    LAS unsigned short* WL = WH + 16384;
    LAS float* GL = (LAS float*)(F.lds + RING_OFF + 65536);
    const int lane = F.lane, tq = lane & 15, kg = lane >> 4, kh = F.wave & 1, c0 = 2 * kh, c1 = 2 * kh + 1, tfirst = F.vcu * 4;
    LAS float* EX = (LAS float*)(F.lds + RING_OFF + 73728);
    v4u xa[8], xb[8];
#define RT_LOAD(buf, c) do { _Pragma("unroll") for (int s8 = 0; s8 < 8; ++s8) buf[s8] = *(const v4u*)(xr + 32 * (8 * (c) + s8)); } while (0)
#define RT_X0(r_) ((f32x4){bflo((r_).x), bfhi((r_).x), bflo((r_).y), bfhi((r_).y)})
#define RT_X1(r_) ((f32x4){bflo((r_).z), bfhi((r_).z), bflo((r_).w), bfhi((r_).w)})
#define RT_P1(buf, c) do { _Pragma("unroll") for (int s8 = 0; s8 < 8; ++s8) { const int sk = 8 * (c) + s8; \
                const f32x4 g0 = *(const LAS f32x4*)(GL + 32 * sk + 8 * kg), g1 = *(const LAS f32x4*)(GL + 32 * sk + 8 * kg + 4); \
                const f32x4 x0 = RT_X0(buf[s8]), x1 = RT_X1(buf[s8]); \
                ss += ((x0.x * x0.x + x0.y * x0.y) + (x0.z * x0.z + x0.w * x0.w)) + ((x1.x * x1.x + x1.y * x1.y) + (x1.z * x1.z + x1.w * x1.w)); \
                const f32x4 v0 = x0 * g0, v1 = x1 * g1; \
                mx = fmaxf(mx, fmaxf(fmaxf(fmaxf(fabsf(v0.x), fabsf(v0.y)), fmaxf(fabsf(v0.z), fabsf(v0.w))), fmaxf(fmaxf(fabsf(v1.x), fabsf(v1.y)), fmaxf(fabsf(v1.z), fabsf(v1.w))))); \
                v4u hi; hi.x = pk2(v0.x, v0.y); hi.y = pk2(v0.z, v0.w); hi.z = pk2(v1.x, v1.y); hi.w = pk2(v1.z, v1.w); \
                v4u lo; lo.x = pk2(v0.x - bflo(hi.x), v0.y - bfhi(hi.x)); lo.y = pk2(v0.z - bflo(hi.y), v0.w - bfhi(hi.y)); lo.z = pk2(v1.x - bflo(hi.z), v1.y - bfhi(hi.z)); lo.w = pk2(v1.z - bflo(hi.w), v1.w - bfhi(hi.w)); \
                const bf16x8 wh = *(const LAS bf16x8*)(WH + ((sk * 4 + kg) * 16 + tq) * 8), wl = *(const LAS bf16x8*)(WL + ((sk * 4 + kg) * 16 + tq) * 8); \
                const bf16x8 ah = __builtin_bit_cast(bf16x8, hi), al = __builtin_bit_cast(bf16x8, lo); \
                acc = __builtin_amdgcn_mfma_f32_16x16x32_bf16(ah, wh, acc, 0, 0, 0); acc = __builtin_amdgcn_mfma_f32_16x16x32_bf16(al, wh, acc, 0, 0, 0); acc = __builtin_amdgcn_mfma_f32_16x16x32_bf16(ah, wl, acc, 0, 0, 0); } } while (0)
#define RT_P2(buf, c) do { _Pragma("unroll") for (int s8 = 0; s8 < 8; ++s8) { const int sk = 8 * (c) + s8; \
                const f32x4 g0 = *(const LAS f32x4*)(GL + 32 * sk + 8 * kg) * qi, g1 = *(const LAS f32x4*)(GL + 32 * sk + 8 * kg + 4) * qi; \
                v4u r_ = buf[s8]; asm volatile("" : "+v"(r_.x), "+v"(r_.y), "+v"(r_.z), "+v"(r_.w));        \
                const f32x4 x0 = RT_X0(r_), x1 = RT_X1(r_); u32x2 o; o.x = q8x4(x0.x * g0.x, x0.y * g0.y, x0.z * g0.z, x0.w * g0.w); o.y = q8x4(x1.x * g1.x, x1.y * g1.y, x1.z * g1.z, x1.w * g1.w); \
                *(u32x2*)(orow + 32 * sk) = o; } } while (0)
#define SB __builtin_amdgcn_sched_barrier(0)
    if (tfirst < T / 16) { const bf16* xr = x + (size_t)(16 * (tfirst + (F.wave >> 1)) + tq) * DM + 8 * kg; RT_LOAD(xa, c0); RT_LOAD(xb, c1); }
    SB;
#pragma unroll
    for (int kh = 0; kh < 2; ++kh) {   f32x4 wv[4];
#pragma unroll
        for (int k = 0; k < 4; ++k) wv[k] = ((const f32x4*)wr)[F.tid + 512 * (4 * kh + k)];
#pragma unroll
        for (int k = 0; k < 4; ++k) { const int i4 = F.tid + 512 * (4 * kh + k), d = i4 >> 2, e0 = (i4 & 3) * 4; const int base = (((d >> 5) * 4 + ((d >> 3) & 3)) * 16) * 8 + (d & 7);
#pragma unroll
            for (int c = 0; c < 4; ++c) { const float w = wv[k][c]; const unsigned hi = pk2(w, 0.f) & 0xffffu; const float lo = w - bflo(hi);
                WH[base + (e0 + c) * 8] = (unsigned short)hi; WL[base + (e0 + c) * 8] = (unsigned short)(pk2(lo, 0.f) & 0xffffu); } } }
    for (int i = F.tid; i < DM / 4; i += NWAVES * 64) ((LAS f32x4*)GL)[i] = ((const f32x4*)gain)[i];
    __syncthreads();
#pragma unroll 1
    for (int t0 = tfirst; t0 < T / 16; t0 += F.G * 4) {
        const int tile = t0 + (F.wave >> 1), token = 16 * tile + tq; const bf16* xr = x + (size_t)token * DM + 8 * kg;
        if (t0 != tfirst) { RT_LOAD(xa, c0); RT_LOAD(xb, c1); }
        f32x4 acc = {0.f, 0.f, 0.f, 0.f}; float ss = 0.f, mx = 0.f;
        SB; RT_P1(xa, c0); SB; RT_P1(xb, c1); SB;
        ss += __shfl_xor(ss, 16); ss += __shfl_xor(ss, 32); mx = fmaxf(mx, __shfl_xor(mx, 16)); mx = fmaxf(mx, __shfl_xor(mx, 32));
        {   LAS float* ex = EX + (F.wave * 64 + lane) * 8; *(LAS f32x4*)ex = acc; *(LAS f32x2_t*)(ex + 4) = (f32x2_t){ss, mx}; }
        __syncthreads();
        {   const LAS float* ex = EX + ((F.wave ^ 1) * 64 + lane) * 8; const f32x4 pa = *(const LAS f32x4*)ex; const f32x2_t pm = *(const LAS f32x2_t*)(ex + 4); acc += pa; ss += pm.x; mx = fmaxf(mx, pm.y); }
        const float rstd = rsqrtf(ss * (1.f / DM) + EPS);
#pragma unroll
        for (int rr = 0; rr < 2; ++rr) { const int r = 2 * kh + rr; const float l = (kh ? acc[2 + rr] : acc[rr]) * __shfl(rstd, 4 * kg + r);
            float m = l; m = fmaxf(m, __shfl_xor(m, 1)); m = fmaxf(m, __shfl_xor(m, 2)); m = fmaxf(m, __shfl_xor(m, 4)); m = fmaxf(m, __shfl_xor(m, 8));
            const float p = __expf(l - m); float den = p; den += __shfl_xor(den, 1); den += __shfl_xor(den, 2); den += __shfl_xor(den, 4); den += __shfl_xor(den, 8);
            AFF[(size_t)(16 * tile + 4 * kg + r) * 16 + tq] = p / den; }
        const float qi = mx > 0.f ? 127.f / mx : 0.f;
        signed char* orow = H8 + (size_t)token * DM + 8 * kg;
        SB; RT_P2(xa, c0); SB; RT_P2(xb, c1);
        if (kg == 0 && kh == 0) HS[token] = mx * rstd * (1.f / 127.f);
        __syncthreads();
    }
#undef SB
#undef RT_LOAD
#undef RT_X0
#undef RT_X1
#undef RT_P1
#undef RT_P2
}

__device__ __forceinline__ int block_excl_scan(Frame& F, const int v, LAS int* wsum) {
    int inc = v;
#pragma unroll
    for (int o = 1; o < 64; o <<= 1) { const int t = __shfl_up(inc, o); if (F.lane >= o) inc += t; }
    if (F.lane == 63) wsum[F.wave] = inc;
    __syncthreads();
    int off = 0;
#pragma unroll
    for (int w = 0; w < NWAVES; ++w) off += (w < F.wave) ? wsum[w] : 0;
    __syncthreads();
    return off + inc - v;
}
__device__ __forceinline__ void phase_topk(Frame& F, const Args& a) {
    unsigned char* ws = F.ws; const float* AFF = (const float*)(ws + WS_AFF); const signed char* H8 = (const signed char*)(ws + WS_H); const float* HS = (const float*)(ws + WS_HS);
    int* IDX = (int*)(ws + WS_IDX); float* GW = (float*)(ws + WS_GW); int* SLOT = (int*)(ws + WS_SLOT); signed char* XIN = (signed char*)(ws + WS_XIN); float* XS = (float*)(ws + WS_XS);
    LAS int* hist = (LAS int*)(F.lds + RING_OFF);
    LAS int* res = hist + 256;
    LAS int* wsum = hist + 272;
    LAS int* cnt = hist + 288;
    LAS int* selt = hist + 512;
    LAS int* selr = hist + 1024;
    const int tid = F.tid, lane = F.lane;
#pragma unroll 1
    for (int u = F.vcu; u < NB * NE * 2; u += F.G) {
        const int half = u & 1, be = u >> 1, b = be >> 4, e = be & 15;
        unsigned key[4];
#pragma unroll
        for (int i = 0; i < 4; ++i) key[i] = __float_as_uint(AFF[(size_t)(b * SEQ + 4 * tid + i) * 16 + e]);
        unsigned prefix = 0; int k = CAP; int one = 1; asm volatile("" : "+v"(one));
#pragma unroll
        for (int pass = 0; pass < 4; ++pass) { const int shift = 24 - 8 * pass;
            __syncthreads();
            if (tid < 256) hist[tid] = 0;
            if (tid == 0) cnt[0] = 0;
            __syncthreads();
#pragma unroll
            for (int i = 0; i < 4; ++i) if (pass == 0 || (key[i] >> (shift + 8)) == prefix) __hip_atomic_fetch_add(&hist[(key[i] >> shift) & 255], one, __ATOMIC_RELAXED, __HIP_MEMORY_SCOPE_WORKGROUP);
            __syncthreads();
            if (F.wave == 0) {
                const int c0 = hist[4 * lane], c1 = hist[4 * lane + 1], c2 = hist[4 * lane + 2], c3 = hist[4 * lane + 3]; const int t = (c0 + c1) + (c2 + c3);
                int suf = t;
#pragma unroll
                for (int o = 1; o < 64; o <<= 1) { const int v = __shfl_down(suf, o); if (lane + o < 64) suf += v; }
                int cum = suf - t;
                if (cum < k && cum + t >= k) { int d = 3;
                    if (cum + c3 >= k) d = 3; else { cum += c3; if (cum + c2 >= k) d = 2; else { cum += c2; if (cum + c1 >= k) d = 1; else { cum += c1; d = 0; } } }
                    res[0] = 4 * lane + d; res[1] = k - cum; }
            }
            __syncthreads();
            prefix = (prefix << 8) | (unsigned)res[0]; k = res[1];
        }
        int eqc = 0;
#pragma unroll
        for (int i = 0; i < 4; ++i) eqc += (key[i] == prefix) ? 1 : 0;
        int eqpre = block_excl_scan(F, eqc, wsum);
        int selc = 0; bool sel[4];
#pragma unroll
        for (int i = 0; i < 4; ++i) { const bool eq = key[i] == prefix; sel[i] = key[i] > prefix || (eq && eqpre < k); eqpre += eq ? 1 : 0; selc += sel[i] ? 1 : 0; }
        int pre = block_excl_scan(F, selc, wsum);
        if ((tid >> 8) == half) {
            int sl[4];
#pragma unroll
            for (int i = 0; i < 4; ++i) { sl[i] = -1;
                if (sel[i]) { sl[i] = pre; const int row = (e * NB + b) * CAP + pre, tok = b * SEQ + 4 * tid + i; IDX[row] = tok; GW[row] = __uint_as_float(key[i]);
                    const int p = __hip_atomic_fetch_add(cnt, 1, __ATOMIC_RELAXED, __HIP_MEMORY_SCOPE_WORKGROUP); selt[p] = tok; selr[p] = row; ++pre; } }
            *(int4*)(SLOT + (size_t)(b * NE + e) * SEQ + 4 * tid) = make_int4(sl[0], sl[1], sl[2], sl[3]);
        }
        __syncthreads();
        const int n = cnt[0];
#pragma unroll 1
        for (int i0 = 4 * F.wave; i0 < n; i0 += 4 * NWAVES) {
            v4u r[4]; float sc[4]; int row[4];
#pragma unroll
            for (int j = 0; j < 4; ++j) { const int ii = (i0 + j < n) ? i0 + j : n - 1; const int tok = selt[ii]; row[j] = selr[ii]; r[j] = ((const v4u*)(H8 + (size_t)tok * DM))[lane]; sc[j] = HS[tok]; }
#pragma unroll
            for (int j = 0; j < 4; ++j) { ((v4u*)(XIN + (size_t)row[j] * DM))[lane] = r[j]; if (lane == 0) XS[row[j]] = sc[j]; }
        }
    }
    __syncthreads();
}

struct CmbIn { f32x4 v[4]; int sl; };
__device__ __forceinline__ void cmb_load(CmbIn& I, const int t, const int lane, const bf16* x, const int* SLOT) {
    const int b = t / SEQ, s = t % SEQ; const u32x2* xr = (const u32x2*)(x + (size_t)t * DM) + lane;
#pragma unroll
    for (int j = 0; j < 4; ++j) { const u32x2 r = xr[64 * j]; I.v[j] = (f32x4){bflo(r.x), bfhi(r.x), bflo(r.y), bfhi(r.y)}; }
    I.sl = SLOT[(size_t)(b * NE + (lane & 15)) * SEQ + s];
}
__device__ __forceinline__ void cmb_add_rows(CmbIn& I, const int t, const int lane, const bf16* Y) {
    const int b = t / SEQ;
    unsigned m = (unsigned)(__ballot(I.sl >= 0) & 0xffffull);
    while (m) {
        const int e0 = __builtin_ctz(m); m &= m - 1; const int e1 = m ? __builtin_ctz(m) : e0; const bool two = m != 0; m &= m - 1;
        const int s0 = __builtin_amdgcn_readlane(I.sl, e0), s1 = __builtin_amdgcn_readlane(I.sl, e1);
        const u32x2* y0 = (const u32x2*)(Y + ((size_t)(e0 * NB + b) * CAP + s0) * DM) + lane; const u32x2* y1 = (const u32x2*)(Y + ((size_t)(e1 * NB + b) * CAP + s1) * DM) + lane;
        u32x2 a[4], c[4];
#pragma unroll
        for (int j = 0; j < 4; ++j) { a[j] = y0[64 * j]; c[j] = y1[64 * j]; }
#pragma unroll
        for (int j = 0; j < 4; ++j) { I.v[j].x += bflo(a[j].x); I.v[j].y += bfhi(a[j].x); I.v[j].z += bflo(a[j].y); I.v[j].w += bfhi(a[j].y);
            if (two) { I.v[j].x += bflo(c[j].x); I.v[j].y += bfhi(c[j].x); I.v[j].z += bflo(c[j].y); I.v[j].w += bfhi(c[j].y); } }
    }
}
__device__ __forceinline__ void cmb_finish(CmbIn& I, const int t, const int lane, bf16* x, float* outf, const float* gain, const bool final_, signed char* H8, float* HS) {
    u32x2* xr = (u32x2*)(x + (size_t)t * DM) + lane; f32x4* fr_ = (f32x4*)(outf + (size_t)t * DM) + lane; const f32x4* gr = (const f32x4*)gain + lane;
    float ss = 0.f;
#pragma unroll
    for (int j = 0; j < 4; ++j) ss += (I.v[j].x * I.v[j].x + I.v[j].y * I.v[j].y) + (I.v[j].z * I.v[j].z + I.v[j].w * I.v[j].w);
    const float rstd = rsqrtf(wave_sum(ss) * (1.f / DM) + EPS);
    if (!final_) {
#pragma unroll
        for (int j = 0; j < 4; ++j) { const f32x4 g = gr[64 * j]; u32x2 xo; xo.x = pk2(I.v[j].x, I.v[j].y); xo.y = pk2(I.v[j].z, I.v[j].w); xr[64 * j] = xo; I.v[j].x *= rstd * g.x; I.v[j].y *= rstd * g.y; I.v[j].z *= rstd * g.z; I.v[j].w *= rstd * g.w; }
        quant_row_store(I.v, H8 + (size_t)t * DM, HS + t, lane); }
    else {
#pragma unroll
        for (int j = 0; j < 4; ++j) { const f32x4 g = gr[64 * j]; f32x4 o; o.x = I.v[j].x * rstd * g.x; o.y = I.v[j].y * rstd * g.y; o.z = I.v[j].z * rstd * g.z; o.w = I.v[j].w * rstd * g.w; fr_[64 * j] = o; } }
}
__device__ __forceinline__ void phase_combine_norm(Frame& F, const Args& a, int layer) {
    unsigned char* ws = F.ws; bf16* x = (bf16*)(ws + WS_XB); const bf16* Y = (const bf16*)(ws + WS_Y); const int* SLOT = (const int*)(ws + WS_SLOT); signed char* H8 = (signed char*)(ws + WS_H); float* HS = (float*)(ws + WS_HS);
    const bool final_ = (layer + 1 == DEPTH); const float* gain = final_ ? a.in[12] : a.in[6] + (size_t)(layer + 1) * DM;
    const int gw = F.vcu * NWAVES + F.wave, NGW = F.G * NWAVES, lane = F.lane;
#pragma unroll 1
    for (int t = gw; t < T; t += 2 * NGW) {
        CmbIn A, B; const int t2 = t + NGW; const bool two = t2 < T;
        cmb_load(A, t, lane, x, SLOT); cmb_load(B, two ? t2 : t, lane, x, SLOT);
        cmb_add_rows(A, t, lane, Y); if (two) cmb_add_rows(B, t2, lane, Y);
        cmb_finish(A, t, lane, x, a.out, gain, final_, H8, HS); if (two) cmb_finish(B, t2, lane, x, a.out, gain, final_, H8, HS);
    }
}

typedef short s16x4 __attribute__((ext_vector_type(4)));
constexpr int AT_ROWB = 128;
constexpr int AT_KOFF = 0, AT_VOFF = 256 * AT_ROWB, AT_BUF = 2 * 256 * AT_ROWB;
#define LDS_BAR() do { asm volatile("s_waitcnt lgkmcnt(0)" ::: "memory"); __builtin_amdgcn_s_barrier(); asm volatile("" ::: "memory"); } while (0)
struct AttnPre { v4u k[4], v[4]; bf16x8 q0, q1; };
__device__ __forceinline__ void attn_decode(const int su, int& g, int& b, int& h, int& r, int& u, int& dsh) {
    const int x = su & 15; h = (su >> 4) & 7; b = (su >> 7) & 7; g = su >> 10; dsh = 2 * g; r = x & ((1 << dsh) - 1); u = x >> dsh;
}
__device__ __forceinline__ void attn_issue(Frame& F, const int su, const bf16* __restrict__ PROJ, AttnPre& P) {
    int g, b, h, r, u, dsh; attn_decode(su, g, b, h, r, u, dsh); const int d = 1 << dsh, L = SEQ >> dsh;
    const bf16* kbase = PROJ + PO_ATT + ((((size_t)(g * 3 + 1) * 8 + b) * 8 + h) * 2048 + (size_t)r * L) * 64;
    constexpr size_t PART = (size_t)8 * 8 * 2048 * 64;
#pragma unroll
    for (int p = 0; p < 4; ++p) { const int idx = F.tid + 512 * p, kk = idx >> 3, ch = idx & 7;
        int lp = 128 * u - 64 + kk; lp = lp < 0 ? 0 : (lp > L - 1 ? L - 1 : lp);
        const bf16* src = kbase + (size_t)lp * 64 + ch * 8;
        P.k[p] = *(const v4u*)src; P.v[p] = *(const v4u*)(src + PART); }
    const int lq = 128 * u + 16 * F.wave + (F.lane & 15);
    const bf16* qp = kbase - PART + (size_t)lq * 64 + 8 * (F.lane >> 4);
    P.q0 = *(const bf16x8*)qp; P.q1 = *(const bf16x8*)(qp + 32);
}
__device__ __forceinline__ void attn_stage(Frame& F, const AttnPre& P, const int boff) {
    LAS unsigned char* Ks = F.lds + RING_OFF + boff + AT_KOFF; LAS unsigned char* Vs = F.lds + RING_OFF + boff + AT_VOFF;
#pragma unroll
    for (int p = 0; p < 4; ++p) { const int idx = F.tid + 512 * p, kk = idx >> 3, ch = idx & 7, o = kk * AT_ROWB + ((ch ^ (kk & 7)) << 4);
        *(LAS v4u*)(Ks + o) = P.k[p]; *(LAS v4u*)(Vs + o) = P.v[p]; }
}
__device__ __forceinline__ void attn_compute(Frame& F, const int su, const bf16x8 qf0, const bf16x8 qf1, bf16* __restrict__ ATTO, float* __restrict__ LSEb, const int boff) {
    int g, b, h, r, u, dsh; attn_decode(su, g, b, h, r, u, dsh); const int d = 1 << dsh, L = SEQ >> dsh;
    const int lane = F.lane, w = F.wave, q = lane & 15, kg = lane >> 4;
    LAS unsigned char* Ks = F.lds + RING_OFF + boff + AT_KOFF; LAS unsigned char* Vs = F.lds + RING_OFF + boff + AT_VOFF;
    const int lq = 128 * u + 16 * w + q; const size_t tokq = (size_t)(b * SEQ + lq * d + r);
    f32x4 sc[9];
    {   const LAS unsigned char* kp = Ks + (16 * w + q) * AT_ROWB; const int ko0 = (kg ^ (q & 7)) << 4, ko1 = ko0 ^ 64;
#pragma unroll
        for (int hb = 0; hb < 2; ++hb) { bf16x8 kf[5][2];
#pragma unroll
            for (int i = 0; i < 5; ++i) if (5 * hb + i < 9) { kf[i][0] = *(const LAS bf16x8*)(kp + (5 * hb + i) * 16 * AT_ROWB + ko0); kf[i][1] = *(const LAS bf16x8*)(kp + (5 * hb + i) * 16 * AT_ROWB + ko1); }
            __builtin_amdgcn_sched_barrier(0);
#pragma unroll
            for (int i = 0; i < 5; ++i) if (5 * hb + i < 9) sc[5 * hb + i] = __builtin_amdgcn_mfma_f32_16x16x32_bf16(kf[i][0], qf0, (f32x4){0.f, 0.f, 0.f, 0.f}, 0, 0, 0);
#pragma unroll
            for (int i = 0; i < 5; ++i) if (5 * hb + i < 9) sc[5 * hb + i] = __builtin_amdgcn_mfma_f32_16x16x32_bf16(kf[i][1], qf1, sc[5 * hb + i], 0, 0, 0);
            __builtin_amdgcn_sched_barrier(0); } }
    const float c1 = 0.125f * 1.4426950408889634f, c2 = __builtin_amdgcn_exp2f(-(float)(h + 1)) * (float)d * 1.4426950408889634f;
    float ce[4], ae[4]; bool ge0[4], le0[4];
#pragma unroll
    for (int rr = 0; rr < 4; ++rr) { const int e = 4 * kg + rr - q; ce[rr] = c2 * (float)e; ae[rr] = -c2 * (float)(e < 0 ? -e : e); ge0[rr] = e >= 0; le0[rr] = e <= 0; }
    float mx = -INFINITY;
#pragma unroll
    for (int i = 0; i < 9; ++i) { const bool ok = (unsigned)(128 * u - 64 + 16 * (w + i)) < (unsigned)L;
        const float ki = -c2 * (float)(i < 4 ? 64 - 16 * i : 16 * i - 64);
#pragma unroll
        for (int rr = 0; rr < 4; ++rr) { float v = (i < 4) ? (sc[i][rr] * c1 + ce[rr]) + ki : (i == 4) ? sc[i][rr] * c1 + ae[rr] : (sc[i][rr] * c1 - ce[rr]) + ki;
            bool val = ok; if (i == 0) val = val && ge0[rr]; if (i == 8) val = val && le0[rr];
            v = val ? v : -INFINITY; sc[i][rr] = v; mx = fmaxf(mx, v); } }
    mx = fmaxf(mx, __shfl_xor(mx, 16)); mx = fmaxf(mx, __shfl_xor(mx, 32));
    float sum = 0.f; s16x4 pf[9];
#pragma unroll
    for (int i = 0; i < 9; ++i) { const float p0 = __builtin_amdgcn_exp2f(sc[i][0] - mx), p1 = __builtin_amdgcn_exp2f(sc[i][1] - mx), p2 = __builtin_amdgcn_exp2f(sc[i][2] - mx), p3 = __builtin_amdgcn_exp2f(sc[i][3] - mx);
        sum += (p0 + p1) + (p2 + p3); const unsigned lo = pk2(p0, p1), hi = pk2(p2, p3);
        pf[i] = (s16x4){(short)(lo & 0xffff), (short)(lo >> 16), (short)(hi & 0xffff), (short)(hi >> 16)}; }
    sum += __shfl_xor(sum, 16); sum += __shfl_xor(sum, 32);
    const float inv = 1.f / sum;
    const LAS unsigned char* vp = Vs + (16 * w + 4 * kg + (q >> 2)) * AT_ROWB + 8 * (q & 1); const int vm = (4 * kg + (q >> 2)) & 7, vc = (q & 3) >> 1;
    bf16* op = ATTO + ((size_t)g * T + tokq) * AW + h * 64 + 4 * kg;
#pragma unroll
    for (int dh = 0; dh < 2; ++dh) { s16x4 vf[2][9];
#pragma unroll
        for (int dd = 0; dd < 2; ++dd)
#pragma unroll
            for (int i = 0; i < 9; ++i) vf[dd][i] = __builtin_bit_cast(s16x4, __builtin_amdgcn_ds_read_tr16_b64_v4i16((LAS s16x4*)(vp + i * 16 * AT_ROWB + (((2 * (2 * dh + dd) + vc) ^ vm) << 4))));
        __builtin_amdgcn_sched_barrier(0);
        f32x4 acc[2] = {{0.f, 0.f, 0.f, 0.f}, {0.f, 0.f, 0.f, 0.f}};
#pragma unroll
        for (int i = 0; i < 9; ++i) { acc[0] = __builtin_amdgcn_mfma_f32_16x16x16bf16_1k(vf[0][i], pf[i], acc[0], 0, 0, 0); acc[1] = __builtin_amdgcn_mfma_f32_16x16x16bf16_1k(vf[1][i], pf[i], acc[1], 0, 0, 0); }
#pragma unroll
        for (int dd = 0; dd < 2; ++dd) { u32x2 o; o.x = pk2(acc[dd][0] * inv, acc[dd][1] * inv); o.y = pk2(acc[dd][2] * inv, acc[dd][3] * inv);
            *(u32x2*)(op + 16 * (2 * dh + dd)) = o; } }
    if (kg == 0) LSEb[((size_t)g * T + tokq) * 8 + h] = (mx + __log2f(sum)) * 0.6931471805599453f;
}
__device__ __forceinline__ void phase_attn(Frame& F, const Args& a) {
    unsigned char* ws = F.ws; const bf16* PROJ = (const bf16*)(ws + WS_PROJ);
    constexpr int NSU = 3 * NB * 8 * 16;
    AttnPre P;
    bf16x8 qc0, qc1;
    if (F.vcu < NSU) { attn_issue(F, F.vcu, PROJ, P); attn_stage(F, P, 0); qc0 = P.q0; qc1 = P.q1; if (F.vcu + F.G < NSU) attn_issue(F, F.vcu + F.G, PROJ, P); }
    LDS_BAR();
#pragma unroll 1
    for (int su = F.vcu, par = 0; su < NSU; su += F.G, par ^= 1) {
        bf16x8 qn0 = qc0, qn1 = qc1;
        if (su + F.G < NSU) { attn_stage(F, P, (par ^ 1) * AT_BUF); qn0 = P.q0; qn1 = P.q1;
            if (su + 2 * F.G < NSU) attn_issue(F, su + 2 * F.G, PROJ, P); }
        attn_compute(F, su, qc0, qc1, (bf16*)(ws + WS_ATTO), (float*)(ws + WS_LSE), par * AT_BUF);
        LDS_BAR();
        qc0 = qn0; qc1 = qn1;
    }
    __syncthreads();
}
constexpr int RT_ROWB = 528, RT_ROWS = 144, RT_KB = 64 * RT_ROWB, RT_VB = 64 * RT_ROWS;
constexpr int RT_K = 0, RT_S = 2 * RT_KB, RT_V = 3 * RT_KB, RT_P = RT_V + 2 * RT_VB, RT_END = RT_P + RT_VB;
static_assert(RT_END <= RING_BYTES, "retention LDS map");
__device__ __forceinline__ void ret_unit(Frame& F, const int unit, const bf16* __restrict__ PROJ, const float* __restrict__ dlog, bf16* __restrict__ YF, bf16* __restrict__ YB) {
    const int dvs = unit & 3, dir = (unit >> 2) & 1, h = (unit >> 3) & 3, b = unit >> 5;
    const int tid = F.tid, lane = F.lane, w = F.wave, fr = lane & 15, kg = lane >> 4;
    LAS unsigned char* L0 = F.lds + RING_OFF;
    const float lg = -log1pf(expf(-dlog[dir * 4 + h]));
    const float gC = __expf(lg * 64.f);
    const int srow = tid >> 5, sch = tid & 31, vrow = tid >> 3, vch = tid & 7;
    float zeta[4];
#pragma unroll
    for (int p = 0; p < 4; ++p) { const int m = srow + 16 * p; zeta[p] = __expf(lg * (float)(dir ? m : 63 - m)); }
    const int qt = w >> 1, half = w & 1;
    const int nq = 16 * qt + fr;
    const float rho = __expf(lg * (float)(dir ? -nq : nq - 63)) * 0.0625f;
    const bf16* qbase = PROJ + PO_RQK + ((size_t)(b * 4 + h) * 2048 + nq) * 256 + 8 * kg;
    const bf16* colk = PROJ + PO_RQK + (size_t)T * RW + ((size_t)(b * 4 + h) * 2048) * 256 + sch * 8; const bf16* colv = PROJ + PO_RV + (((size_t)(b * 4 + h) * 4 + dvs) * 2048) * 64 + vch * 8;
    bf16* Yo = (dir ? YB : YF) + h * 256 + dvs * 64;
    __syncthreads();
    { unsigned z = 0u; asm volatile("" : "+v"(z));
      for (int i = tid; i < 64 * RT_ROWB / 16; i += NWAVES * 64) ((LAS v4u*)(L0 + RT_S))[i] = (v4u){z, z, z, z}; }
    f32x4 st[2][4];
#pragma unroll
    for (int a = 0; a < 2; ++a)
#pragma unroll
        for (int c = 0; c < 4; ++c) st[a][c] = (f32x4){0.f, 0.f, 0.f, 0.f};
    v4u pk[4], pv; bf16x8 qc[8], qn[8];
#define RET_LOADKV(ci_) do { const size_t t0_ = (size_t)64 * (ci_); _Pragma("unroll") for (int p = 0; p < 4; ++p) pk[p] = *(const v4u*)(colk + (t0_ + srow + 16 * p) * 256); pv = *(const v4u*)(colv + (t0_ + vrow) * 64); } while (0)
#define RET_LOADQ(dst, ci_) do { const bf16* qg_ = qbase + ((size_t)64 * (ci_)) * 256; _Pragma("unroll") for (int s = 0; s < 8; ++s) dst[s] = *(const bf16x8*)(qg_ + 32 * s); } while (0)
#define RET_STAGE(bf_) do { LAS unsigned char* kb_ = L0 + RT_K + (bf_) * RT_KB; _Pragma("unroll") for (int p = 0; p < 4; ++p) { const int row = srow + 16 * p; const float z = zeta[p]; v4u kk = pk[p]; \
            kk.x = pk2(bflo(kk.x) * z, bfhi(kk.x) * z); kk.y = pk2(bflo(kk.y) * z, bfhi(kk.y) * z); kk.z = pk2(bflo(kk.z) * z, bfhi(kk.z) * z); kk.w = pk2(bflo(kk.w) * z, bfhi(kk.w) * z); \
            *(LAS v4u*)(kb_ + row * RT_ROWB + sch * 16) = kk; } \
        LAS unsigned short* vt = (LAS unsigned short*)(L0 + RT_V + (bf_) * RT_VB) + vrow; \
        vt[(8 * vch + 0) * 72] = (unsigned short)(pv.x & 0xffff); vt[(8 * vch + 1) * 72] = (unsigned short)(pv.x >> 16); \
        vt[(8 * vch + 2) * 72] = (unsigned short)(pv.y & 0xffff); vt[(8 * vch + 3) * 72] = (unsigned short)(pv.y >> 16); \
        vt[(8 * vch + 4) * 72] = (unsigned short)(pv.z & 0xffff); vt[(8 * vch + 5) * 72] = (unsigned short)(pv.z >> 16); \
        vt[(8 * vch + 6) * 72] = (unsigned short)(pv.w & 0xffff); vt[(8 * vch + 7) * 72] = (unsigned short)(pv.w >> 16); } while (0)
    {   const int cf = dir ? 31 : 0, cs = dir ? 30 : 1;
        RET_LOADKV(cf); RET_LOADQ(qc, cf); RET_STAGE(0); RET_LOADKV(cs); }
    LDS_BAR();
#pragma unroll 1
    for (int step = 0; step < 32; ++step) {
        const int ci = dir ? 31 - step : step, cur = step & 1;
        const LAS unsigned char* Kc = L0 + RT_K + cur * RT_KB; const LAS unsigned char* Vc = L0 + RT_V + cur * RT_VB;
        if (step + 1 < 32) { RET_STAGE(cur ^ 1); if (step + 2 < 32) RET_LOADKV(dir ? ci - 2 : ci + 2); RET_LOADQ(qn, dir ? ci - 1 : ci + 1); }
        {   bf16x8 kf[2][8];
            const LAS unsigned char* kp = Kc + (32 * half + fr) * RT_ROWB + 16 * kg;
#pragma unroll
            for (int s = 0; s < 8; ++s) { kf[0][s] = *(const LAS bf16x8*)(kp + 64 * s); kf[1][s] = *(const LAS bf16x8*)(kp + 16 * RT_ROWB + 64 * s); }
            f32x4 acc[2] = {{0.f, 0.f, 0.f, 0.f}, {0.f, 0.f, 0.f, 0.f}};
#pragma unroll
            for (int s = 0; s < 8; ++s) { acc[0] = __builtin_amdgcn_mfma_f32_16x16x32_bf16(kf[0][s], qc[s], acc[0], 0, 0, 0); acc[1] = __builtin_amdgcn_mfma_f32_16x16x32_bf16(kf[1][s], qc[s], acc[1], 0, 0, 0); }
#pragma unroll
            for (int j = 0; j < 2; ++j) { const int m0 = 32 * half + 16 * j + 4 * kg;
                float p0 = acc[j][0], p1 = acc[j][1], p2 = acc[j][2], p3 = acc[j][3];
                if (dir) { p0 = (m0 + 0 > nq) ? p0 : 0.f; p1 = (m0 + 1 > nq) ? p1 : 0.f; p2 = (m0 + 2 > nq) ? p2 : 0.f; p3 = (m0 + 3 > nq) ? p3 : 0.f; }
                else     { p0 = (m0 + 0 <= nq) ? p0 : 0.f; p1 = (m0 + 1 <= nq) ? p1 : 0.f; p2 = (m0 + 2 <= nq) ? p2 : 0.f; p3 = (m0 + 3 <= nq) ? p3 : 0.f; }
                u32x2 o; o.x = pk2(p0, p1); o.y = pk2(p2, p3);
                *(LAS u32x2*)(L0 + RT_P + nq * RT_ROWS + m0 * 2) = o; } }
        {   bf16x8 vf[4][2], kf[2][2];
#pragma unroll
            for (int c = 0; c < 4; ++c)
#pragma unroll
                for (int s = 0; s < 2; ++s) vf[c][s] = *(const LAS bf16x8*)(Vc + (16 * c + fr) * RT_ROWS + 64 * s + 16 * kg);
#pragma unroll
            for (int a = 0; a < 2; ++a)
#pragma unroll
                for (int s = 0; s < 2; ++s) {
                    const LAS unsigned char* tp = Kc + (32 * s + 8 * kg + (fr >> 2)) * RT_ROWB + (16 * (2 * w + a) + 4 * (fr & 3)) * 2;
                    const s16x4 lo = __builtin_bit_cast(s16x4, __builtin_amdgcn_ds_read_tr16_b64_v4i16((LAS s16x4*)tp));
                    const s16x4 hi = __builtin_bit_cast(s16x4, __builtin_amdgcn_ds_read_tr16_b64_v4i16((LAS s16x4*)(tp + 4 * RT_ROWB)));
                    kf[a][s] = (bf16x8){lo[0], lo[1], lo[2], lo[3], hi[0], hi[1], hi[2], hi[3]}; }
            __builtin_amdgcn_sched_barrier(0);
#pragma unroll
            for (int s = 0; s < 2; ++s)
#pragma unroll
                for (int a = 0; a < 2; ++a)
#pragma unroll
                    for (int c = 0; c < 4; ++c) st[a][c] = __builtin_amdgcn_mfma_f32_16x16x32_bf16(kf[a][s], vf[c][s], st[a][c], 0, 0, 0); }
        LDS_BAR();
        {   bf16x8 pf[2], vf[2][2];
            const LAS unsigned char* pp = L0 + RT_P + (16 * qt + fr) * RT_ROWS + 16 * kg; pf[0] = *(const LAS bf16x8*)pp; pf[1] = *(const LAS bf16x8*)(pp + 64);
            const LAS unsigned char* vp = Vc + (32 * half + fr) * RT_ROWS + 16 * kg;
            const LAS unsigned char* sp = L0 + RT_S + (32 * half + fr) * RT_ROWB + 16 * kg;
#pragma unroll
            for (int j = 0; j < 2; ++j) { vf[j][0] = *(const LAS bf16x8*)(vp + j * 16 * RT_ROWS); vf[j][1] = *(const LAS bf16x8*)(vp + j * 16 * RT_ROWS + 64); }
            f32x4 acc[2] = {{0.f, 0.f, 0.f, 0.f}, {0.f, 0.f, 0.f, 0.f}};
#pragma unroll
            for (int hs = 0; hs < 2; ++hs) { bf16x8 sf[2][4];
#pragma unroll
                for (int s = 0; s < 4; ++s) { sf[0][s] = *(const LAS bf16x8*)(sp + 64 * (4 * hs + s)); sf[1][s] = *(const LAS bf16x8*)(sp + 16 * RT_ROWB + 64 * (4 * hs + s)); }
                __builtin_amdgcn_sched_barrier(0);
                if (hs == 0) {
#pragma unroll
                    for (int s = 0; s < 2; ++s) { acc[0] = __builtin_amdgcn_mfma_f32_16x16x32_bf16(vf[0][s], pf[s], acc[0], 0, 0, 0); acc[1] = __builtin_amdgcn_mfma_f32_16x16x32_bf16(vf[1][s], pf[s], acc[1], 0, 0, 0); } }
#pragma unroll
                for (int s = 0; s < 4; ++s) { acc[0] = __builtin_amdgcn_mfma_f32_16x16x32_bf16(sf[0][s], qc[4 * hs + s], acc[0], 0, 0, 0); acc[1] = __builtin_amdgcn_mfma_f32_16x16x32_bf16(sf[1][s], qc[4 * hs + s], acc[1], 0, 0, 0); }
                __builtin_amdgcn_sched_barrier(0); }
            const size_t tok = (size_t)b * SEQ + 64 * ci + nq;
#pragma unroll
            for (int j = 0; j < 2; ++j) { u32x2 o; o.x = pk2(acc[j][0] * rho, acc[j][1] * rho); o.y = pk2(acc[j][2] * rho, acc[j][3] * rho);
                *(u32x2*)(Yo + tok * RW + 16 * (2 * half + j) + 4 * kg) = o; } }
        LDS_BAR();
#pragma unroll
        for (int a = 0; a < 2; ++a)
#pragma unroll
            for (int c = 0; c < 4; ++c) { st[a][c] *= gC; u32x2 o; o.x = pk2(st[a][c][0], st[a][c][1]); o.y = pk2(st[a][c][2], st[a][c][3]);
                *(LAS u32x2*)(L0 + RT_S + (16 * c + fr) * RT_ROWB + (16 * (2 * w + a) + 4 * kg) * 2) = o; }
        if (step + 1 < 32) {
#pragma unroll
            for (int s = 0; s < 8; ++s) qc[s] = qn[s]; }
    }
#undef RET_LOADKV
#undef RET_LOADQ
#undef RET_STAGE
    __syncthreads();
}
__device__ __forceinline__ void phase_mix(Frame& F, const Args& a, int layer) {
    unsigned char* ws = F.ws; const bf16* PROJ = (const bf16*)(ws + WS_PROJ);
#ifndef REP_RET
#define REP_RET 1
#define REP_ATTN 1
#endif
#pragma unroll 1
    for (int rr = 0; rr < REP_RET; ++rr)
#pragma unroll 1
    for (int unit = F.vcu; unit < NB * 4 * 4 * 2; unit += F.G) ret_unit(F, unit, PROJ, a.in[5] + layer * 8, (bf16*)(ws + WS_YF), (bf16*)(ws + WS_YB));
#pragma unroll 1
    for (int rr = 0; rr < REP_ATTN; ++rr) phase_attn(F, a);
}


constexpr int popc10(int m) { int c = 0; for (int k = 0; k < 10; ++k) c += (m >> k) & 1; return c; }
constexpr int REP0 = (REP_MASK >> 10) & 1, SLOTS_LAYER = NPH_LAYER + popc10(REP_MASK), NSLOTS = 1 + REP0 + DEPTH * SLOTS_LAYER;
__device__ __forceinline__ int slot_phase(int slot) {
#if REP_MASK
    if (slot <= REP0) return 0;
    const int s = slot - 1 - REP0, layer = s / SLOTS_LAYER; int j = s % SLOTS_LAYER, k = 0;
    for (;;) { const int n = 1 + ((REP_MASK >> k) & 1); if (j < n) break; j -= n; ++k; }
    return 1 + layer * NPH_LAYER + k;
#else
    return slot;
#endif
}
__global__ void __launch_bounds__(NWAVES * 64, 2) mega(Args args) {
    extern __shared__ __attribute__((aligned(16))) unsigned char lds[];
    Frame F;
    F.lds = (LAS unsigned char*)lds; F.MISC = (volatile LAS unsigned*)(F.lds + MISC_OFF);
    F.tid = threadIdx.x; F.lane = F.tid & 63; F.wave = __builtin_amdgcn_readfirstlane(F.tid >> 6);
    F.G = gridDim.x;
    unsigned char* ws = args.ws; F.ctl = (unsigned*)(ws + WS_CTL);
    for (int u = F.tid; u < (LDS_BYTES - LDSCTL_OFF) / 4; u += NWAVES * 64) ((LAS unsigned*)(F.lds + LDSCTL_OFF))[u] = 0u;
    __syncthreads();
    if (F.tid == 0) {
        unsigned* cen = F.ctl + CW_CENSUS; const unsigned x = xb_xcc_id(); const unsigned slot = xb_add(&cen[64 * x], 1u);
        unsigned cnt[16]; unsigned sum = 0, sp = 0;
        for (;;) { sum = 0;
#pragma unroll
            for (int j = 0; j < 16; ++j) { cnt[j] = xb_ld(&cen[64 * j]); sum += cnt[j]; }
            if (sum == (unsigned)F.G || ++sp > (1u << 20)) break; __builtin_amdgcn_s_sleep(1); }
        unsigned pop = 0, ord = 0; bool even = (sum == (unsigned)F.G) && (F.G % 8 == 0);
#pragma unroll
        for (int j = 0; j < 16; ++j) { if (cnt[j]) { ++pop; if ((unsigned)j < x) ++ord; if (cnt[j] != (unsigned)F.G / 8) even = false; } }
        even = even && pop == 8;
        F.MISC[0] = even ? slot * 8 + ord : blockIdx.x;
        F.MISC[1] = even ? ord * (F.G / 8) + slot : blockIdx.x;
        F.MISC[2] = even ? 1u : 0u; F.MISC[3] = x;
    }
    __syncthreads();
    const int cid0 = __builtin_amdgcn_readfirstlane((int)F.MISC[0]), vcu0 = __builtin_amdgcn_readfirstlane((int)F.MISC[1]); F.cid = cid0; F.vcu = vcu0;
    const bool multi = !USE_CG_SYNC && (args.ph_hi - args.ph_lo) > 1;
    XcdBarrier bar; bar.bar = F.ctl + CW_BAR; bar.x = 0; bar.st = nullptr;
    if (multi) bar = xcd_barrier_post(F.ctl + CW_BAR, F.MISC + 8);
#pragma unroll 1
    for (int slot = args.ph_lo; slot < args.ph_hi; ++slot) {
        const int ph = slot_phase(slot);
        GAS unsigned char* wsg = (GAS unsigned char*)args.ws; asm volatile("" : "+s"(wsg)); unsigned char* ws = (unsigned char*)wsg; F.ws = ws;
        { int v_ = vcu0, c_ = cid0, g_ = (int)gridDim.x; asm volatile("" : "+s"(v_), "+s"(c_), "+s"(g_)); F.vcu = v_; F.cid = c_; F.G = g_; }
        { int tid_ = threadIdx.x; asm volatile("" : "+v"(tid_)); F.tid = tid_; F.lane = tid_ & 63; F.wave = __builtin_amdgcn_readfirstlane(tid_ >> 6); }
        {
        if (ph == 0) phase_p0(F, args);
        else {
            const int layer = (ph - 1) / NPH_LAYER, k = (ph - 1) % NPH_LAYER;
            if (k == 0) {
                pg8::Gemm g{(const pg8::bf16_t*)(ws + WS_H), (const pg8::bf16_t*)(ws + WS_WIN) + (size_t)layer * NIN * (DM / 2), T, NIN, DM / 2, 30, 0}; pg8::StaticOrder S; S.init(T, NIN, F.G, F.cid);
                pg8::EpiStoreI8 E{(pg8::bf16_t*)(ws + WS_PROJ), NIN, (const float*)(ws + WS_HS), (const float*)(ws + WS_WINS) + (size_t)layer * NIN};
                pg8::gemm_phase<pg8::EpiStoreI8, pg8::StaticOrder, true, true, 1>(F.lds + RING_OFF, g, S, E, F.tid);
            } else if (k == 1) phase_mix(F, args, layer); else if (k == 2) phase_finalize(F, args);
            else if (k == 3) {
                pg8::Gemm g{(const pg8::bf16_t*)(ws + WS_CAT), (const pg8::bf16_t*)(ws + WS_WCAT + (size_t)layer * DM * CATW), T, DM, CATW / 2, 30, 0}; pg8::StaticOrder S; S.init(T, DM, F.G, F.cid);
                pg8::EpiMerge E{(const pg8::bf16_t*)(ws + WS_PROJ), (pg8::bf16_t*)(ws + WS_MERGED), 1.f / 1024.f};
                pg8::gemm_phase<pg8::EpiMerge, pg8::StaticOrder, true, true, 2>(F.lds + RING_OFF, g, S, E, F.tid);
            } else if (k == 4) {
                pg8::Gemm g{(const pg8::bf16_t*)(ws + WS_MERGED), (const pg8::bf16_t*)(ws + WS_WO) + (size_t)layer * DM * DM, T, DM, DM, 30, 0}; pg8::StaticOrder S; S.init(T, DM, F.G, F.cid);
                if (layer == 0) { pg8::EpiResidB<true> E{(const void*)args.in[0], (pg8::bf16_t*)(ws + WS_XB), 1.f}; pg8::gemm_phase<pg8::EpiResidB<true>, pg8::StaticOrder, true, true>(F.lds + RING_OFF, g, S, E, F.tid); }
                else { pg8::EpiResidB<false> E{(const void*)(ws + WS_XB), (pg8::bf16_t*)(ws + WS_XB), 1.f}; pg8::gemm_phase<pg8::EpiResidB<false>, pg8::StaticOrder, true, true>(F.lds + RING_OFF, g, S, E, F.tid); }
            } else if (k == 5) phase_norm_router(F, args, layer);
            else if (k == 6) phase_topk(F, args);
            else if (k == 7) {
                pg8::Gemm g{(const pg8::bf16_t*)(ws + WS_XIN), (const pg8::bf16_t*)(ws + WS_WGU) + (size_t)layer * NE * 2 * FF * (DM / 2), NROWS_E, 2 * FF, DM / 2, 3, (size_t)2 * FF * DM}; pg8::StaticOrder S; S.init(NROWS_E, 2 * FF, F.G, F.cid);
                pg8::EpiSwigluI8 E{(pg8::bf16_t*)(ws + WS_ACT), (const float*)(ws + WS_XS), (const float*)(ws + WS_WGUS) + (size_t)layer * NE * 2 * FF, 1};
                pg8::gemm_phase<pg8::EpiSwigluI8, pg8::StaticOrder, true, true, 1>(F.lds + RING_OFF, g, S, E, F.tid);
            } else if (k == 8) {
                pg8::StaticOrder S; S.init(NROWS_E, DM, F.G, F.cid);
                {   pg8::Gemm g{(const pg8::bf16_t*)(ws + WS_ACT), (const pg8::bf16_t*)(ws + WS_WDN + (size_t)layer * NE * DM * FF), NROWS_E, DM, FF / 2, 3, (size_t)DM * FF};
                    pg8::EpiDown E{(const float*)(ws + WS_GW), (pg8::bf16_t*)(ws + WS_Y), 1.f / 1024.f};
                    pg8::gemm_phase<pg8::EpiDown, pg8::StaticOrder, true, true, 2>(F.lds + RING_OFF, g, S, E, F.tid); }
            } else phase_combine_norm(F, args, layer);
        }
        }
        const int kk_ = (ph - 1) % NPH_LAYER; const bool local_seam = __builtin_amdgcn_readfirstlane((int)F.MISC[2]) != 0 && ph > 0 && (kk_ == 3 || kk_ == 4 || kk_ == 5 || kk_ == 7) && slot + 1 < args.ph_hi && slot_phase(slot + 1) == ph + 1;
        if (slot + 1 < args.ph_hi) { if (USE_CG_SYNC || slot - args.ph_lo < args.cg_seams) cooperative_groups::this_grid().sync(); else if (local_seam) { GAS unsigned* cp = (GAS unsigned*)F.ctl; asm volatile("" : "+s"(cp)); xcc_local_barrier((unsigned*)cp, (unsigned)__builtin_amdgcn_readfirstlane((int)F.MISC[3]), (unsigned)F.G / 8u, (unsigned*)cp + CW_BAR); } else { XcdBarrier bb = bar; GAS unsigned* bp = (GAS unsigned*)bb.bar; asm volatile("" : "+s"(bp)); bb.bar = (unsigned*)bp; xcd_barrier(bb); } }
    }
}


extern "C" void kernel_launch(void* const* d_in, const int* in_sizes, int n_in, void* d_out, int out_size, void* d_ws, size_t ws_size, hipStream_t stream) {
    static int grid = 0;
    if (grid == 0) {
        if (n_in != 13 || in_sizes[0] != T * DM || out_size != T * DM || ws_size < WS_END) { fprintf(stderr, "kernel_launch: unexpected shapes (n_in %d, ws %zu)\n", n_in, ws_size); grid = -1; return; }
        if (hipFuncSetAttribute((const void*)mega, hipFuncAttributeMaxDynamicSharedMemorySize, LDS_BYTES) != hipSuccess) { fprintf(stderr, "kernel_launch: hipFuncSetAttribute failed\n"); grid = -1; return; }
        int dev = 0, cus = 0, per_cu = 0;
        if (hipGetDevice(&dev) != hipSuccess || hipDeviceGetAttribute(&cus, hipDeviceAttributeMultiprocessorCount, dev) != hipSuccess) { grid = -1; return; }
        if (hipOccupancyMaxActiveBlocksPerMultiprocessor(&per_cu, (const void*)mega, NWAVES * 64, LDS_BYTES) != hipSuccess || per_cu < 1) { fprintf(stderr, "kernel_launch: occupancy query says %d blocks per CU; nothing launched\n", per_cu); grid = -1; return; }
        (void)hipGetLastError();
        grid = cus;
    }
    if (grid < 0) return;
    unsigned char* ws = (unsigned char*)d_ws;
    hipMemsetAsync(ws + WS_CTL, 0, CTL_ZERO_BYTES, stream);
    Args a{};
    for (int i = 0; i < 13; ++i) a.in[i] = (const float*)d_in[i];
    a.out = (float*)d_out; a.ws = ws; a.ph_lo = 0; a.ph_hi = NSLOTS; a.cg_seams = 0; a.pad = 0;
    void* kargs[] = {&a};
    hipError_t e = hipLaunchCooperativeKernel((const void*)mega, dim3(grid), dim3(NWAVES * 64), kargs, LDS_BYTES, stream);
    if (e != hipSuccess) fprintf(stderr, "kernel_launch: cooperative launch failed: %s (grid %d)\n", hipGetErrorString(e), grid);
}
```

```cpp
#include <hip/hip_runtime.h>
#include <hip/hip_cooperative_groups.h>
#include <cstdio>
#include <cstdint>

constexpr int NB = 8, SEQ = 2048, DM = 1024, T = NB * SEQ, DEPTH = 2;
constexpr int NIN = 10752, ATTN_IN = 4608, AW = 512, RW = 1024, CATW = AW + RW;
constexpr int OFF_RQ = 4608, OFF_RK = 5632, OFF_RV = 6656, OFF_RG = 7680, OFF_GA = 8704, OFF_GR = 9728;
constexpr int NE = 16, FF = 2048, CAP = 256, NROWS_E = NB * NE * CAP;
constexpr float EPS = 1e-6f;

constexpr size_t PO_ATT = 0, PO_RQK = (size_t)9 * T * AW, PO_RV = PO_RQK + (size_t)2 * T * RW, PO_RG = PO_RV + (size_t)T * RW, PO_GATE = PO_RG + (size_t)T * RW, PO_END = PO_GATE + (size_t)2 * T * DM;
static_assert(PO_END == (size_t)T * NIN, "split projection layout covers the PROJ region exactly");
struct ProjCol { size_t base; unsigned bstride, pitch; int dsh; };
__host__ __device__ __forceinline__ ProjCol proj_col(int c) {
    ProjCol p;
    if (c < 4608) { const int g = c / 1536, r = c - g * 1536, which = r >> 9, h = (r >> 6) & 7, dc = r & 63; p.base = PO_ATT + (((size_t)(g * 3 + which) * 64 + h) * 2048) * 64 + dc; p.bstride = 8u * 2048u * 64u; p.pitch = 64; p.dsh = 2 * g; }
    else if (c < 6656) { const int r = c - 4608, which = r >> 10, h = (r >> 8) & 3, dk = r & 255; p.base = PO_RQK + (((size_t)which * 32 + h) * 2048) * 256 + dk; p.bstride = 4u * 2048u * 256u; p.pitch = 256; p.dsh = 0; }
    else if (c < 7680) { const int r = c - 6656, h = r >> 8, dvs = (r >> 6) & 3, dv = r & 63; p.base = PO_RV + (((size_t)h * 4 + dvs) * 2048) * 64 + dv; p.bstride = 16u * 2048u * 64u; p.pitch = 64; p.dsh = 0; }
    else if (c < 8704) { p.base = PO_RG + (c - 7680); p.bstride = 2048u * 1024u; p.pitch = 1024; p.dsh = 0; }
    else { p.base = PO_GATE + (c - 8704); p.bstride = 2048u * 2048u; p.pitch = 2048; p.dsh = 0; }
    return p;
}
__host__ __device__ __forceinline__ size_t proj_row(const ProjCol& p, int t) {
    const unsigned b = (unsigned)t >> 11, s = (unsigned)t & 2047u, sp = ((s & ((1u << p.dsh) - 1u)) << (11 - p.dsh)) | (s >> p.dsh);
    return p.base + (size_t)b * p.bstride + (size_t)sp * p.pitch;
}
__host__ __device__ __forceinline__ size_t proj_off(int t, int c) {
    const int b = t >> 11, s = t & 2047;
    if (c < 4608) { const int g = c / 1536, r = c - g * 1536, which = r >> 9, h = (r >> 6) & 7, dc = r & 63, dsh = 2 * g;
        const int perm = ((s & ((1 << dsh) - 1)) << (11 - dsh)) | (s >> dsh);
        return PO_ATT + ((((size_t)(g * 3 + which) * 8 + b) * 8 + h) * 2048 + perm) * 64 + dc; }
    if (c < 6656) { const int r = c - 4608, which = r >> 10, h = (r >> 8) & 3, dk = r & 255; return PO_RQK + ((((size_t)which * 8 + b) * 4 + h) * 2048 + s) * 256 + dk; }
    if (c < 7680) { const int r = c - 6656, h = r >> 8, dvs = (r >> 6) & 3, dv = r & 63; return PO_RV + ((((size_t)b * 4 + h) * 4 + dvs) * 2048 + s) * 64 + dv; }
    if (c < 8704) return PO_RG + (size_t)t * 1024 + (c - 7680);
    return PO_GATE + (size_t)t * 2048 + (c - 8704);
}

constexpr size_t MiB = 1u << 20;
constexpr size_t WS_CTL = 0;
constexpr size_t WS_WIN = 1 * MiB;
constexpr size_t WS_WCAT = WS_WIN + 42 * MiB;
constexpr size_t WS_WO  = WS_WCAT + 6 * MiB;
constexpr size_t WS_WGU = WS_WO + 4 * MiB;
constexpr size_t WS_WDN = WS_WGU + 256 * MiB;
constexpr size_t WS_XB  = WS_WDN + 64 * MiB;
constexpr size_t WS_H   = WS_WDN + 128 * MiB;
constexpr size_t WS_PROJ = WS_H + 32 * MiB;
constexpr size_t WS_XIN = WS_PROJ;
constexpr size_t WS_ACT = WS_PROJ + 64 * MiB;
constexpr size_t WS_Y   = WS_PROJ + 192 * MiB;
constexpr size_t WS_ATTO = WS_PROJ + 336 * MiB;
constexpr size_t WS_LSE = WS_ATTO + 48 * MiB;
constexpr size_t WS_YF  = WS_LSE + 2 * MiB;
constexpr size_t WS_MERGED = WS_YF;
constexpr size_t WS_YB  = WS_YF + 32 * MiB;
constexpr size_t WS_CAT = WS_YB + 32 * MiB;
constexpr size_t WS_AFF = WS_CAT + 48 * MiB;
constexpr size_t WS_IDX = WS_AFF + 1 * MiB;
constexpr size_t WS_GW  = WS_IDX + 256 * 1024;
constexpr size_t WS_SLOT = WS_GW + 256 * 1024;
constexpr size_t WS_SC  = WS_SLOT + 1 * MiB;
constexpr size_t WS_WINS = WS_SC, WS_WGUS = WS_SC + 128 * 1024, WS_HS = WS_SC + 640 * 1024, WS_XS = WS_SC + 704 * 1024;
constexpr size_t WS_END = WS_SC + 1 * MiB;
constexpr size_t WS_WMAX = 64 * 1024;
constexpr int WMAX_IN = 0, WMAX_G = DEPTH * NIN, WMAX_U = WMAX_G + DEPTH * NE * FF, NWMAX = WMAX_U + DEPTH * NE * FF;
static_assert(WS_WMAX + (size_t)NWMAX * 4 <= 1 * MiB, "WMAX inside the CTL MiB");
static_assert(WS_END <= 1024 * MiB, "workspace map");

#define GAS __attribute__((address_space(1)))
#define LAS __attribute__((address_space(3)))
typedef unsigned short bf16;
typedef unsigned v4u __attribute__((ext_vector_type(4)));
typedef float f32x4 __attribute__((ext_vector_type(4)));
typedef short bf16x8 __attribute__((ext_vector_type(8)));
typedef GAS unsigned gu32;
typedef GAS unsigned long long gu64;
#define RLX_AGENT __ATOMIC_RELAXED, __HIP_MEMORY_SCOPE_AGENT
#define LDS_WAIT() asm volatile("s_waitcnt lgkmcnt(0)" ::: "memory")
#define VM_WAIT() asm volatile("s_waitcnt vmcnt(0)" ::: "memory")
__device__ __forceinline__ unsigned long long rt() { return __builtin_amdgcn_s_memrealtime(); }
__device__ __forceinline__ unsigned f2bf(float f) { unsigned u = __builtin_bit_cast(unsigned, f); return (u + 0x7fffu + ((u >> 16) & 1u)) >> 16; }
typedef float f32x2_t __attribute__((ext_vector_type(2))); typedef __bf16 bf16x2_t __attribute__((ext_vector_type(2)));
__device__ __forceinline__ unsigned pk2(float lo, float hi) { const f32x2_t v = {lo, hi}; return __builtin_bit_cast(unsigned, __builtin_convertvector(v, bf16x2_t)); }

__device__ __forceinline__ float fp8_lim() { float l = 448.f; asm volatile("" : "+v"(l)); return l; }
__device__ __forceinline__ unsigned fp8x4(float a, float b, float c, float d, float lim) { int p = 0; p = __builtin_amdgcn_cvt_pk_fp8_f32(__builtin_amdgcn_fmed3f(a, -lim, lim), __builtin_amdgcn_fmed3f(b, -lim, lim), p, false); p = __builtin_amdgcn_cvt_pk_fp8_f32(__builtin_amdgcn_fmed3f(c, -lim, lim), __builtin_amdgcn_fmed3f(d, -lim, lim), p, true); return (unsigned)p; }

#define XB_TMO      128
#define XB_XCNT(j)  (256  + 64 * (j))
#define XB_XSUB(j)  (1280 + 64 * (j))
#define XB_XGEN(j)  (2304 + 64 * (j))
#define XB_TOP      3328
#define XB_TOPGEN   3392
#define XCD_BAR_WORDS 3456
#define XB_SPIN_CAP (1u << 18)

__device__ __forceinline__ unsigned xb_ld(unsigned* p)              { return __hip_atomic_load(p, __ATOMIC_RELAXED, __HIP_MEMORY_SCOPE_AGENT); }
__device__ __forceinline__ unsigned xb_add(unsigned* p, unsigned v) { return __hip_atomic_fetch_add(p, v, __ATOMIC_RELAXED, __HIP_MEMORY_SCOPE_AGENT); }
__device__ __forceinline__ unsigned xb_xcc_id() { return (unsigned)__builtin_amdgcn_s_getreg((3 << 11) | 20) & 0xFu; }
#define XB_SPIN(cond, bar) do { unsigned _sp = 0; while (cond) { __builtin_amdgcn_s_sleep(1); \
    if ((++_sp & 255u) == 0u) { if (xb_ld(&(bar)[XB_TMO])) break; if (_sp > XB_SPIN_CAP) { atomicAdd(&(bar)[XB_TMO], 1u); break; } } } } while (0)

struct XcdBarrier {
    unsigned* bar; unsigned x;
    volatile LAS unsigned* st;
};

__device__ __forceinline__ XcdBarrier xcd_barrier_post(unsigned* bar, volatile LAS unsigned* st) {
    XcdBarrier b; b.bar = bar; b.x = xb_xcc_id(); b.st = st;
    if (threadIdx.x == 0) (void)xb_add(&bar[XB_XCNT(b.x)], 1u);
    return b;
}
__device__ __forceinline__ void xcd_barrier_complete(unsigned* bar, unsigned x, unsigned& nloc, unsigned& nx) {
    const unsigned G = gridDim.x * gridDim.y * gridDim.z;
    unsigned sum, cnt, mine, sp = 0u;
    for (;;) {
        sum = 0u; cnt = 0u; mine = 0u;
#pragma unroll
        for (unsigned j = 0; j < 16; ++j) { const unsigned c = xb_ld(&bar[XB_XCNT(j)]); sum += c; cnt += (c > 0u) ? 1u : 0u; mine = (j == x) ? c : mine; }
        if (sum == G) break;
        __builtin_amdgcn_s_sleep(1);
        if ((++sp & 255u) == 0u) { if (xb_ld(&bar[XB_TMO])) break; if (sp > XB_SPIN_CAP) { atomicAdd(&bar[XB_TMO], 1u); break; } }
    }
    nloc = mine > 0u ? mine : 1u; nx = cnt > 0u ? cnt : 1u;
}

__device__ __forceinline__ void xcd_barrier(const XcdBarrier& b) {
    asm volatile("s_waitcnt vmcnt(0)" ::: "memory");
    __syncthreads();
    if (threadIdx.x == 0) {
        unsigned* bar = b.bar;
        __builtin_amdgcn_s_waitcnt(0);
        unsigned nloc = b.st[0], nx = b.st[1];
        if (nloc == 0u) { xcd_barrier_complete(bar, b.x, nloc, nx); b.st[0] = nloc; b.st[1] = nx; }
        const unsigned old = xb_add(&bar[XB_XSUB(b.x)], 1u);
        const unsigned gen = old / nloc;
        if (old + 1u == (gen + 1u) * nloc) {
            __builtin_amdgcn_fence(__ATOMIC_RELEASE, "agent");
            asm volatile("s_waitcnt vmcnt(0)" ::: "memory");
            const unsigned og = xb_add(&bar[XB_TOP], 1u);
            const unsigned tg = og / nx;
            if (og + 1u == (tg + 1u) * nx) xb_add(&bar[XB_TOPGEN], 1u);
            else XB_SPIN(xb_ld(&bar[XB_TOPGEN]) == tg, bar);
            __builtin_amdgcn_fence(__ATOMIC_ACQUIRE, "agent");
            xb_add(&bar[XB_XGEN(b.x)], 1u);
            asm volatile("s_waitcnt vmcnt(0)" ::: "memory");
        } else {
            XB_SPIN(xb_ld(&bar[XB_XGEN(b.x)]) == gen, bar);
            __builtin_amdgcn_fence(__ATOMIC_ACQUIRE, "agent");
            asm volatile("s_waitcnt vmcnt(0)" ::: "memory");
        }
    }
    __syncthreads();
}


#define CW_LBAR 8192
#define CW_AQ 12288
__device__ __forceinline__ void xcc_local_barrier(unsigned* ctl, const unsigned x, const unsigned nloc, unsigned* tmo_bar) {
    asm volatile("s_waitcnt vmcnt(0)" ::: "memory");
    __syncthreads();
    if (threadIdx.x == 0) {
        unsigned* w = ctl + CW_LBAR + 64 * x;
        const unsigned old = xb_add(w, 1u); const unsigned target = (old / nloc + 1u) * nloc;
        XB_SPIN(xb_ld(w) < target, tmo_bar);
        __builtin_amdgcn_fence(__ATOMIC_ACQUIRE, "agent");
        asm volatile("s_waitcnt vmcnt(0)" ::: "memory");
    }
    __syncthreads();
}

typedef unsigned u32x2 __attribute__((ext_vector_type(2)));
typedef unsigned u32x4 __attribute__((ext_vector_type(4)));
__device__ __forceinline__ float bf2f(unsigned short h) { return __builtin_bit_cast(float, (unsigned)h << 16); }
__device__ __forceinline__ float sigmoidf_(float v) { return 1.f / (1.f + __expf(-v)); }
__device__ __forceinline__ float siluf_(float v) { return v / (1.f + __expf(-v)); }
namespace pg8 {
#define PG8_LAS __attribute__((address_space(3)))
typedef unsigned short bf16_t;
typedef short bf16x8 __attribute__((ext_vector_type(8)));
typedef float f32x4 __attribute__((ext_vector_type(4)));
typedef unsigned u32x4 __attribute__((ext_vector_type(4)));
constexpr int BM = 256, BK = 64, HALF = 128, HTB = HALF * BK * 2  , STAGE_BYTES = 8 * HTB, NXCD = 8, WGM = 8;

__host__ __device__ __forceinline__ int lds_byte(int r, int c) { const int st = r >> 3, rr = r & 7, ch = c >> 3; return st * 1024 + rr * 128 + ((ch ^ rr) << 4) + (c & 7) * 2; }
__host__ __device__ __forceinline__ void stage_rc(int b, int& R, int& C) { const int st = b / 1024, sb = b % 1024, rr = sb >> 7, slot = (sb >> 4) & 7; R = st * 8 + rr; C = ((slot ^ rr) << 3) + ((sb & 15) >> 1); }
__host__ __device__ __forceinline__ int perm32(int rho) { const int n = rho >> 4, i = rho & 15; return 8 * (i >> 2) + 4 * n + (i & 3); }

struct Unit { int pm, pn; };
struct Gemm { const bf16_t* A; const bf16_t* Bt; int M, N, K; int gshift; size_t gstrideB; };

struct StaticOrder {
    int nM, nN, nwg, G, c;
    int sync_ui; unsigned* sctl; unsigned sx, snloc; unsigned* stmo;
    __host__ __device__ void init(int M, int N, int G_, int c_) { nM = M / BM; nN = N / BM; nwg = nM * nN; G = G_; c = c_; sync_ui = -1; sctl = nullptr; sx = 0; snloc = 1; stmo = nullptr; }
    __device__ __forceinline__ void after_unit(int ui) const { if (ui == sync_ui) xcc_local_barrier(sctl, sx, snloc, stmo); }
    __host__ __device__ bool next(int i, Unit& u) const {
        const long L = (long)i * G + c; if (L >= nwg) return false;
        int wgid = (int)L; { const int q = nwg / NXCD, r = nwg % NXCD, xcd = wgid % NXCD, off = wgid / NXCD; wgid = (xcd < r ? xcd * (q + 1) : r * (q + 1) + (xcd - r) * q) + off; }
        const int nig = WGM * nN, gid = wgid / nig, fm = gid * WGM, gsz = (nM - fm) < WGM ? (nM - fm) : WGM;
        u.pm = fm + ((wgid % nig) % gsz); u.pn = (wgid % nig) / gsz; return true;
    }
    __device__ __forceinline__ void a_ready(const Unit&) const {}
    __device__ __forceinline__ void done(const Unit&) const {}
};

__device__ __forceinline__ unsigned cvt_pk_bf16(float lo, float hi) { unsigned r; asm volatile("v_cvt_pk_bf16_f32 %0, %1, %2" : "=v"(r) : "v"(lo), "v"(hi)); return r; }
typedef float f32x2 __attribute__((ext_vector_type(2)));
typedef unsigned u32x2 __attribute__((ext_vector_type(2)));
constexpr int P_NIN = 10752, P_OFF_GA = 8704, P_OFF_GR = 9728, P_FF = 2048;
__device__ __forceinline__ float bflo(unsigned w) { return __builtin_bit_cast(float, w << 16); }
__device__ __forceinline__ float bfhi(unsigned w) { return __builtin_bit_cast(float, w & 0xffff0000u); }
__device__ __forceinline__ float fsig(float v) { return __builtin_amdgcn_rcpf(1.f + __expf(-v)); }
struct EpiStore {
    static constexpr bool PERM = true, AFTER_DRAIN = false; static constexpr int MID_T = 0;
    bf16_t* O; int ldc;
    __device__ __forceinline__ void operator()(const f32x4 (&acc)[2][2][4][2], const Unit& u, int wr, int wc, int fr, int fq) const {
        int row0 = u.pm * BM + wr * 64 + fr, col0 = u.pn * BM + wc * 64 + 8 * fq; asm volatile("" : "+v"(row0));
#pragma unroll
        for (int ai = 0; ai < 2; ++ai)
#pragma unroll
            for (int m = 0; m < 4; ++m) { bf16_t* rowp = O + (size_t)(row0 + ai * HALF + m * 16) * ldc + col0;
#pragma unroll
                for (int bj = 0; bj < 2; ++bj) { const f32x4 v0 = acc[ai][bj][m][0], v1 = acc[ai][bj][m][1];
                    u32x4 w; w.x = cvt_pk_bf16(v0[0], v0[1]); w.y = cvt_pk_bf16(v0[2], v0[3]); w.z = cvt_pk_bf16(v1[0], v1[1]); w.w = cvt_pk_bf16(v1[2], v1[3]);
                    *(u32x4*)(rowp + bj * 32) = w; } }
    }
};
struct EpiMerge {
    static constexpr bool PERM = true, AFTER_DRAIN = false; static constexpr int MID_T = 4;
    const bf16_t* proj; bf16_t* O; float post;
    __device__ __forceinline__ void mid(f32x4 (&acc)[2][2][4][2], const Unit& u, int wr, int wc, int fr, int fq) const {
        int row0 = u.pm * BM + wr * 64 + fr, col0 = u.pn * BM + wc * 64 + 8 * fq; asm volatile("" : "+v"(row0));
#pragma unroll
        for (int ai = 0; ai < 2; ++ai) { u32x4 ga[4][2], gr[4][2];
#pragma unroll
            for (int m = 0; m < 4; ++m) { const bf16_t* pr = proj + PO_GATE + (size_t)(row0 + ai * HALF + m * 16) * 2048 + col0;
#pragma unroll
                for (int bj = 0; bj < 2; ++bj) { ga[m][bj] = *(const u32x4*)(pr + bj * 32); gr[m][bj] = *(const u32x4*)(pr + 1024 + bj * 32); } }
#pragma unroll
            for (int m = 0; m < 4; ++m)
#pragma unroll
                for (int bj = 0; bj < 2; ++bj) { const u32x4 a = ga[m][bj], r = gr[m][bj]; f32x4 r0, r1;
                    r0[0] = (1.f + __expf(-bflo(r.x))) * __builtin_amdgcn_rcpf(1.f + __expf(-bflo(a.x))); r0[1] = (1.f + __expf(-bfhi(r.x))) * __builtin_amdgcn_rcpf(1.f + __expf(-bfhi(a.x)));
                    r0[2] = (1.f + __expf(-bflo(r.y))) * __builtin_amdgcn_rcpf(1.f + __expf(-bflo(a.y))); r0[3] = (1.f + __expf(-bfhi(r.y))) * __builtin_amdgcn_rcpf(1.f + __expf(-bfhi(a.y)));
                    r1[0] = (1.f + __expf(-bflo(r.z))) * __builtin_amdgcn_rcpf(1.f + __expf(-bflo(a.z))); r1[1] = (1.f + __expf(-bfhi(r.z))) * __builtin_amdgcn_rcpf(1.f + __expf(-bfhi(a.z)));
                    r1[2] = (1.f + __expf(-bflo(r.w))) * __builtin_amdgcn_rcpf(1.f + __expf(-bflo(a.w))); r1[3] = (1.f + __expf(-bfhi(r.w))) * __builtin_amdgcn_rcpf(1.f + __expf(-bfhi(a.w)));
                    acc[ai][bj][m][0] *= r0; acc[ai][bj][m][1] *= r1; } }
    }
    __device__ __forceinline__ void operator()(const f32x4 (&acc)[2][2][4][2], const Unit& u, int wr, int wc, int fr, int fq) const {
        int row0 = u.pm * BM + wr * 64 + fr, col0 = u.pn * BM + wc * 64 + 8 * fq; asm volatile("" : "+v"(row0));
#pragma unroll
        for (int ai = 0; ai < 2; ++ai) { u32x4 gr[4][2];
#pragma unroll
            for (int m = 0; m < 4; ++m)
#pragma unroll
                for (int bj = 0; bj < 2; ++bj) gr[m][bj] = *(const u32x4*)(proj + PO_GATE + (size_t)(row0 + ai * HALF + m * 16) * 2048 + 1024 + col0 + bj * 32);
#pragma unroll
            for (int m = 0; m < 4; ++m) { bf16_t* rowp = O + (size_t)(row0 + ai * HALF + m * 16) * 1024 + col0;
#pragma unroll
                for (int bj = 0; bj < 2; ++bj) { const u32x4 g = gr[m][bj]; const f32x4 v0 = acc[ai][bj][m][0] * post, v1 = acc[ai][bj][m][1] * post;
                    u32x4 w; w.x = cvt_pk_bf16(v0[0] * fsig(bflo(g.x)), v0[1] * fsig(bfhi(g.x))); w.y = cvt_pk_bf16(v0[2] * fsig(bflo(g.y)), v0[3] * fsig(bfhi(g.y)));
                    w.z = cvt_pk_bf16(v1[0] * fsig(bflo(g.z)), v1[1] * fsig(bfhi(g.z))); w.w = cvt_pk_bf16(v1[2] * fsig(bflo(g.w)), v1[3] * fsig(bfhi(g.w)));
                    *(u32x4*)(rowp + bj * 32) = w; } } }
    }
};
__device__ __forceinline__ float i2f(float bits) { return (float)__builtin_bit_cast(int, bits); }
struct EpiStoreI8 {
    static constexpr bool PERM = true, AFTER_DRAIN = false; static constexpr int MID_T = 0;
    bf16_t* O; int ldc; const float* rs; const float* cs;
    __device__ __forceinline__ void operator()(const f32x4 (&acc)[2][2][4][2], const Unit& u, int wr, int wc, int fr, int fq) const {
        int row0 = u.pm * BM + wr * 64 + fr, col0 = u.pn * BM + wc * 64 + 8 * fq; asm volatile("" : "+v"(row0), "+v"(col0));
        const bool odd = fr & 1; const int rowe = row0 & ~1;
        f32x4 c[2][2];
#pragma unroll
        for (int bj = 0; bj < 2; ++bj) { c[bj][0] = *(const f32x4*)(cs + col0 + bj * 32); c[bj][1] = *(const f32x4*)(cs + col0 + bj * 32 + 4); }
        const ProjCol pc = proj_col(col0 + (odd ? 32 : 0));
        bf16_t* const base0 = O + proj_row(pc, rowe); bf16_t* const base1 = O + proj_row(pc, rowe + 1); const unsigned step = (16u * pc.pitch) >> pc.dsh;
        float srv[8];
#pragma unroll
        for (int i = 0; i < 8; ++i) srv[i] = rs[row0 + (i >> 2) * HALF + (i & 3) * 16];
#pragma unroll
        for (int ai = 0; ai < 2; ++ai)
#pragma unroll
            for (int m = 0; m < 4; ++m) { const float sr = srv[ai * 4 + m]; u32x4 w[2];
#pragma unroll
                for (int bj = 0; bj < 2; ++bj) { const f32x4 a0 = acc[ai][bj][m][0], a1 = acc[ai][bj][m][1];
                    const f32x4 v0 = (f32x4){i2f(a0[0]), i2f(a0[1]), i2f(a0[2]), i2f(a0[3])} * (c[bj][0] * sr), v1 = (f32x4){i2f(a1[0]), i2f(a1[1]), i2f(a1[2]), i2f(a1[3])} * (c[bj][1] * sr);
                    w[bj].x = cvt_pk_bf16(v0[0], v0[1]); w[bj].y = cvt_pk_bf16(v0[2], v0[3]); w[bj].z = cvt_pk_bf16(v1[0], v1[1]); w[bj].w = cvt_pk_bf16(v1[2], v1[3]); }
                u32x4 snd, rcv;
                snd.x = odd ? w[0].x : w[1].x; snd.y = odd ? w[0].y : w[1].y; snd.z = odd ? w[0].z : w[1].z; snd.w = odd ? w[0].w : w[1].w;
                rcv.x = (unsigned)__builtin_amdgcn_mov_dpp((int)snd.x, 0xB1, 0xF, 0xF, true); rcv.y = (unsigned)__builtin_amdgcn_mov_dpp((int)snd.y, 0xB1, 0xF, 0xF, true);
                rcv.z = (unsigned)__builtin_amdgcn_mov_dpp((int)snd.z, 0xB1, 0xF, 0xF, true); rcv.w = (unsigned)__builtin_amdgcn_mov_dpp((int)snd.w, 0xB1, 0xF, 0xF, true);
                u32x4 s0, s1;
                s0.x = odd ? rcv.x : w[0].x; s0.y = odd ? rcv.y : w[0].y; s0.z = odd ? rcv.z : w[0].z; s0.w = odd ? rcv.w : w[0].w;
                s1.x = odd ? w[1].x : rcv.x; s1.y = odd ? w[1].y : rcv.y; s1.z = odd ? w[1].z : rcv.z; s1.w = odd ? w[1].w : rcv.w;
                const size_t o = (size_t)((ai * 8 + m) * step);
                *(u32x4*)(base0 + o) = s0; *(u32x4*)(base1 + o) = s1; }
    }
};
struct EpiSwigluI8 {
    static constexpr bool PERM = false, AFTER_DRAIN = false; static constexpr int MID_T = 0;
    bf16_t* O; const float* rs; const float* cs; int fp8;
    __device__ __forceinline__ void operator()(const f32x4 (&acc)[2][2][4][2], const Unit& u, int wr, int wc, int fr, int fq) const {
        int row0 = u.pm * BM + wr * 64 + fr, f0 = u.pn * (BM / 2) + wc * 32 + 8 * fq; asm volatile("" : "+v"(row0));
        int cofs = u.pn * BM + wc * 32 + 4 * fq; asm volatile("" : "+v"(cofs));
        const float* csp = cs + (size_t)(u.pm >> 3) * (2 * P_FF) + cofs;
        f32x4 cg[2], cu[2];
#pragma unroll
        for (int bj = 0; bj < 2; ++bj) { cg[bj] = *(const f32x4*)(csp + bj * HALF); cu[bj] = *(const f32x4*)(csp + bj * HALF + 16); }
        float srv[8];
#pragma unroll
        for (int i = 0; i < 8; ++i) srv[i] = rs[row0 + (i >> 2) * HALF + (i & 3) * 16];
#pragma unroll
        for (int ai = 0; ai < 2; ++ai)
#pragma unroll
            for (int m = 0; m < 4; ++m) { const size_t r = (size_t)(row0 + ai * HALF + m * 16); const float sr = srv[ai * 4 + m];
                float ov[8];
#pragma unroll
                for (int bj = 0; bj < 2; ++bj) { const f32x4 ga = acc[ai][bj][m][0], ua = acc[ai][bj][m][1];
#pragma unroll
                    for (int i = 0; i < 4; ++i) { const float a = i2f(ga[i]) * (cg[bj][i] * sr), b = i2f(ua[i]) * (cu[bj][i] * sr); ov[4 * bj + i] = a * fsig(a) * b; } }
                if (fp8) { const float lim = fp8_lim(); u32x2 w; w.x = fp8x4(ov[0] * 16.f, ov[1] * 16.f, ov[2] * 16.f, ov[3] * 16.f, lim); w.y = fp8x4(ov[4] * 16.f, ov[5] * 16.f, ov[6] * 16.f, ov[7] * 16.f, lim);
                    *(u32x2*)((unsigned char*)O + r * P_FF + f0) = w; }
                else { u32x4 w; w.x = cvt_pk_bf16(ov[0], ov[1]); w.y = cvt_pk_bf16(ov[2], ov[3]); w.z = cvt_pk_bf16(ov[4], ov[5]); w.w = cvt_pk_bf16(ov[6], ov[7]);
                    *(u32x4*)(O + r * P_FF + f0) = w; } }
    }
};

template <bool SRCF32> struct EpiResidB {
    static constexpr bool PERM = true, AFTER_DRAIN = false; static constexpr int MID_T = 0;
    const void* src; bf16_t* out; float post;
    __device__ __forceinline__ void operator()(const f32x4 (&acc)[2][2][4][2], const Unit& u, int wr, int wc, int fr, int fq) const {
        int row0 = u.pm * BM + wr * 64 + fr, col0 = u.pn * BM + wc * 64 + 8 * fq; asm volatile("" : "+v"(row0));
#pragma unroll
        for (int ai = 0; ai < 2; ++ai)
#pragma unroll
            for (int mh = 0; mh < 2; ++mh) {
                u32x4 rb[2][2]; f32x4 rf[2][2][2];
#pragma unroll
                for (int mm = 0; mm < 2; ++mm)
#pragma unroll
                    for (int bj = 0; bj < 2; ++bj) { const size_t o = (size_t)(row0 + ai * HALF + (2 * mh + mm) * 16) * 1024 + col0 + bj * 32;
                        if constexpr (SRCF32) { rf[mm][bj][0] = *(const f32x4*)((const float*)src + o); rf[mm][bj][1] = *(const f32x4*)((const float*)src + o + 4); }
                        else rb[mm][bj] = *(const u32x4*)((const bf16_t*)src + o); }
#pragma unroll
                for (int mm = 0; mm < 2; ++mm)
#pragma unroll
                    for (int bj = 0; bj < 2; ++bj) { const int m = 2 * mh + mm; const size_t o = (size_t)(row0 + ai * HALF + m * 16) * 1024 + col0 + bj * 32;
                        f32x4 s0, s1;
                        if constexpr (SRCF32) { s0 = rf[mm][bj][0]; s1 = rf[mm][bj][1]; }
                        else { const u32x4 r = rb[mm][bj]; s0 = (f32x4){bflo(r.x), bfhi(r.x), bflo(r.y), bfhi(r.y)}; s1 = (f32x4){bflo(r.z), bfhi(r.z), bflo(r.w), bfhi(r.w)}; }
                        const f32x4 v0 = s0 + acc[ai][bj][m][0] * post, v1 = s1 + acc[ai][bj][m][1] * post;
                        u32x4 w; w.x = cvt_pk_bf16(v0[0], v0[1]); w.y = cvt_pk_bf16(v0[2], v0[3]); w.z = cvt_pk_bf16(v1[0], v1[1]); w.w = cvt_pk_bf16(v1[2], v1[3]);
                        *(u32x4*)(out + o) = w; } }
    }
};
struct EpiResid {
    static constexpr bool PERM = false, AFTER_DRAIN = false; static constexpr int MID_T = 0;
    const float* src; float* out;
    __device__ __forceinline__ void operator()(const f32x4 (&acc)[2][2][4][2], const Unit& u, int wr, int wc, int fr, int fq) const {
        int row0 = u.pm * BM + wr * 64 + fr, col0 = u.pn * BM + wc * 32 + 4 * fq; asm volatile("" : "+v"(row0));
#pragma unroll
        for (int ai = 0; ai < 2; ++ai) { f32x4 sv[4][2][2];
#pragma unroll
            for (int m = 0; m < 4; ++m)
#pragma unroll
                for (int bj = 0; bj < 2; ++bj)
#pragma unroll
                    for (int n = 0; n < 2; ++n) sv[m][bj][n] = *(const f32x4*)(src + (size_t)(row0 + ai * HALF + m * 16) * 1024 + col0 + bj * HALF + n * 16);
#pragma unroll
            for (int m = 0; m < 4; ++m)
#pragma unroll
                for (int bj = 0; bj < 2; ++bj)
#pragma unroll
                    for (int n = 0; n < 2; ++n) *(f32x4*)(out + (size_t)(row0 + ai * HALF + m * 16) * 1024 + col0 + bj * HALF + n * 16) = sv[m][bj][n] + acc[ai][bj][m][n]; }
    }
};
struct EpiSwiglu {
    static constexpr bool PERM = false, AFTER_DRAIN = false; static constexpr int MID_T = 0;
    bf16_t* O;
    __device__ __forceinline__ void operator()(const f32x4 (&acc)[2][2][4][2], const Unit& u, int wr, int wc, int fr, int fq) const {
        int row0 = u.pm * BM + wr * 64 + fr, f0 = (u.pn * BM + wc * 32) / 2 + 4 * fq; asm volatile("" : "+v"(row0));
#pragma unroll
        for (int ai = 0; ai < 2; ++ai)
#pragma unroll
            for (int m = 0; m < 4; ++m) { bf16_t* rowp = O + (size_t)(row0 + ai * HALF + m * 16) * P_FF + f0;
#pragma unroll
                for (int bj = 0; bj < 2; ++bj) { const f32x4 a = acc[ai][bj][m][0], b = acc[ai][bj][m][1];
                    u32x2 w; w.x = cvt_pk_bf16(a[0] * fsig(a[0]) * b[0], a[1] * fsig(a[1]) * b[1]); w.y = cvt_pk_bf16(a[2] * fsig(a[2]) * b[2], a[3] * fsig(a[3]) * b[3]);
                    *(u32x2*)(rowp + bj * (HALF / 2)) = w; } }
    }
};
struct EpiDown {
    static constexpr bool PERM = true, AFTER_DRAIN = false; static constexpr int MID_T = 0;
    const float* gw; bf16_t* O; float post;
    __device__ __forceinline__ void operator()(const f32x4 (&acc)[2][2][4][2], const Unit& u, int wr, int wc, int fr, int fq) const {
        int row0 = u.pm * BM + wr * 64 + fr, col0 = u.pn * BM + wc * 64 + 8 * fq; asm volatile("" : "+v"(row0));
        float srv[8];
#pragma unroll
        for (int i = 0; i < 8; ++i) srv[i] = gw[row0 + (i >> 2) * HALF + (i & 3) * 16] * post;
#pragma unroll
        for (int ai = 0; ai < 2; ++ai)
#pragma unroll
            for (int m = 0; m < 4; ++m) { const size_t r = (size_t)(row0 + ai * HALF + m * 16); const float s = srv[ai * 4 + m]; bf16_t* rowp = O + r * 1024 + col0;
#pragma unroll
                for (int bj = 0; bj < 2; ++bj) { const f32x4 v0 = acc[ai][bj][m][0] * s, v1 = acc[ai][bj][m][1] * s;
                    u32x4 w; w.x = cvt_pk_bf16(v0[0], v0[1]); w.y = cvt_pk_bf16(v0[2], v0[3]); w.z = cvt_pk_bf16(v1[0], v1[1]); w.w = cvt_pk_bf16(v1[2], v1[3]);
                    *(u32x4*)(rowp + bj * 32) = w; } }
    }
};
typedef int i32x4 __attribute__((ext_vector_type(4)));
typedef long i64x2 __attribute__((ext_vector_type(2)));
template <int MT> __device__ __forceinline__ f32x4 mma16(const bf16x8 a, const bf16x8 b, const f32x4 c) {
    if constexpr (MT == 1) return __builtin_bit_cast(f32x4, __builtin_amdgcn_mfma_i32_16x16x64_i8(__builtin_bit_cast(i32x4, a), __builtin_bit_cast(i32x4, b), __builtin_bit_cast(i32x4, c), 0, 0, 0));
    else if constexpr (MT == 2) { const i64x2 a2 = __builtin_bit_cast(i64x2, a), b2 = __builtin_bit_cast(i64x2, b);
        return __builtin_amdgcn_mfma_f32_16x16x32_fp8_fp8(a2[1], b2[1], __builtin_amdgcn_mfma_f32_16x16x32_fp8_fp8(a2[0], b2[0], c, 0, 0, 0), 0, 0, 0); }
    else return __builtin_amdgcn_mfma_f32_16x16x32_bf16(a, b, c, 0, 0, 0);
}
typedef int i32x8 __attribute__((ext_vector_type(8))); typedef short bf16x16 __attribute__((ext_vector_type(16)));
__device__ __forceinline__ i32x8 cat8(const bf16x8 lo, const bf16x8 hi) { const i32x4 l = __builtin_bit_cast(i32x4, lo), h = __builtin_bit_cast(i32x4, hi); return __builtin_shufflevector(l, h, 0, 1, 2, 3, 4, 5, 6, 7); }
__device__ __forceinline__ void mma_f8x128(f32x4& c, const i32x8 a, const i32x8 b, const int one) {
    asm volatile("s_nop 1\n\tv_mfma_scale_f32_16x16x128_f8f6f4 %0, %1, %2, %0, %3, %3 op_sel_hi:[0,0,0]" : "+v"(c) : "v"(a), "v"(b), "v"(one));
}
template <class Epi, class Sched, bool ALIGN_EPI = false, bool SP2 = false, int MT = 0>
__device__ __forceinline__ void gemm_phase(PG8_LAS unsigned char* lds, const Gemm g, const Sched& S, const Epi& E, const int tid) {
    const int wid = __builtin_amdgcn_readfirstlane(tid >> 6), lane = tid & 63, wr = wid >> 2, wc = wid & 3, fr = lane & 15, fq = lane >> 4;
    const int K = g.K, nt = K / BK;
    unsigned voffA[2], voffB[2];
#pragma unroll
    for (int i = 0; i < 2; ++i) { int R, C; stage_rc(tid * 16 + i * 8192, R, C); const int Rb = Epi::PERM ? ((R & ~31) * 2 + perm32(R & 31)) : R;
        voffA[i] = (unsigned)(R * K + C) * 2u; voffB[i] = (unsigned)(Rb * K + C) * 2u; }
    const size_t kstep = (size_t)(BK * 2);
    const size_t hstep = (size_t)HALF * K * 2;
    const size_t tstep = 2 * hstep;
    const size_t hstepB = Epi::PERM ? (size_t)32 * K * 2 : hstep;
    const unsigned ldsw = (unsigned)wid * 1024u;
    const int aoff = lds_byte(wr * 64 + fr, fq * 8), boff = lds_byte(wc * 32 + fr, fq * 8);
#define PG8_SA(b, h) (((b) * 2 + (h)) * HTB)
#define PG8_SB(b, h) ((4 + (b) * 2 + (h)) * HTB)
#define PG8_STAGE(bufoff, gbase, voff) do { _Pragma("unroll") for (int _i = 0; _i < 2; ++_i) \
        __builtin_amdgcn_global_load_lds((const unsigned*)((const char*)(gbase) + (voff)[_i]), (PG8_LAS unsigned*)(lds + (bufoff) + ldsw + _i * 8192), 16, 0, 0); } while (0)
#define PG8_LDA(dst, b, h) do { _Pragma("unroll") for (int m = 0; m < 4; ++m) _Pragma("unroll") for (int k = 0; k < 2; ++k) dst[m][k] = *(const PG8_LAS bf16x8*)(lds + PG8_SA(b, h) + (aoff ^ (k * 64)) + m * 2048); } while (0)
#define PG8_LDB(dst, b, h) do { _Pragma("unroll") for (int n = 0; n < 2; ++n) _Pragma("unroll") for (int k = 0; k < 2; ++k) dst[n][k] = *(const PG8_LAS bf16x8*)(lds + PG8_SB(b, h) + (boff ^ (k * 64)) + n * 2048); } while (0)
#define PG8_MMA(ai, bj, At, Bt) do { __builtin_amdgcn_s_setprio(1); _Pragma("unroll") for (int m = 0; m < 4; ++m) _Pragma("unroll") for (int n = 0; n < 2; ++n) { \
        if constexpr (MT == 2) mma_f8x128(acc[ai][bj][m][n], cat8(Bt[n][0], Bt[n][1]), cat8(At[m][0], At[m][1]), mxone); \
        else { _Pragma("unroll") for (int k = 0; k < 2; ++k) acc[ai][bj][m][n] = mma16<MT>(Bt[n][k], At[m][k], acc[ai][bj][m][n]); } } __builtin_amdgcn_s_setprio(0); } while (0)
#define PG8_WAIT_V(n) asm volatile("s_waitcnt vmcnt(" #n ")" ::: "memory")
#define PG8_WAIT_L(n) asm volatile("s_waitcnt lgkmcnt(" #n ")" ::: "memory")
#define PG8_BAR __builtin_amdgcn_s_barrier()
#define PG8_SCHED __builtin_amdgcn_sched_barrier(0)
    Unit cur, nxt; int ui = 0;
    if (!S.next(0, cur)) return;
    f32x4 acc[2][2][4][2];
#pragma unroll
    for (int a = 0; a < 2; ++a)
#pragma unroll
        for (int b = 0; b < 2; ++b)
#pragma unroll
            for (int m = 0; m < 4; ++m)
#pragma unroll
                for (int n = 0; n < 2; ++n) acc[a][b][m][n] = (f32x4){0.f, 0.f, 0.f, 0.f};
    bf16x8 At[4][2], B0[2][2], B1[2][2]; const int mxone = 0x7f7f7f7f;
    const char* cA = (const char*)g.A + (size_t)cur.pm * tstep; const char* cB = (const char*)g.Bt + (size_t)(cur.pm >> g.gshift) * g.gstrideB + (size_t)cur.pn * tstep;
    S.a_ready(cur);
    if constexpr (SP2) {
        PG8_STAGE(PG8_SB(0, 0), cB, voffB); PG8_STAGE(PG8_SB(0, 1), cB + hstepB, voffB); PG8_STAGE(PG8_SA(0, 0), cA, voffA); PG8_STAGE(PG8_SA(0, 1), cA + hstep, voffA);
        if (wr == 1) PG8_BAR;
        PG8_WAIT_V(2); PG8_BAR;
        PG8_STAGE(PG8_SB(1, 0), cB + kstep, voffB); PG8_STAGE(PG8_SA(1, 0), cA + kstep, voffA); PG8_STAGE(PG8_SB(1, 1), cB + hstepB + kstep, voffB);
        PG8_WAIT_V(6); PG8_BAR;
    } else {
        PG8_STAGE(PG8_SB(0, 0), cB, voffB); PG8_STAGE(PG8_SA(0, 0), cA, voffA); PG8_STAGE(PG8_SB(0, 1), cB + hstepB, voffB); PG8_STAGE(PG8_SA(0, 1), cA + hstep, voffA);
        if (wr == 1) PG8_BAR;
        PG8_WAIT_V(4); PG8_BAR;
        PG8_STAGE(PG8_SB(1, 0), cB + kstep, voffB); PG8_STAGE(PG8_SA(1, 0), cA + kstep, voffA); PG8_STAGE(PG8_SB(1, 1), cB + hstepB + kstep, voffB);
        PG8_WAIT_V(6); PG8_BAR;
    }
    for (;;) {
        const bool has_next = S.next(ui + 1, nxt);
        const char* nA = has_next ? (const char*)g.A + (size_t)nxt.pm * tstep : cA; const char* nB = has_next ? (const char*)g.Bt + (size_t)(nxt.pm >> g.gshift) * g.gstrideB + (size_t)nxt.pn * tstep : cB;
        for (int t = 0; t < nt; t += 2) {
            const bool last = (t == nt - 2);
            if constexpr (Epi::MID_T > 0) { if (t == Epi::MID_T) { if constexpr (MT == 2) asm volatile("s_nop 15\n\ts_nop 7" ::: "memory"); E.mid(acc, cur, wr, wc, fr, fq); } }
            const char* a1 = cA + (size_t)(t + 1) * kstep;
            const char* a2 = last ? nA : cA + (size_t)(t + 2) * kstep; const char* b2 = last ? nB : cB + (size_t)(t + 2) * kstep;
            const char* a3 = a2 + kstep; const char* b3 = b2 + kstep;
            if (last && has_next) S.a_ready(nxt);
            if constexpr (SP2) {
            PG8_LDB(B0, 0, 0); PG8_LDB(B1, 0, 1); PG8_SCHED; PG8_LDA(At, 0, 0); PG8_STAGE(PG8_SA(1, 1), a1 + hstep, voffA);
            PG8_WAIT_V(8); PG8_WAIT_L(0); PG8_BAR; PG8_MMA(0, 0, At, B0); PG8_MMA(0, 1, At, B1); PG8_BAR; PG8_SCHED;
            PG8_LDA(At, 0, 1); PG8_STAGE(PG8_SB(0, 0), b2, voffB); PG8_STAGE(PG8_SB(0, 1), b2 + hstepB, voffB); PG8_STAGE(PG8_SA(0, 0), a2, voffA);
            PG8_WAIT_V(8); PG8_WAIT_L(0); PG8_BAR; PG8_MMA(1, 0, At, B0); PG8_MMA(1, 1, At, B1); PG8_BAR; PG8_SCHED;
            PG8_LDB(B0, 1, 0); PG8_LDB(B1, 1, 1); PG8_SCHED; PG8_LDA(At, 1, 0); PG8_STAGE(PG8_SA(0, 1), a2 + hstep, voffA);
            PG8_WAIT_V(8); PG8_WAIT_L(0); PG8_BAR; PG8_MMA(0, 0, At, B0); PG8_MMA(0, 1, At, B1); PG8_BAR; PG8_SCHED;
            PG8_LDA(At, 1, 1); PG8_STAGE(PG8_SB(1, 0), b3, voffB); PG8_STAGE(PG8_SB(1, 1), b3 + hstepB, voffB); PG8_STAGE(PG8_SA(1, 0), a3, voffA);
            PG8_WAIT_V(8); PG8_WAIT_L(0); PG8_BAR; PG8_MMA(1, 0, At, B0); PG8_MMA(1, 1, At, B1); PG8_BAR; PG8_SCHED;
            } else {
            PG8_LDB(B0, 0, 0); PG8_SCHED; PG8_LDA(At, 0, 0); PG8_STAGE(PG8_SA(1, 1), a1 + hstep, voffA);
            PG8_WAIT_L(8); PG8_BAR; PG8_WAIT_L(0); PG8_MMA(0, 0, At, B0); PG8_BAR; PG8_SCHED;
            PG8_LDB(B1, 0, 1); PG8_STAGE(PG8_SB(0, 0), b2, voffB);
            PG8_BAR; PG8_WAIT_L(0); PG8_MMA(0, 1, At, B1); PG8_BAR;
            PG8_LDA(At, 0, 1); PG8_STAGE(PG8_SA(0, 0), a2, voffA);
            PG8_BAR; PG8_WAIT_L(0); PG8_MMA(1, 0, At, B0); PG8_BAR; PG8_SCHED;
            PG8_STAGE(PG8_SB(0, 1), b2 + hstepB, voffB);
            PG8_WAIT_V(6); PG8_BAR; PG8_MMA(1, 1, At, B1); PG8_BAR;
            PG8_LDB(B0, 1, 0); PG8_SCHED; PG8_LDA(At, 1, 0); PG8_STAGE(PG8_SA(0, 1), a2 + hstep, voffA);
            PG8_WAIT_L(8); PG8_BAR; PG8_WAIT_L(0); PG8_MMA(0, 0, At, B0); PG8_BAR; PG8_SCHED;
            PG8_LDB(B1, 1, 1); PG8_STAGE(PG8_SB(1, 0), b3, voffB);
            PG8_BAR; PG8_WAIT_L(0); PG8_MMA(0, 1, At, B1); PG8_BAR;
            PG8_LDA(At, 1, 1); PG8_STAGE(PG8_SA(1, 0), a3, voffA);
            PG8_BAR; PG8_WAIT_L(0); PG8_MMA(1, 0, At, B0); PG8_BAR; PG8_SCHED;
            PG8_STAGE(PG8_SB(1, 1), b3 + hstepB, voffB);
            PG8_WAIT_V(6); PG8_BAR; PG8_MMA(1, 1, At, B1); PG8_BAR;
            }
        }
        if constexpr (MT == 2) asm volatile("s_nop 15\n\ts_nop 7" ::: "memory");
        if constexpr (ALIGN_EPI) { if (wr == 0) PG8_BAR; }
        if constexpr (!Epi::AFTER_DRAIN) { E(acc, cur, wr, wc, fr, fq); S.done(cur); S.after_unit(ui); }
        if (!has_next) break;
#pragma unroll
        for (int a = 0; a < 2; ++a)
#pragma unroll
            for (int b = 0; b < 2; ++b)
#pragma unroll
                for (int m = 0; m < 4; ++m)
#pragma unroll
                    for (int n = 0; n < 2; ++n) acc[a][b][m][n] = (f32x4){0.f, 0.f, 0.f, 0.f};
        cur = nxt; cA = nA; cB = nB; ++ui;
        if constexpr (ALIGN_EPI) { if (wr == 1) PG8_BAR; }
    }
    PG8_WAIT_V(0);
    if constexpr (!ALIGN_EPI) { if (wr == 0) PG8_BAR; }
    PG8_BAR;
    if constexpr (Epi::AFTER_DRAIN) { E.fused(acc, cur, wr, wc, fr, fq, lds, wid, lane); S.done(cur); }
#undef PG8_SA
#undef PG8_SB
#undef PG8_STAGE
#undef PG8_LDA
#undef PG8_LDB
#undef PG8_MMA
#undef PG8_WAIT_V
#undef PG8_WAIT_L
#undef PG8_BAR
#undef PG8_SCHED
}
}


constexpr int NWAVES = 8;
constexpr bool USE_CG_SYNC = false;
#ifndef REP_MASK
#define REP_MASK 0
#endif
constexpr int RING_OFF = 0, RING_BYTES = 131072;
constexpr int LDSCTL_OFF = RING_BYTES, MISC_OFF = LDSCTL_OFF + 320;
constexpr int LDS_BYTES = 147456;
constexpr int CW_CENSUS = 1024;
constexpr int CW_BAR = 4096;
constexpr size_t CTL_ZERO_BYTES = 1 * MiB;
constexpr int NPH_LAYER = 10, NPHASES = 1 + DEPTH * NPH_LAYER;

struct Frame {
    LAS unsigned char* lds; volatile LAS unsigned* MISC; unsigned* ctl;
    int tid, lane, wave, G, vcu, cid;
    unsigned char* ws;
};
struct Args { const float* in[13]; float* out; unsigned char* ws; int ph_lo, ph_hi, cg_seams, pad; };

__device__ __forceinline__ float wave_sum(float v) {
#pragma unroll
    for (int o = 1; o < 64; o <<= 1) v += __shfl_xor(v, o);
    return v;
}
__device__ __forceinline__ float bflo(unsigned w) { return __builtin_bit_cast(float, w << 16); }
__device__ __forceinline__ float bfhi(unsigned w) { return __builtin_bit_cast(float, w & 0xffff0000u); }

__device__ __forceinline__ unsigned q8x4(float a, float b, float c, float d) {
    const int ia = (int)__builtin_rintf(a), ib = (int)__builtin_rintf(b), ic = (int)__builtin_rintf(c), id = (int)__builtin_rintf(d);
    return (unsigned)(ia & 0xff) | ((unsigned)(ib & 0xff) << 8) | ((unsigned)(ic & 0xff) << 16) | ((unsigned)id << 24);
}
__device__ __forceinline__ float wave_max(float v) {
#pragma unroll
    for (int o = 1; o < 64; o <<= 1) v = fmaxf(v, __shfl_xor(v, o));
    return v;
}
__device__ __forceinline__ void quant_row_store(const f32x4 (&h)[4], signed char* orow, float* scale_out, int lane) {
    float m = 0.f;
#pragma unroll
    for (int j = 0; j < 4; ++j) m = fmaxf(fmaxf(m, fmaxf(fabsf(h[j].x), fabsf(h[j].y))), fmaxf(fabsf(h[j].z), fabsf(h[j].w)));
    m = wave_max(m);
    const float inv = m > 0.f ? 127.f / m : 0.f;
    unsigned* o4 = (unsigned*)orow + lane;
#pragma unroll
    for (int j = 0; j < 4; ++j) o4[64 * j] = q8x4(h[j].x * inv, h[j].y * inv, h[j].z * inv, h[j].w * inv);
    if (lane == 0) *scale_out = m * (1.f / 127.f);
}
__device__ __forceinline__ void rms_row_to_i8(const float* xrow, const float* gain, signed char* orow, float* scale_out, int lane) {
    const f32x4* xr = (const f32x4*)xrow + lane; const f32x4* gr = (const f32x4*)gain + lane;
    f32x4 v[4]; float s = 0.f;
#pragma unroll
    for (int j = 0; j < 4; ++j) { v[j] = xr[64 * j]; s += (v[j].x * v[j].x + v[j].y * v[j].y) + (v[j].z * v[j].z + v[j].w * v[j].w); }
    const float rstd = rsqrtf(wave_sum(s) * (1.f / DM) + EPS);
#pragma unroll
    for (int j = 0; j < 4; ++j) { const f32x4 g = gr[64 * j]; v[j].x *= rstd * g.x; v[j].y *= rstd * g.y; v[j].z *= rstd * g.z; v[j].w *= rstd * g.w; }
    quant_row_store(v, orow, scale_out, lane);
}
__device__ __forceinline__ void p0_q8_block_item(Frame& F, const float* W, int N, int n0, signed char* WQ, float* wsc, int mode, LAS float* red) {
    const int lane = F.lane, w = F.wave;
    const float* p = W + (size_t)(128 * w) * N + n0 + lane;
    float v[128]; float m = 0.f;
#pragma unroll
    for (int i = 0; i < 128; ++i) v[i] = __builtin_nontemporal_load(p + (size_t)i * N);
#pragma unroll
    for (int i = 0; i < 128; ++i) m = fmaxf(m, fabsf(v[i]));
    red[w * 64 + lane] = m;
    __syncthreads();
    float M = red[lane];
#pragma unroll
    for (int j = 1; j < 8; ++j) M = fmaxf(M, red[j * 64 + lane]);
    const float inv = M > 0.f ? 127.f / M : 0.f;
    const int ng = n0 + lane;
    const int np = (mode == 0) ? ng : ((ng >> 7) * 256 + ((ng >> 2) & 1) * 128 + ((ng >> 5) & 3) * 32 + (mode == 2 ? 16 : 0) + ((ng >> 3) & 3) * 4 + (ng & 3));
    v4u* o = (v4u*)(WQ + (size_t)np * 1024 + 128 * w);
#pragma unroll
    for (int i = 0; i < 8; ++i) { v4u q; q.x = q8x4(v[16 * i] * inv, v[16 * i + 1] * inv, v[16 * i + 2] * inv, v[16 * i + 3] * inv); q.y = q8x4(v[16 * i + 4] * inv, v[16 * i + 5] * inv, v[16 * i + 6] * inv, v[16 * i + 7] * inv);
        q.z = q8x4(v[16 * i + 8] * inv, v[16 * i + 9] * inv, v[16 * i + 10] * inv, v[16 * i + 11] * inv); q.w = q8x4(v[16 * i + 12] * inv, v[16 * i + 13] * inv, v[16 * i + 14] * inv, v[16 * i + 15] * inv); o[i] = q; }
    if (w == 0) wsc[np] = M * (1.f / 127.f);
    __syncthreads();
}
__device__ __forceinline__ void p0_tr16_item(const float* W, int K, int N, bf16* WT, int ldo, int koff, int item, int lane) {
    const int nblk = N / 128, kb = item / nblk, nb = item % nblk, k0 = 32 * kb, n0 = 128 * nb;
    const f32x2_t* p = (const f32x2_t*)(W + (size_t)k0 * N + n0) + lane; const size_t rstep = (size_t)N / 2;
    f32x2_t v[32];
#pragma unroll
    for (int i = 0; i < 32; ++i) v[i] = p[(size_t)i * rstep];
    v4u* o0 = (v4u*)(WT + (size_t)(n0 + 2 * lane) * ldo + koff + k0); v4u* o1 = (v4u*)(WT + (size_t)(n0 + 2 * lane + 1) * ldo + koff + k0);
#pragma unroll
    for (int i = 0; i < 4; ++i) { v4u q0, q1;
        q0.x = pk2(v[8 * i].x, v[8 * i + 1].x); q0.y = pk2(v[8 * i + 2].x, v[8 * i + 3].x); q0.z = pk2(v[8 * i + 4].x, v[8 * i + 5].x); q0.w = pk2(v[8 * i + 6].x, v[8 * i + 7].x);
        q1.x = pk2(v[8 * i].y, v[8 * i + 1].y); q1.y = pk2(v[8 * i + 2].y, v[8 * i + 3].y); q1.z = pk2(v[8 * i + 4].y, v[8 * i + 5].y); q1.w = pk2(v[8 * i + 6].y, v[8 * i + 7].y);
        o0[i] = q0; o1[i] = q1; }
}
struct TrTile { const float* W; bf16* WT; int N, ldo, koff, k0, n0, fp8; };
__device__ __forceinline__ void p0_tr_load(const TrTile& t, f32x4 (&v)[8], const int w, const int lane) {
    const float* p = t.W + (size_t)(t.k0 + 8 * w) * t.N + t.n0 + 4 * lane;
#pragma unroll
    for (int i = 0; i < 8; ++i) v[i] = __builtin_nontemporal_load((const f32x4*)(p + (size_t)i * t.N));
}
__device__ __forceinline__ void p0_tr_store(Frame& F, const TrTile& t, const f32x4 (&v)[8], LAS float* buf) {
    const int w = F.wave, lane = F.lane, tid = F.tid;
#pragma unroll
    for (int i = 0; i < 8; ++i) *(LAS f32x4*)(buf + (8 * w + i) * 256 + 4 * lane) = v[i];
    __syncthreads();
    const int n = tid & 255;
#pragma unroll
    for (int j = 0; j < 4; ++j) { const int kc = (tid >> 8) + 2 * j; const LAS float* sp = buf + (8 * kc) * 256 + n;
        v4u o; o.x = pk2(sp[0], sp[256]); o.y = pk2(sp[2 * 256], sp[3 * 256]); o.z = pk2(sp[4 * 256], sp[5 * 256]); o.w = pk2(sp[6 * 256], sp[7 * 256]);
        *(v4u*)(t.WT + (size_t)(t.n0 + n) * t.ldo + t.koff + t.k0 + 8 * kc) = o; }
}
__device__ __forceinline__ void p0_tr_store_fp8(Frame& F, const TrTile& t, const f32x4 (&v)[8], LAS float* buf) {
    const int w = F.wave, lane = F.lane;
#pragma unroll
    for (int i = 0; i < 8; ++i) *(LAS f32x4*)(buf + (8 * w + i) * 256 + 4 * (lane ^ (4 * (w >> 1)))) = v[i];
    __syncthreads();
    unsigned char* W8 = (unsigned char*)t.WT; const float lim = fp8_lim(); const int kq = lane & 3;
#pragma unroll
    for (int jj = 0; jj < 2; ++jj) { const int n = 32 * w + 16 * jj + (lane >> 2); const LAS float* sp = buf + (16 * kq) * 256 + 4 * ((n >> 2) ^ (4 * kq)) + (n & 3);
        u32x4 o;
        o.x = fp8x4(sp[0] * 64.f, sp[256] * 64.f, sp[2 * 256] * 64.f, sp[3 * 256] * 64.f, lim); o.y = fp8x4(sp[4 * 256] * 64.f, sp[5 * 256] * 64.f, sp[6 * 256] * 64.f, sp[7 * 256] * 64.f, lim);
        o.z = fp8x4(sp[8 * 256] * 64.f, sp[9 * 256] * 64.f, sp[10 * 256] * 64.f, sp[11 * 256] * 64.f, lim); o.w = fp8x4(sp[12 * 256] * 64.f, sp[13 * 256] * 64.f, sp[14 * 256] * 64.f, sp[15 * 256] * 64.f, lim);
        *(u32x4*)(W8 + (size_t)(t.n0 + n) * t.ldo + t.koff + t.k0 + 16 * kq) = o; }
}
__device__ __forceinline__ void phase_p0(Frame& F, const Args& a) {
    const int gw = F.vcu * NWAVES + F.wave, NGW = F.G * NWAVES;
    unsigned char* ws = F.ws;
    {   constexpr int B_IN = NIN / 64, B_G = FF / 64, B_TOT = DEPTH * B_IN + 2 * DEPTH * NE * B_G;
        LAS float* red = (LAS float*)(F.lds + RING_OFF);
        struct Q8Item { const float* W; signed char* WQ; float* wsc; int N, n0, mode; };
        auto decode = [&](int it, Q8Item& q) { int r = it;
            if (r < DEPTH * B_IN) { const int l = r / B_IN; r %= B_IN; q.W = a.in[1] + (size_t)l * DM * NIN; q.N = NIN; q.n0 = 64 * r; q.WQ = (signed char*)(ws + WS_WIN) + (size_t)l * NIN * DM; q.wsc = (float*)(ws + WS_WINS) + l * NIN; q.mode = 0; return; }
            r -= DEPTH * B_IN; const int which = r / (DEPTH * NE * B_G); r %= (DEPTH * NE * B_G); const int le = r / B_G; r %= B_G;
            q.W = a.in[which ? 10 : 9] + (size_t)le * DM * FF; q.N = FF; q.n0 = 64 * r; q.WQ = (signed char*)(ws + WS_WGU) + (size_t)le * 2 * FF * DM; q.wsc = (float*)(ws + WS_WGUS) + (size_t)le * 2 * FF; q.mode = which ? 2 : 1; };
        float v[128]; Q8Item cur, nxt; const int lane = F.lane, w = F.wave;
#define P0_Q8_LOAD(q_) do { const float* p_ = (q_).W + (size_t)(128 * w) * (q_).N + (q_).n0 + lane; _Pragma("unroll") for (int i = 0; i < 128; ++i) v[i] = __builtin_nontemporal_load(p_ + (size_t)i * (q_).N); } while (0)
        int it = F.vcu, par = 0;
        if (it < B_TOT) { decode(it, cur); P0_Q8_LOAD(cur); }
#pragma unroll 1
        for (; it < B_TOT; it += F.G, par ^= 1) {
            const bool more = it + F.G < B_TOT; if (more) decode(it + F.G, nxt);
            float m = 0.f;
#pragma unroll
            for (int i = 0; i < 128; ++i) m = fmaxf(m, fabsf(v[i]));
            red[par * 512 + w * 64 + lane] = m;
            __syncthreads();
            float M = red[par * 512 + lane];
#pragma unroll
            for (int j = 1; j < 8; ++j) M = fmaxf(M, red[par * 512 + j * 64 + lane]);
            const float inv = M > 0.f ? 127.f / M : 0.f;
            v4u q[8];
#pragma unroll
            for (int i = 0; i < 8; ++i) { q[i].x = q8x4(v[16 * i] * inv, v[16 * i + 1] * inv, v[16 * i + 2] * inv, v[16 * i + 3] * inv); q[i].y = q8x4(v[16 * i + 4] * inv, v[16 * i + 5] * inv, v[16 * i + 6] * inv, v[16 * i + 7] * inv);
                q[i].z = q8x4(v[16 * i + 8] * inv, v[16 * i + 9] * inv, v[16 * i + 10] * inv, v[16 * i + 11] * inv); q[i].w = q8x4(v[16 * i + 12] * inv, v[16 * i + 13] * inv, v[16 * i + 14] * inv, v[16 * i + 15] * inv); }
#define P0_NP(ng_) ((cur.mode == 0) ? (ng_) : (((ng_) >> 7) * 256 + (((ng_) >> 2) & 1) * 128 + (((ng_) >> 5) & 3) * 32 + (cur.mode == 2 ? 16 : 0) + (((ng_) >> 3) & 3) * 4 + ((ng_) & 3)))
            {   LAS unsigned char* tb = F.lds + RING_OFF + 8192 + w * (64 * 144);
#pragma unroll
                for (int i = 0; i < 8; ++i) *(LAS v4u*)(tb + lane * 144 + i * 16) = q[i];
                const int g8 = lane >> 3, j8 = lane & 7;
#pragma unroll
                for (int i = 0; i < 8; ++i) { const int c = 8 * g8 + i; const v4u r = *(const LAS v4u*)(tb + c * 144 + j8 * 16); const int ngc = cur.n0 + c, npc = P0_NP(ngc);
                    *(v4u*)(cur.WQ + (size_t)npc * 1024 + 128 * w + 16 * j8) = r; } }
            if (w == 0) { const int ng = cur.n0 + lane; cur.wsc[P0_NP(ng)] = M * (1.f / 127.f); }
#undef P0_NP
            if (more) { cur = nxt; P0_Q8_LOAD(cur); }
        }
#undef P0_Q8_LOAD
        __syncthreads();
    }
    {   constexpr int T_AO = (AW / 64) * (DM / 256), T_RO = (RW / 64) * (DM / 256), T_O = (DM / 64) * (DM / 256), T_D = (FF / 64) * (DM / 256);
        constexpr int T_LAYER = T_AO + T_RO + T_O + NE * T_D, T_TOT = DEPTH * T_LAYER;
        LAS float* buf = (LAS float*)(F.lds + RING_OFF);
        auto decode = [&](int it, TrTile& t) {
            const int l = it / T_LAYER; int r = it % T_LAYER; t.fp8 = 0;
            if (r < T_AO) { t.W = a.in[2] + (size_t)l * AW * DM; t.N = DM; t.WT = (bf16*)(ws + WS_WCAT + (size_t)l * DM * CATW); t.ldo = CATW; t.koff = 0; t.fp8 = 1; }
            else if ((r -= T_AO) < T_RO) { t.W = a.in[3] + (size_t)l * RW * DM; t.N = DM; t.WT = (bf16*)(ws + WS_WCAT + (size_t)l * DM * CATW); t.ldo = CATW; t.koff = AW; t.fp8 = 1; }
            else if ((r -= T_RO) < T_O) { t.W = a.in[4] + (size_t)l * DM * DM; t.N = DM; t.WT = (bf16*)(ws + WS_WO) + (size_t)l * DM * DM; t.ldo = DM; t.koff = 0; }
            else { r -= T_O; const int e = r / T_D; r %= T_D; const size_t le = (size_t)l * NE + e; t.W = a.in[11] + le * FF * DM; t.N = DM; t.ldo = FF; t.koff = 0;
                t.WT = (bf16*)(ws + WS_WDN + le * DM * FF); t.fp8 = 1; }
            t.k0 = 64 * (r >> 2); t.n0 = 256 * (r & 3);
        };
        TrTile cur, nx1, nx2; f32x4 v[8], v1[8], v2[8];
        int it = F.vcu, tpar = 0;
        if (it < T_TOT) { decode(it, cur); p0_tr_load(cur, v, F.wave, F.lane); }
        if (it + F.G < T_TOT) { decode(it + F.G, nx1); p0_tr_load(nx1, v1, F.wave, F.lane); }
#pragma unroll 1
        for (; it < T_TOT; it += F.G) {
            if (it + 2 * F.G < T_TOT) { decode(it + 2 * F.G, nx2); p0_tr_load(nx2, v2, F.wave, F.lane); }
            if (cur.fp8) p0_tr_store_fp8(F, cur, v, buf + tpar * 16384); else p0_tr_store(F, cur, v, buf + tpar * 16384);
            tpar ^= 1; cur = nx1; nx1 = nx2;
#pragma unroll
            for (int i = 0; i < 8; ++i) { v[i] = v1[i]; v1[i] = v2[i]; }
        }
        __syncthreads();
    }
#pragma unroll 1
    for (int m = gw; m < T; m += 4 * NGW) {
        f32x4 xv[4][4];
#pragma unroll
        for (int r = 0; r < 4; ++r) { const int mr = (m + r * NGW < T) ? m + r * NGW : m; const f32x4* xr = (const f32x4*)(a.in[0] + (size_t)mr * DM) + F.lane;
#pragma unroll
            for (int j = 0; j < 4; ++j) xv[r][j] = xr[64 * j]; }
#pragma unroll
        for (int r = 0; r < 4; ++r) { const int mr = m + r * NGW; if (mr < T) {
            float ss = 0.f;
#pragma unroll
            for (int j = 0; j < 4; ++j) ss += (xv[r][j].x * xv[r][j].x + xv[r][j].y * xv[r][j].y) + (xv[r][j].z * xv[r][j].z + xv[r][j].w * xv[r][j].w);
            const float rstd = rsqrtf(wave_sum(ss) * (1.f / DM) + EPS); const f32x4* gr = (const f32x4*)a.in[6] + F.lane;
#pragma unroll
            for (int j = 0; j < 4; ++j) { const f32x4 g = gr[64 * j]; xv[r][j].x *= rstd * g.x; xv[r][j].y *= rstd * g.y; xv[r][j].z *= rstd * g.z; xv[r][j].w *= rstd * g.w; }
            quant_row_store(xv[r], (signed char*)(ws + WS_H) + (size_t)mr * DM, (float*)(ws + WS_HS) + mr, F.lane); } }
    }
}

struct FinIn { u32x2 yf[4], yb[4], gq[4]; float l0, l1, l2; v4u p0, p1, p2; };
__device__ __forceinline__ void fin_load(FinIn& I, const int t, const int lane, const bf16* PROJ, const bf16* YF, const bf16* YB, const bf16* ATTO, const float* LSE) {
#pragma unroll
    for (int j = 0; j < 4; ++j) { const int c = 256 * j + 4 * lane;
        I.yf[j] = *(const u32x2*)(YF + (size_t)t * RW + c); I.yb[j] = *(const u32x2*)(YB + (size_t)t * RW + c); I.gq[j] = *(const u32x2*)(PROJ + PO_RG + (size_t)t * RW + c); }
    const int hh = lane >> 3, c = 8 * lane;
    I.l0 = LSE[((size_t)0 * T + t) * 8 + hh]; I.l1 = LSE[((size_t)1 * T + t) * 8 + hh]; I.l2 = LSE[((size_t)2 * T + t) * 8 + hh];
    I.p0 = *(const v4u*)(ATTO + ((size_t)0 * T + t) * AW + c); I.p1 = *(const v4u*)(ATTO + ((size_t)1 * T + t) * AW + c); I.p2 = *(const v4u*)(ATTO + ((size_t)2 * T + t) * AW + c);
}
__device__ __forceinline__ void fin_compute(const FinIn& I, const int t, const int lane, unsigned char* CAT) {
    unsigned char* crow = CAT + (size_t)t * CATW; const float lim = fp8_lim();
#pragma unroll
    for (int j = 0; j < 4; ++j) {
        const int c = 256 * j + 4 * lane; const u32x2 yf = I.yf[j], yb = I.yb[j], gq = I.gq[j];
        const float r0 = bflo(yf.x) + bflo(yb.x), r1 = bfhi(yf.x) + bfhi(yb.x), r2 = bflo(yf.y) + bflo(yb.y), r3 = bfhi(yf.y) + bfhi(yb.y);
        const float rstd = rsqrtf(wave_sum((r0 * r0 + r1 * r1) + (r2 * r2 + r3 * r3)) * (1.f / 256.f) + EPS);
        const float g0 = bflo(gq.x), g1 = bfhi(gq.x), g2 = bflo(gq.y), g3 = bfhi(gq.y);
        const float rs16 = rstd * 16.f;
        *(unsigned*)(crow + AW + c) = fp8x4(siluf_(g0) * r0 * rs16, siluf_(g1) * r1 * rs16, siluf_(g2) * r2 * rs16, siluf_(g3) * r3 * rs16, lim);
    }
    {
        const int c = 8 * lane; const float l0 = I.l0, l1 = I.l1, l2 = I.l2; const v4u p0 = I.p0, p1 = I.p1, p2 = I.p2;
        const float mx = fmaxf(l0, fmaxf(l1, l2)); float w0 = __expf(l0 - mx), w1 = __expf(l1 - mx), w2 = __expf(l2 - mx); const float inv = 16.f / (w0 + w1 + w2); w0 *= inv; w1 *= inv; w2 *= inv;
        u32x2 o;
        o.x = fp8x4(w0 * bflo(p0.x) + w1 * bflo(p1.x) + w2 * bflo(p2.x), w0 * bfhi(p0.x) + w1 * bfhi(p1.x) + w2 * bfhi(p2.x), w0 * bflo(p0.y) + w1 * bflo(p1.y) + w2 * bflo(p2.y), w0 * bfhi(p0.y) + w1 * bfhi(p1.y) + w2 * bfhi(p2.y), lim);
        o.y = fp8x4(w0 * bflo(p0.z) + w1 * bflo(p1.z) + w2 * bflo(p2.z), w0 * bfhi(p0.z) + w1 * bfhi(p1.z) + w2 * bfhi(p2.z), w0 * bflo(p0.w) + w1 * bflo(p1.w) + w2 * bflo(p2.w), w0 * bfhi(p0.w) + w1 * bfhi(p1.w) + w2 * bfhi(p2.w), lim);
        *(u32x2*)(crow + c) = o;
    }
}
__device__ __forceinline__ void phase_finalize(Frame& F, const Args& a) {
    unsigned char* ws = F.ws; const bf16* PROJ = (const bf16*)(ws + WS_PROJ); const bf16* YF = (const bf16*)(ws + WS_YF); const bf16* YB = (const bf16*)(ws + WS_YB);
    const bf16* ATTO = (const bf16*)(ws + WS_ATTO); const float* LSE = (const float*)(ws + WS_LSE); unsigned char* CAT = ws + WS_CAT;
    const int gw = F.vcu * NWAVES + F.wave, NGW = F.G * NWAVES, lane = F.lane;
#pragma unroll 1
    for (int t = gw; t < T; t += 2 * NGW) {
        FinIn A, B; const int t2 = t + NGW; const bool two = t2 < T;
        fin_load(A, t, lane, PROJ, YF, YB, ATTO, LSE); fin_load(B, two ? t2 : t, lane, PROJ, YF, YB, ATTO, LSE);
        fin_compute(A, t, lane, CAT); if (two) fin_compute(B, t2, lane, CAT);
    }
}

__device__ __forceinline__ void phase_norm_router(Frame& F, const Args& a, int layer) {
    unsigned char* ws = F.ws; const bf16* x = (const bf16*)(ws + WS_XB); const float* gain = a.in[7] + (size_t)layer * DM; const float* wr = a.in[8] + (size_t)layer * DM * NE;
    signed char* H8 = (signed char*)(ws + WS_H); float* HS = (float*)(ws + WS_HS); float* AFF = (float*)(ws + WS_AFF);
    LAS unsigned short* WH = (LAS unsigned short*)(F.lds + RING_OFF);
    LAS unsigned short* WL = WH + 16384;
    LAS float* GL = (LAS float*)(F.lds + RING_OFF + 65536);
    const int lane = F.lane, tq = lane & 15, kg = lane >> 4, kh = F.wave & 1, c0 = 2 * kh, c1 = 2 * kh + 1, tfirst = F.vcu * 4;
    LAS float* EX = (LAS float*)(F.lds + RING_OFF + 73728);
    v4u xa[8], xb[8];
#define RT_LOAD(buf, c) do { _Pragma("unroll") for (int s8 = 0; s8 < 8; ++s8) buf[s8] = *(const v4u*)(xr + 32 * (8 * (c) + s8)); } while (0)
#define RT_X0(r_) ((f32x4){bflo((r_).x), bfhi((r_).x), bflo((r_).y), bfhi((r_).y)})
#define RT_X1(r_) ((f32x4){bflo((r_).z), bfhi((r_).z), bflo((r_).w), bfhi((r_).w)})
#define RT_P1(buf, c) do { _Pragma("unroll") for (int s8 = 0; s8 < 8; ++s8) { const int sk = 8 * (c) + s8; \
                const f32x4 g0 = *(const LAS f32x4*)(GL + 32 * sk + 8 * kg), g1 = *(const LAS f32x4*)(GL + 32 * sk + 8 * kg + 4); \
                const f32x4 x0 = RT_X0(buf[s8]), x1 = RT_X1(buf[s8]); \
                ss += ((x0.x * x0.x + x0.y * x0.y) + (x0.z * x0.z + x0.w * x0.w)) + ((x1.x * x1.x + x1.y * x1.y) + (x1.z * x1.z + x1.w * x1.w)); \
                const f32x4 v0 = x0 * g0, v1 = x1 * g1; \
                mx = fmaxf(mx, fmaxf(fmaxf(fmaxf(fabsf(v0.x), fabsf(v0.y)), fmaxf(fabsf(v0.z), fabsf(v0.w))), fmaxf(fmaxf(fabsf(v1.x), fabsf(v1.y)), fmaxf(fabsf(v1.z), fabsf(v1.w))))); \
                v4u hi; hi.x = pk2(v0.x, v0.y); hi.y = pk2(v0.z, v0.w); hi.z = pk2(v1.x, v1.y); hi.w = pk2(v1.z, v1.w); \
                v4u lo; lo.x = pk2(v0.x - bflo(hi.x), v0.y - bfhi(hi.x)); lo.y = pk2(v0.z - bflo(hi.y), v0.w - bfhi(hi.y)); lo.z = pk2(v1.x - bflo(hi.z), v1.y - bfhi(hi.z)); lo.w = pk2(v1.z - bflo(hi.w), v1.w - bfhi(hi.w)); \
                const bf16x8 wh = *(const LAS bf16x8*)(WH + ((sk * 4 + kg) * 16 + tq) * 8), wl = *(const LAS bf16x8*)(WL + ((sk * 4 + kg) * 16 + tq) * 8); \
                const bf16x8 ah = __builtin_bit_cast(bf16x8, hi), al = __builtin_bit_cast(bf16x8, lo); \
                acc = __builtin_amdgcn_mfma_f32_16x16x32_bf16(ah, wh, acc, 0, 0, 0); acc = __builtin_amdgcn_mfma_f32_16x16x32_bf16(al, wh, acc, 0, 0, 0); acc = __builtin_amdgcn_mfma_f32_16x16x32_bf16(ah, wl, acc, 0, 0, 0); } } while (0)
#define RT_P2(buf, c) do { _Pragma("unroll") for (int s8 = 0; s8 < 8; ++s8) { const int sk = 8 * (c) + s8; \
                const f32x4 g0 = *(const LAS f32x4*)(GL + 32 * sk + 8 * kg) * qi, g1 = *(const LAS f32x4*)(GL + 32 * sk + 8 * kg + 4) * qi; \
                v4u r_ = buf[s8]; asm volatile("" : "+v"(r_.x), "+v"(r_.y), "+v"(r_.z), "+v"(r_.w));        \
                const f32x4 x0 = RT_X0(r_), x1 = RT_X1(r_); u32x2 o; o.x = q8x4(x0.x * g0.x, x0.y * g0.y, x0.z * g0.z, x0.w * g0.w); o.y = q8x4(x1.x * g1.x, x1.y * g1.y, x1.z * g1.z, x1.w * g1.w); \
                *(u32x2*)(orow + 32 * sk) = o; } } while (0)
#define SB __builtin_amdgcn_sched_barrier(0)
    if (tfirst < T / 16) { const bf16* xr = x + (size_t)(16 * (tfirst + (F.wave >> 1)) + tq) * DM + 8 * kg; RT_LOAD(xa, c0); RT_LOAD(xb, c1); }
    SB;
#pragma unroll
    for (int kh = 0; kh < 2; ++kh) {   f32x4 wv[4];
#pragma unroll
        for (int k = 0; k < 4; ++k) wv[k] = ((const f32x4*)wr)[F.tid + 512 * (4 * kh + k)];
#pragma unroll
        for (int k = 0; k < 4; ++k) { const int i4 = F.tid + 512 * (4 * kh + k), d = i4 >> 2, e0 = (i4 & 3) * 4; const int base = (((d >> 5) * 4 + ((d >> 3) & 3)) * 16) * 8 + (d & 7);
#pragma unroll
            for (int c = 0; c < 4; ++c) { const float w = wv[k][c]; const unsigned hi = pk2(w, 0.f) & 0xffffu; const float lo = w - bflo(hi);
                WH[base + (e0 + c) * 8] = (unsigned short)hi; WL[base + (e0 + c) * 8] = (unsigned short)(pk2(lo, 0.f) & 0xffffu); } } }
    for (int i = F.tid; i < DM / 4; i += NWAVES * 64) ((LAS f32x4*)GL)[i] = ((const f32x4*)gain)[i];
    __syncthreads();
#pragma unroll 1
    for (int t0 = tfirst; t0 < T / 16; t0 += F.G * 4) {
        const int tile = t0 + (F.wave >> 1), token = 16 * tile + tq; const bf16* xr = x + (size_t)token * DM + 8 * kg;
        if (t0 != tfirst) { RT_LOAD(xa, c0); RT_LOAD(xb, c1); }
        f32x4 acc = {0.f, 0.f, 0.f, 0.f}; float ss = 0.f, mx = 0.f;
        SB; RT_P1(xa, c0); SB; RT_P1(xb, c1); SB;
        ss += __shfl_xor(ss, 16); ss += __shfl_xor(ss, 32); mx = fmaxf(mx, __shfl_xor(mx, 16)); mx = fmaxf(mx, __shfl_xor(mx, 32));
        {   LAS float* ex = EX + (F.wave * 64 + lane) * 8; *(LAS f32x4*)ex = acc; *(LAS f32x2_t*)(ex + 4) = (f32x2_t){ss, mx}; }
        __syncthreads();
        {   const LAS float* ex = EX + ((F.wave ^ 1) * 64 + lane) * 8; const f32x4 pa = *(const LAS f32x4*)ex; const f32x2_t pm = *(const LAS f32x2_t*)(ex + 4); acc += pa; ss += pm.x; mx = fmaxf(mx, pm.y); }
        const float rstd = rsqrtf(ss * (1.f / DM) + EPS);
#pragma unroll
        for (int rr = 0; rr < 2; ++rr) { const int r = 2 * kh + rr; const float l = (kh ? acc[2 + rr] : acc[rr]) * __shfl(rstd, 4 * kg + r);
            float m = l; m = fmaxf(m, __shfl_xor(m, 1)); m = fmaxf(m, __shfl_xor(m, 2)); m = fmaxf(m, __shfl_xor(m, 4)); m = fmaxf(m, __shfl_xor(m, 8));
            const float p = __expf(l - m); float den = p; den += __shfl_xor(den, 1); den += __shfl_xor(den, 2); den += __shfl_xor(den, 4); den += __shfl_xor(den, 8);
            AFF[(size_t)(16 * tile + 4 * kg + r) * 16 + tq] = p / den; }
        const float qi = mx > 0.f ? 127.f / mx : 0.f;
        signed char* orow = H8 + (size_t)token * DM + 8 * kg;
        SB; RT_P2(xa, c0); SB; RT_P2(xb, c1);
        if (kg == 0 && kh == 0) HS[token] = mx * rstd * (1.f / 127.f);
        __syncthreads();
    }
#undef SB
#undef RT_LOAD
#undef RT_X0
#undef RT_X1
#undef RT_P1
#undef RT_P2
}

__device__ __forceinline__ int block_excl_scan(Frame& F, const int v, LAS int* wsum) {
    int inc = v;
#pragma unroll
    for (int o = 1; o < 64; o <<= 1) { const int t = __shfl_up(inc, o); if (F.lane >= o) inc += t; }
    if (F.lane == 63) wsum[F.wave] = inc;
    __syncthreads();
    int off = 0;
#pragma unroll
    for (int w = 0; w < NWAVES; ++w) off += (w < F.wave) ? wsum[w] : 0;
    __syncthreads();
    return off + inc - v;
}
__device__ __forceinline__ void phase_topk(Frame& F, const Args& a) {
    unsigned char* ws = F.ws; const float* AFF = (const float*)(ws + WS_AFF); const signed char* H8 = (const signed char*)(ws + WS_H); const float* HS = (const float*)(ws + WS_HS);
    int* IDX = (int*)(ws + WS_IDX); float* GW = (float*)(ws + WS_GW); int* SLOT = (int*)(ws + WS_SLOT); signed char* XIN = (signed char*)(ws + WS_XIN); float* XS = (float*)(ws + WS_XS);
    LAS int* hist = (LAS int*)(F.lds + RING_OFF);
    LAS int* res = hist + 256;
    LAS int* wsum = hist + 272;
    LAS int* cnt = hist + 288;
    LAS int* selt = hist + 512;
    LAS int* selr = hist + 1024;
    const int tid = F.tid, lane = F.lane;
#pragma unroll 1
    for (int u = F.vcu; u < NB * NE * 2; u += F.G) {
        const int half = u & 1, be = u >> 1, b = be >> 4, e = be & 15;
        unsigned key[4];
#pragma unroll
        for (int i = 0; i < 4; ++i) key[i] = __float_as_uint(AFF[(size_t)(b * SEQ + 4 * tid + i) * 16 + e]);
        unsigned prefix = 0; int k = CAP; int one = 1; asm volatile("" : "+v"(one));
#pragma unroll
        for (int pass = 0; pass < 4; ++pass) { const int shift = 24 - 8 * pass;
            __syncthreads();
            if (tid < 256) hist[tid] = 0;
            if (tid == 0) cnt[0] = 0;
            __syncthreads();
#pragma unroll
            for (int i = 0; i < 4; ++i) if (pass == 0 || (key[i] >> (shift + 8)) == prefix) __hip_atomic_fetch_add(&hist[(key[i] >> shift) & 255], one, __ATOMIC_RELAXED, __HIP_MEMORY_SCOPE_WORKGROUP);
            __syncthreads();
            if (F.wave == 0) {
                const int c0 = hist[4 * lane], c1 = hist[4 * lane + 1], c2 = hist[4 * lane + 2], c3 = hist[4 * lane + 3]; const int t = (c0 + c1) + (c2 + c3);
                int suf = t;
#pragma unroll
                for (int o = 1; o < 64; o <<= 1) { const int v = __shfl_down(suf, o); if (lane + o < 64) suf += v; }
                int cum = suf - t;
                if (cum < k && cum + t >= k) { int d = 3;
                    if (cum + c3 >= k) d = 3; else { cum += c3; if (cum + c2 >= k) d = 2; else { cum += c2; if (cum + c1 >= k) d = 1; else { cum += c1; d = 0; } } }
                    res[0] = 4 * lane + d; res[1] = k - cum; }
            }
            __syncthreads();
            prefix = (prefix << 8) | (unsigned)res[0]; k = res[1];
        }
        int eqc = 0;
#pragma unroll
        for (int i = 0; i < 4; ++i) eqc += (key[i] == prefix) ? 1 : 0;
        int eqpre = block_excl_scan(F, eqc, wsum);
        int selc = 0; bool sel[4];
#pragma unroll
        for (int i = 0; i < 4; ++i) { const bool eq = key[i] == prefix; sel[i] = key[i] > prefix || (eq && eqpre < k); eqpre += eq ? 1 : 0; selc += sel[i] ? 1 : 0; }
        int pre = block_excl_scan(F, selc, wsum);
        if ((tid >> 8) == half) {
            int sl[4];
#pragma unroll
            for (int i = 0; i < 4; ++i) { sl[i] = -1;
                if (sel[i]) { sl[i] = pre; const int row = (e * NB + b) * CAP + pre, tok = b * SEQ + 4 * tid + i; IDX[row] = tok; GW[row] = __uint_as_float(key[i]);
                    const int p = __hip_atomic_fetch_add(cnt, 1, __ATOMIC_RELAXED, __HIP_MEMORY_SCOPE_WORKGROUP); selt[p] = tok; selr[p] = row; ++pre; } }
            *(int4*)(SLOT + (size_t)(b * NE + e) * SEQ + 4 * tid) = make_int4(sl[0], sl[1], sl[2], sl[3]);
        }
        __syncthreads();
        const int n = cnt[0];
#pragma unroll 1
        for (int i0 = 4 * F.wave; i0 < n; i0 += 4 * NWAVES) {
            v4u r[4]; float sc[4]; int row[4];
#pragma unroll
            for (int j = 0; j < 4; ++j) { const int ii = (i0 + j < n) ? i0 + j : n - 1; const int tok = selt[ii]; row[j] = selr[ii]; r[j] = ((const v4u*)(H8 + (size_t)tok * DM))[lane]; sc[j] = HS[tok]; }
#pragma unroll
            for (int j = 0; j < 4; ++j) { ((v4u*)(XIN + (size_t)row[j] * DM))[lane] = r[j]; if (lane == 0) XS[row[j]] = sc[j]; }
        }
    }
    __syncthreads();
}

struct CmbIn { f32x4 v[4]; int sl; };
__device__ __forceinline__ void cmb_load(CmbIn& I, const int t, const int lane, const bf16* x, const int* SLOT) {
    const int b = t / SEQ, s = t % SEQ; const u32x2* xr = (const u32x2*)(x + (size_t)t * DM) + lane;
#pragma unroll
    for (int j = 0; j < 4; ++j) { const u32x2 r = xr[64 * j]; I.v[j] = (f32x4){bflo(r.x), bfhi(r.x), bflo(r.y), bfhi(r.y)}; }
    I.sl = SLOT[(size_t)(b * NE + (lane & 15)) * SEQ + s];
}
__device__ __forceinline__ void cmb_add_rows(CmbIn& I, const int t, const int lane, const bf16* Y) {
    const int b = t / SEQ;
    unsigned m = (unsigned)(__ballot(I.sl >= 0) & 0xffffull);
    while (m) {
        const int e0 = __builtin_ctz(m); m &= m - 1; const int e1 = m ? __builtin_ctz(m) : e0; const bool two = m != 0; m &= m - 1;
        const int s0 = __builtin_amdgcn_readlane(I.sl, e0), s1 = __builtin_amdgcn_readlane(I.sl, e1);
        const u32x2* y0 = (const u32x2*)(Y + ((size_t)(e0 * NB + b) * CAP + s0) * DM) + lane; const u32x2* y1 = (const u32x2*)(Y + ((size_t)(e1 * NB + b) * CAP + s1) * DM) + lane;
        u32x2 a[4], c[4];
#pragma unroll
        for (int j = 0; j < 4; ++j) { a[j] = y0[64 * j]; c[j] = y1[64 * j]; }
#pragma unroll
        for (int j = 0; j < 4; ++j) { I.v[j].x += bflo(a[j].x); I.v[j].y += bfhi(a[j].x); I.v[j].z += bflo(a[j].y); I.v[j].w += bfhi(a[j].y);
            if (two) { I.v[j].x += bflo(c[j].x); I.v[j].y += bfhi(c[j].x); I.v[j].z += bflo(c[j].y); I.v[j].w += bfhi(c[j].y); } }
    }
}
__device__ __forceinline__ void cmb_finish(CmbIn& I, const int t, const int lane, bf16* x, float* outf, const float* gain, const bool final_, signed char* H8, float* HS) {
    u32x2* xr = (u32x2*)(x + (size_t)t * DM) + lane; f32x4* fr_ = (f32x4*)(outf + (size_t)t * DM) + lane; const f32x4* gr = (const f32x4*)gain + lane;
    float ss = 0.f;
#pragma unroll
    for (int j = 0; j < 4; ++j) ss += (I.v[j].x * I.v[j].x + I.v[j].y * I.v[j].y) + (I.v[j].z * I.v[j].z + I.v[j].w * I.v[j].w);
    const float rstd = rsqrtf(wave_sum(ss) * (1.f / DM) + EPS);
    if (!final_) {
#pragma unroll
        for (int j = 0; j < 4; ++j) { const f32x4 g = gr[64 * j]; u32x2 xo; xo.x = pk2(I.v[j].x, I.v[j].y); xo.y = pk2(I.v[j].z, I.v[j].w); xr[64 * j] = xo; I.v[j].x *= rstd * g.x; I.v[j].y *= rstd * g.y; I.v[j].z *= rstd * g.z; I.v[j].w *= rstd * g.w; }
        quant_row_store(I.v, H8 + (size_t)t * DM, HS + t, lane); }
    else {
#pragma unroll
        for (int j = 0; j < 4; ++j) { const f32x4 g = gr[64 * j]; f32x4 o; o.x = I.v[j].x * rstd * g.x; o.y = I.v[j].y * rstd * g.y; o.z = I.v[j].z * rstd * g.z; o.w = I.v[j].w * rstd * g.w; fr_[64 * j] = o; } }
}
__device__ __forceinline__ void phase_combine_norm(Frame& F, const Args& a, int layer) {
    unsigned char* ws = F.ws; bf16* x = (bf16*)(ws + WS_XB); const bf16* Y = (const bf16*)(ws + WS_Y); const int* SLOT = (const int*)(ws + WS_SLOT); signed char* H8 = (signed char*)(ws + WS_H); float* HS = (float*)(ws + WS_HS);
    const bool final_ = (layer + 1 == DEPTH); const float* gain = final_ ? a.in[12] : a.in[6] + (size_t)(layer + 1) * DM;
    const int gw = F.vcu * NWAVES + F.wave, NGW = F.G * NWAVES, lane = F.lane;
#pragma unroll 1
    for (int t = gw; t < T; t += 2 * NGW) {
        CmbIn A, B; const int t2 = t + NGW; const bool two = t2 < T;
        cmb_load(A, t, lane, x, SLOT); cmb_load(B, two ? t2 : t, lane, x, SLOT);
        cmb_add_rows(A, t, lane, Y); if (two) cmb_add_rows(B, t2, lane, Y);
        cmb_finish(A, t, lane, x, a.out, gain, final_, H8, HS); if (two) cmb_finish(B, t2, lane, x, a.out, gain, final_, H8, HS);
    }
}

typedef short s16x4 __attribute__((ext_vector_type(4)));
constexpr int AT_ROWB = 128;
constexpr int AT_KOFF = 0, AT_VOFF = 256 * AT_ROWB, AT_BUF = 2 * 256 * AT_ROWB;
#define LDS_BAR() do { asm volatile("s_waitcnt lgkmcnt(0)" ::: "memory"); __builtin_amdgcn_s_barrier(); asm volatile("" ::: "memory"); } while (0)
struct AttnPre { v4u k[4], v[4]; bf16x8 q0, q1; };
__device__ __forceinline__ void attn_decode(const int su, int& g, int& b, int& h, int& r, int& u, int& dsh) {
    const int x = su & 15; h = (su >> 4) & 7; b = (su >> 7) & 7; g = su >> 10; dsh = 2 * g; r = x & ((1 << dsh) - 1); u = x >> dsh;
}
__device__ __forceinline__ void attn_issue(Frame& F, const int su, const bf16* __restrict__ PROJ, AttnPre& P) {
    int g, b, h, r, u, dsh; attn_decode(su, g, b, h, r, u, dsh); const int d = 1 << dsh, L = SEQ >> dsh;
    const bf16* kbase = PROJ + PO_ATT + ((((size_t)(g * 3 + 1) * 8 + b) * 8 + h) * 2048 + (size_t)r * L) * 64;
    constexpr size_t PART = (size_t)8 * 8 * 2048 * 64;
#pragma unroll
    for (int p = 0; p < 4; ++p) { const int idx = F.tid + 512 * p, kk = idx >> 3, ch = idx & 7;
        int lp = 128 * u - 64 + kk; lp = lp < 0 ? 0 : (lp > L - 1 ? L - 1 : lp);
        const bf16* src = kbase + (size_t)lp * 64 + ch * 8;
        P.k[p] = *(const v4u*)src; P.v[p] = *(const v4u*)(src + PART); }
    const int lq = 128 * u + 16 * F.wave + (F.lane & 15);
    const bf16* qp = kbase - PART + (size_t)lq * 64 + 8 * (F.lane >> 4);
    P.q0 = *(const bf16x8*)qp; P.q1 = *(const bf16x8*)(qp + 32);
}
__device__ __forceinline__ void attn_stage(Frame& F, const AttnPre& P, const int boff) {
    LAS unsigned char* Ks = F.lds + RING_OFF + boff + AT_KOFF; LAS unsigned char* Vs = F.lds + RING_OFF + boff + AT_VOFF;
#pragma unroll
    for (int p = 0; p < 4; ++p) { const int idx = F.tid + 512 * p, kk = idx >> 3, ch = idx & 7, o = kk * AT_ROWB + ((ch ^ (kk & 7)) << 4);
        *(LAS v4u*)(Ks + o) = P.k[p]; *(LAS v4u*)(Vs + o) = P.v[p]; }
}
__device__ __forceinline__ void attn_compute(Frame& F, const int su, const bf16x8 qf0, const bf16x8 qf1, bf16* __restrict__ ATTO, float* __restrict__ LSEb, const int boff) {
    int g, b, h, r, u, dsh; attn_decode(su, g, b, h, r, u, dsh); const int d = 1 << dsh, L = SEQ >> dsh;
    const int lane = F.lane, w = F.wave, q = lane & 15, kg = lane >> 4;
    LAS unsigned char* Ks = F.lds + RING_OFF + boff + AT_KOFF; LAS unsigned char* Vs = F.lds + RING_OFF + boff + AT_VOFF;
    const int lq = 128 * u + 16 * w + q; const size_t tokq = (size_t)(b * SEQ + lq * d + r);
    f32x4 sc[9];
    {   const LAS unsigned char* kp = Ks + (16 * w + q) * AT_ROWB; const int ko0 = (kg ^ (q & 7)) << 4, ko1 = ko0 ^ 64;
#pragma unroll
        for (int hb = 0; hb < 2; ++hb) { bf16x8 kf[5][2];
#pragma unroll
            for (int i = 0; i < 5; ++i) if (5 * hb + i < 9) { kf[i][0] = *(const LAS bf16x8*)(kp + (5 * hb + i) * 16 * AT_ROWB + ko0); kf[i][1] = *(const LAS bf16x8*)(kp + (5 * hb + i) * 16 * AT_ROWB + ko1); }
            __builtin_amdgcn_sched_barrier(0);
#pragma unroll
            for (int i = 0; i < 5; ++i) if (5 * hb + i < 9) sc[5 * hb + i] = __builtin_amdgcn_mfma_f32_16x16x32_bf16(kf[i][0], qf0, (f32x4){0.f, 0.f, 0.f, 0.f}, 0, 0, 0);
#pragma unroll
            for (int i = 0; i < 5; ++i) if (5 * hb + i < 9) sc[5 * hb + i] = __builtin_amdgcn_mfma_f32_16x16x32_bf16(kf[i][1], qf1, sc[5 * hb + i], 0, 0, 0);
            __builtin_amdgcn_sched_barrier(0); } }
    const float c1 = 0.125f * 1.4426950408889634f, c2 = __builtin_amdgcn_exp2f(-(float)(h + 1)) * (float)d * 1.4426950408889634f;
    float ce[4], ae[4]; bool ge0[4], le0[4];
#pragma unroll
    for (int rr = 0; rr < 4; ++rr) { const int e = 4 * kg + rr - q; ce[rr] = c2 * (float)e; ae[rr] = -c2 * (float)(e < 0 ? -e : e); ge0[rr] = e >= 0; le0[rr] = e <= 0; }
    float mx = -INFINITY;
#pragma unroll
    for (int i = 0; i < 9; ++i) { const bool ok = (unsigned)(128 * u - 64 + 16 * (w + i)) < (unsigned)L;
        const float ki = -c2 * (float)(i < 4 ? 64 - 16 * i : 16 * i - 64);
#pragma unroll
        for (int rr = 0; rr < 4; ++rr) { float v = (i < 4) ? (sc[i][rr] * c1 + ce[rr]) + ki : (i == 4) ? sc[i][rr] * c1 + ae[rr] : (sc[i][rr] * c1 - ce[rr]) + ki;
            bool val = ok; if (i == 0) val = val && ge0[rr]; if (i == 8) val = val && le0[rr];
            v = val ? v : -INFINITY; sc[i][rr] = v; mx = fmaxf(mx, v); } }
    mx = fmaxf(mx, __shfl_xor(mx, 16)); mx = fmaxf(mx, __shfl_xor(mx, 32));
    float sum = 0.f; s16x4 pf[9];
#pragma unroll
    for (int i = 0; i < 9; ++i) { const float p0 = __builtin_amdgcn_exp2f(sc[i][0] - mx), p1 = __builtin_amdgcn_exp2f(sc[i][1] - mx), p2 = __builtin_amdgcn_exp2f(sc[i][2] - mx), p3 = __builtin_amdgcn_exp2f(sc[i][3] - mx);
        sum += (p0 + p1) + (p2 + p3); const unsigned lo = pk2(p0, p1), hi = pk2(p2, p3);
        pf[i] = (s16x4){(short)(lo & 0xffff), (short)(lo >> 16), (short)(hi & 0xffff), (short)(hi >> 16)}; }
    sum += __shfl_xor(sum, 16); sum += __shfl_xor(sum, 32);
    const float inv = 1.f / sum;
    const LAS unsigned char* vp = Vs + (16 * w + 4 * kg + (q >> 2)) * AT_ROWB + 8 * (q & 1); const int vm = (4 * kg + (q >> 2)) & 7, vc = (q & 3) >> 1;
    bf16* op = ATTO + ((size_t)g * T + tokq) * AW + h * 64 + 4 * kg;
#pragma unroll
    for (int dh = 0; dh < 2; ++dh) { s16x4 vf[2][9];
#pragma unroll
        for (int dd = 0; dd < 2; ++dd)
#pragma unroll
            for (int i = 0; i < 9; ++i) vf[dd][i] = __builtin_bit_cast(s16x4, __builtin_amdgcn_ds_read_tr16_b64_v4i16((LAS s16x4*)(vp + i * 16 * AT_ROWB + (((2 * (2 * dh + dd) + vc) ^ vm) << 4))));
        __builtin_amdgcn_sched_barrier(0);
        f32x4 acc[2] = {{0.f, 0.f, 0.f, 0.f}, {0.f, 0.f, 0.f, 0.f}};
#pragma unroll
        for (int i = 0; i < 9; ++i) { acc[0] = __builtin_amdgcn_mfma_f32_16x16x16bf16_1k(vf[0][i], pf[i], acc[0], 0, 0, 0); acc[1] = __builtin_amdgcn_mfma_f32_16x16x16bf16_1k(vf[1][i], pf[i], acc[1], 0, 0, 0); }
#pragma unroll
        for (int dd = 0; dd < 2; ++dd) { u32x2 o; o.x = pk2(acc[dd][0] * inv, acc[dd][1] * inv); o.y = pk2(acc[dd][2] * inv, acc[dd][3] * inv);
            *(u32x2*)(op + 16 * (2 * dh + dd)) = o; } }
    if (kg == 0) LSEb[((size_t)g * T + tokq) * 8 + h] = (mx + __log2f(sum)) * 0.6931471805599453f;
}
__device__ __forceinline__ void phase_attn(Frame& F, const Args& a, const int layer, const bool dyn) {
    unsigned char* ws = F.ws; const bf16* PROJ = (const bf16*)(ws + WS_PROJ);
    constexpr int NSU = 3 * NB * 8 * 16;
    AttnPre P;
    bf16x8 qc0, qc1;
    if (dyn) {
        constexpr int NQ = 3 * 8 * 16;
        GAS unsigned* qg = (GAS unsigned*)F.ctl; asm volatile("" : "+s"(qg)); unsigned* qctr = (unsigned*)qg + CW_AQ + 64 * (unsigned)__builtin_amdgcn_readfirstlane((int)F.MISC[3]) + layer;
        const int xb = F.vcu >> 5; volatile LAS unsigned* aq = F.MISC + 32;
        auto su_of = [&](int li) { return ((li >> 7) << 10) | (xb << 7) | (li & 127); };
        if (F.tid == 0) { aq[0] = xb_add(qctr, 1u); aq[1] = xb_add(qctr, 1u); aq[2] = xb_add(qctr, 1u); }
        __syncthreads();
        int u0 = __builtin_amdgcn_readfirstlane((int)aq[0]), u1 = __builtin_amdgcn_readfirstlane((int)aq[1]), u2 = __builtin_amdgcn_readfirstlane((int)aq[2]);
        if (u0 < NQ) { attn_issue(F, su_of(u0), PROJ, P); attn_stage(F, P, 0); qc0 = P.q0; qc1 = P.q1; if (u1 < NQ) attn_issue(F, su_of(u1), PROJ, P); }
        LDS_BAR();
#pragma unroll 1
        for (int par = 0; u0 < NQ; par ^= 1) {
            unsigned f = (unsigned)NQ; if (F.tid == 0 && u2 < NQ) f = xb_add(qctr, 1u);
            bf16x8 qn0 = qc0, qn1 = qc1;
            if (u1 < NQ) { attn_stage(F, P, (par ^ 1) * AT_BUF); qn0 = P.q0; qn1 = P.q1; if (u2 < NQ) attn_issue(F, su_of(u2), PROJ, P); }
            attn_compute(F, su_of(u0), qc0, qc1, (bf16*)(ws + WS_ATTO), (float*)(ws + WS_LSE), par * AT_BUF);
            if (F.tid == 0) aq[4 + par] = f;
            LDS_BAR();
            const int u3 = __builtin_amdgcn_readfirstlane((int)aq[4 + par]);
            u0 = u1; u1 = u2; u2 = u3; qc0 = qn0; qc1 = qn1;
        }
        __syncthreads();
        return;
    }
    if (F.vcu < NSU) { attn_issue(F, F.vcu, PROJ, P); attn_stage(F, P, 0); qc0 = P.q0; qc1 = P.q1; if (F.vcu + F.G < NSU) attn_issue(F, F.vcu + F.G, PROJ, P); }
    LDS_BAR();
#pragma unroll 1
    for (int su = F.vcu, par = 0; su < NSU; su += F.G, par ^= 1) {
        bf16x8 qn0 = qc0, qn1 = qc1;
        if (su + F.G < NSU) { attn_stage(F, P, (par ^ 1) * AT_BUF); qn0 = P.q0; qn1 = P.q1;
            if (su + 2 * F.G < NSU) attn_issue(F, su + 2 * F.G, PROJ, P); }
        attn_compute(F, su, qc0, qc1, (bf16*)(ws + WS_ATTO), (float*)(ws + WS_LSE), par * AT_BUF);
        LDS_BAR();
        qc0 = qn0; qc1 = qn1;
    }
    __syncthreads();
}
constexpr int RT_ROWB = 528, RT_ROWS = 144, RT_KB = 64 * RT_ROWB, RT_VB = 64 * RT_ROWS;
constexpr int RT_K = 0, RT_S = 2 * RT_KB, RT_V = 3 * RT_KB, RT_P = RT_V + 2 * RT_VB, RT_END = RT_P + RT_VB;
static_assert(RT_END <= RING_BYTES, "retention LDS map");
__device__ __forceinline__ void ret_unit(Frame& F, const int unit, const bf16* __restrict__ PROJ, const float* __restrict__ dlog, bf16* __restrict__ YF, bf16* __restrict__ YB) {
    const int dvs = unit & 3, dir = (unit >> 2) & 1, h = (unit >> 3) & 3, b = unit >> 5;
    const int tid = F.tid, lane = F.lane, w = F.wave, fr = lane & 15, kg = lane >> 4;
    LAS unsigned char* L0 = F.lds + RING_OFF;
    const float lg = -log1pf(expf(-dlog[dir * 4 + h]));
    const float gC = __expf(lg * 64.f);
    const int srow = tid >> 5, sch = tid & 31, vrow = tid >> 3, vch = tid & 7;
    float zeta[4];
#pragma unroll
    for (int p = 0; p < 4; ++p) { const int m = srow + 16 * p; zeta[p] = __expf(lg * (float)(dir ? m : 63 - m)); }
    const int qt = w >> 1, half = w & 1;
    const int nq = 16 * qt + fr;
    const float rho = __expf(lg * (float)(dir ? -nq : nq - 63)) * 0.0625f;
    const bf16* qbase = PROJ + PO_RQK + ((size_t)(b * 4 + h) * 2048 + nq) * 256 + 8 * kg;
    const bf16* colk = PROJ + PO_RQK + (size_t)T * RW + ((size_t)(b * 4 + h) * 2048) * 256 + sch * 8; const bf16* colv = PROJ + PO_RV + (((size_t)(b * 4 + h) * 4 + dvs) * 2048) * 64 + vch * 8;
    bf16* Yo = (dir ? YB : YF) + h * 256 + dvs * 64;
    __syncthreads();
    { unsigned z = 0u; asm volatile("" : "+v"(z));
      for (int i = tid; i < 64 * RT_ROWB / 16; i += NWAVES * 64) ((LAS v4u*)(L0 + RT_S))[i] = (v4u){z, z, z, z}; }
    f32x4 st[2][4];
#pragma unroll
    for (int a = 0; a < 2; ++a)
#pragma unroll
        for (int c = 0; c < 4; ++c) st[a][c] = (f32x4){0.f, 0.f, 0.f, 0.f};
    v4u pk[4], pv; bf16x8 qc[8], qn[8];
#define RET_LOADKV(ci_) do { const size_t t0_ = (size_t)64 * (ci_); _Pragma("unroll") for (int p = 0; p < 4; ++p) pk[p] = *(const v4u*)(colk + (t0_ + srow + 16 * p) * 256); pv = *(const v4u*)(colv + (t0_ + vrow) * 64); } while (0)
#define RET_LOADQ(dst, ci_) do { const bf16* qg_ = qbase + ((size_t)64 * (ci_)) * 256; _Pragma("unroll") for (int s = 0; s < 8; ++s) dst[s] = *(const bf16x8*)(qg_ + 32 * s); } while (0)
#define RET_STAGE(bf_) do { LAS unsigned char* kb_ = L0 + RT_K + (bf_) * RT_KB; _Pragma("unroll") for (int p = 0; p < 4; ++p) { const int row = srow + 16 * p; const float z = zeta[p]; v4u kk = pk[p]; \
            kk.x = pk2(bflo(kk.x) * z, bfhi(kk.x) * z); kk.y = pk2(bflo(kk.y) * z, bfhi(kk.y) * z); kk.z = pk2(bflo(kk.z) * z, bfhi(kk.z) * z); kk.w = pk2(bflo(kk.w) * z, bfhi(kk.w) * z); \
            *(LAS v4u*)(kb_ + row * RT_ROWB + sch * 16) = kk; } \
        LAS unsigned short* vt = (LAS unsigned short*)(L0 + RT_V + (bf_) * RT_VB) + vrow; \
        vt[(8 * vch + 0) * 72] = (unsigned short)(pv.x & 0xffff); vt[(8 * vch + 1) * 72] = (unsigned short)(pv.x >> 16); \
        vt[(8 * vch + 2) * 72] = (unsigned short)(pv.y & 0xffff); vt[(8 * vch + 3) * 72] = (unsigned short)(pv.y >> 16); \
        vt[(8 * vch + 4) * 72] = (unsigned short)(pv.z & 0xffff); vt[(8 * vch + 5) * 72] = (unsigned short)(pv.z >> 16); \
        vt[(8 * vch + 6) * 72] = (unsigned short)(pv.w & 0xffff); vt[(8 * vch + 7) * 72] = (unsigned short)(pv.w >> 16); } while (0)
    {   const int cf = dir ? 31 : 0, cs = dir ? 30 : 1;
        RET_LOADKV(cf); RET_LOADQ(qc, cf); RET_STAGE(0); RET_LOADKV(cs); }
    LDS_BAR();
#pragma unroll 1
    for (int step = 0; step < 32; ++step) {
        const int ci = dir ? 31 - step : step, cur = step & 1;
        const LAS unsigned char* Kc = L0 + RT_K + cur * RT_KB; const LAS unsigned char* Vc = L0 + RT_V + cur * RT_VB;
        if (step + 1 < 32) { RET_STAGE(cur ^ 1); if (step + 2 < 32) RET_LOADKV(dir ? ci - 2 : ci + 2); RET_LOADQ(qn, dir ? ci - 1 : ci + 1); }
        {   bf16x8 kf[2][8];
            const LAS unsigned char* kp = Kc + (32 * half + fr) * RT_ROWB + 16 * kg;
#pragma unroll
            for (int s = 0; s < 8; ++s) { kf[0][s] = *(const LAS bf16x8*)(kp + 64 * s); kf[1][s] = *(const LAS bf16x8*)(kp + 16 * RT_ROWB + 64 * s); }
            f32x4 acc[2] = {{0.f, 0.f, 0.f, 0.f}, {0.f, 0.f, 0.f, 0.f}};
#pragma unroll
            for (int s = 0; s < 8; ++s) { acc[0] = __builtin_amdgcn_mfma_f32_16x16x32_bf16(kf[0][s], qc[s], acc[0], 0, 0, 0); acc[1] = __builtin_amdgcn_mfma_f32_16x16x32_bf16(kf[1][s], qc[s], acc[1], 0, 0, 0); }
#pragma unroll
            for (int j = 0; j < 2; ++j) { const int m0 = 32 * half + 16 * j + 4 * kg;
                float p0 = acc[j][0], p1 = acc[j][1], p2 = acc[j][2], p3 = acc[j][3];
                if (dir) { p0 = (m0 + 0 > nq) ? p0 : 0.f; p1 = (m0 + 1 > nq) ? p1 : 0.f; p2 = (m0 + 2 > nq) ? p2 : 0.f; p3 = (m0 + 3 > nq) ? p3 : 0.f; }
                else     { p0 = (m0 + 0 <= nq) ? p0 : 0.f; p1 = (m0 + 1 <= nq) ? p1 : 0.f; p2 = (m0 + 2 <= nq) ? p2 : 0.f; p3 = (m0 + 3 <= nq) ? p3 : 0.f; }
                u32x2 o; o.x = pk2(p0, p1); o.y = pk2(p2, p3);
                *(LAS u32x2*)(L0 + RT_P + nq * RT_ROWS + m0 * 2) = o; } }
        {   bf16x8 vf[4][2], kf[2][2];
#pragma unroll
            for (int c = 0; c < 4; ++c)
#pragma unroll
                for (int s = 0; s < 2; ++s) vf[c][s] = *(const LAS bf16x8*)(Vc + (16 * c + fr) * RT_ROWS + 64 * s + 16 * kg);
#pragma unroll
            for (int a = 0; a < 2; ++a)
#pragma unroll
                for (int s = 0; s < 2; ++s) {
                    const LAS unsigned char* tp = Kc + (32 * s + 8 * kg + (fr >> 2)) * RT_ROWB + (16 * (2 * w + a) + 4 * (fr & 3)) * 2;
                    const s16x4 lo = __builtin_bit_cast(s16x4, __builtin_amdgcn_ds_read_tr16_b64_v4i16((LAS s16x4*)tp));
                    const s16x4 hi = __builtin_bit_cast(s16x4, __builtin_amdgcn_ds_read_tr16_b64_v4i16((LAS s16x4*)(tp + 4 * RT_ROWB)));
                    kf[a][s] = (bf16x8){lo[0], lo[1], lo[2], lo[3], hi[0], hi[1], hi[2], hi[3]}; }
            __builtin_amdgcn_sched_barrier(0);
#pragma unroll
            for (int s = 0; s < 2; ++s)
#pragma unroll
                for (int a = 0; a < 2; ++a)
#pragma unroll
                    for (int c = 0; c < 4; ++c) st[a][c] = __builtin_amdgcn_mfma_f32_16x16x32_bf16(kf[a][s], vf[c][s], st[a][c], 0, 0, 0); }
        LDS_BAR();
        {   bf16x8 pf[2], vf[2][2];
            const LAS unsigned char* pp = L0 + RT_P + (16 * qt + fr) * RT_ROWS + 16 * kg; pf[0] = *(const LAS bf16x8*)pp; pf[1] = *(const LAS bf16x8*)(pp + 64);
            const LAS unsigned char* vp = Vc + (32 * half + fr) * RT_ROWS + 16 * kg;
            const LAS unsigned char* sp = L0 + RT_S + (32 * half + fr) * RT_ROWB + 16 * kg;
#pragma unroll
            for (int j = 0; j < 2; ++j) { vf[j][0] = *(const LAS bf16x8*)(vp + j * 16 * RT_ROWS); vf[j][1] = *(const LAS bf16x8*)(vp + j * 16 * RT_ROWS + 64); }
            f32x4 acc[2] = {{0.f, 0.f, 0.f, 0.f}, {0.f, 0.f, 0.f, 0.f}};
#pragma unroll
            for (int hs = 0; hs < 2; ++hs) { bf16x8 sf[2][4];
#pragma unroll
                for (int s = 0; s < 4; ++s) { sf[0][s] = *(const LAS bf16x8*)(sp + 64 * (4 * hs + s)); sf[1][s] = *(const LAS bf16x8*)(sp + 16 * RT_ROWB + 64 * (4 * hs + s)); }
                __builtin_amdgcn_sched_barrier(0);
                if (hs == 0) {
#pragma unroll
                    for (int s = 0; s < 2; ++s) { acc[0] = __builtin_amdgcn_mfma_f32_16x16x32_bf16(vf[0][s], pf[s], acc[0], 0, 0, 0); acc[1] = __builtin_amdgcn_mfma_f32_16x16x32_bf16(vf[1][s], pf[s], acc[1], 0, 0, 0); } }
#pragma unroll
                for (int s = 0; s < 4; ++s) { acc[0] = __builtin_amdgcn_mfma_f32_16x16x32_bf16(sf[0][s], qc[4 * hs + s], acc[0], 0, 0, 0); acc[1] = __builtin_amdgcn_mfma_f32_16x16x32_bf16(sf[1][s], qc[4 * hs + s], acc[1], 0, 0, 0); }
                __builtin_amdgcn_sched_barrier(0); }
            const size_t tok = (size_t)b * SEQ + 64 * ci + nq;
#pragma unroll
            for (int j = 0; j < 2; ++j) { u32x2 o; o.x = pk2(acc[j][0] * rho, acc[j][1] * rho); o.y = pk2(acc[j][2] * rho, acc[j][3] * rho);
                *(u32x2*)(Yo + tok * RW + 16 * (2 * half + j) + 4 * kg) = o; } }
        LDS_BAR();
#pragma unroll
        for (int a = 0; a < 2; ++a)
#pragma unroll
            for (int c = 0; c < 4; ++c) { st[a][c] *= gC; u32x2 o; o.x = pk2(st[a][c][0], st[a][c][1]); o.y = pk2(st[a][c][2], st[a][c][3]);
                *(LAS u32x2*)(L0 + RT_S + (16 * c + fr) * RT_ROWB + (16 * (2 * w + a) + 4 * kg) * 2) = o; }
        if (step + 1 < 32) {
#pragma unroll
            for (int s = 0; s < 8; ++s) qc[s] = qn[s]; }
    }
#undef RET_LOADKV
#undef RET_LOADQ
#undef RET_STAGE
    __syncthreads();
}
__device__ __forceinline__ void phase_mix(Frame& F, const Args& a, int layer) {
    unsigned char* ws = F.ws; const bf16* PROJ = (const bf16*)(ws + WS_PROJ);
#ifndef REP_RET
#define REP_RET 1
#define REP_ATTN 1
#endif
#pragma unroll 1
    for (int rr = 0; rr < REP_RET; ++rr)
#pragma unroll 1
    for (int unit = F.vcu; unit < NB * 4 * 4 * 2; unit += F.G) ret_unit(F, unit, PROJ, a.in[5] + layer * 8, (bf16*)(ws + WS_YF), (bf16*)(ws + WS_YB));
    const bool dyn = __builtin_amdgcn_readfirstlane((int)F.MISC[2]) != 0 && F.G == 256 && REP_MASK == 0 && REP_RET == 1 && REP_ATTN == 1;
#pragma unroll 1
    for (int rr = 0; rr < REP_ATTN; ++rr) phase_attn(F, a, layer, dyn);
}


constexpr int popc10(int m) { int c = 0; for (int k = 0; k < 10; ++k) c += (m >> k) & 1; return c; }
constexpr int REP0 = (REP_MASK >> 10) & 1, SLOTS_LAYER = NPH_LAYER + popc10(REP_MASK), NSLOTS = 1 + REP0 + DEPTH * SLOTS_LAYER;
__device__ __forceinline__ int slot_phase(int slot) {
#if REP_MASK
    if (slot <= REP0) return 0;
    const int s = slot - 1 - REP0, layer = s / SLOTS_LAYER; int j = s % SLOTS_LAYER, k = 0;
    for (;;) { const int n = 1 + ((REP_MASK >> k) & 1); if (j < n) break; j -= n; ++k; }
    return 1 + layer * NPH_LAYER + k;
#else
    return slot;
#endif
}
__global__ void __launch_bounds__(NWAVES * 64, 2) mega(Args args) {
    extern __shared__ __attribute__((aligned(16))) unsigned char lds[];
    Frame F;
    F.lds = (LAS unsigned char*)lds; F.MISC = (volatile LAS unsigned*)(F.lds + MISC_OFF);
    F.tid = threadIdx.x; F.lane = F.tid & 63; F.wave = __builtin_amdgcn_readfirstlane(F.tid >> 6);
    F.G = gridDim.x;
    unsigned char* ws = args.ws; F.ctl = (unsigned*)(ws + WS_CTL);
    for (int u = F.tid; u < (LDS_BYTES - LDSCTL_OFF) / 4; u += NWAVES * 64) ((LAS unsigned*)(F.lds + LDSCTL_OFF))[u] = 0u;
    __syncthreads();
    if (F.tid == 0) {
        unsigned* cen = F.ctl + CW_CENSUS; const unsigned x = xb_xcc_id(); const unsigned slot = xb_add(&cen[64 * x], 1u);
        unsigned cnt[16]; unsigned sum = 0, sp = 0;
        for (;;) { sum = 0;
#pragma unroll
            for (int j = 0; j < 16; ++j) { cnt[j] = xb_ld(&cen[64 * j]); sum += cnt[j]; }
            if (sum == (unsigned)F.G || ++sp > (1u << 20)) break; __builtin_amdgcn_s_sleep(1); }
        unsigned pop = 0, ord = 0; bool even = (sum == (unsigned)F.G) && (F.G % 8 == 0);
#pragma unroll
        for (int j = 0; j < 16; ++j) { if (cnt[j]) { ++pop; if ((unsigned)j < x) ++ord; if (cnt[j] != (unsigned)F.G / 8) even = false; } }
        even = even && pop == 8;
        F.MISC[0] = even ? slot * 8 + ord : blockIdx.x;
        F.MISC[1] = even ? ord * (F.G / 8) + slot : blockIdx.x;
        F.MISC[2] = even ? 1u : 0u; F.MISC[3] = x;
    }
    __syncthreads();
    const int cid0 = __builtin_amdgcn_readfirstlane((int)F.MISC[0]), vcu0 = __builtin_amdgcn_readfirstlane((int)F.MISC[1]); F.cid = cid0; F.vcu = vcu0;
    const bool multi = !USE_CG_SYNC && (args.ph_hi - args.ph_lo) > 1;
    XcdBarrier bar; bar.bar = F.ctl + CW_BAR; bar.x = 0; bar.st = nullptr;
    if (multi) bar = xcd_barrier_post(F.ctl + CW_BAR, F.MISC + 8);
#pragma unroll 1
    for (int slot = args.ph_lo; slot < args.ph_hi; ++slot) {
        const int ph = slot_phase(slot);
        GAS unsigned char* wsg = (GAS unsigned char*)args.ws; asm volatile("" : "+s"(wsg)); unsigned char* ws = (unsigned char*)wsg; F.ws = ws;
        { int v_ = vcu0, c_ = cid0, g_ = (int)gridDim.x; asm volatile("" : "+s"(v_), "+s"(c_), "+s"(g_)); F.vcu = v_; F.cid = c_; F.G = g_; }
        { int tid_ = threadIdx.x; asm volatile("" : "+v"(tid_)); F.tid = tid_; F.lane = tid_ & 63; F.wave = __builtin_amdgcn_readfirstlane(tid_ >> 6); }
        {
        if (ph == 0) phase_p0(F, args);
        else {
            const int layer = (ph - 1) / NPH_LAYER, k = (ph - 1) % NPH_LAYER;
            if (k == 0) {
                pg8::Gemm g{(const pg8::bf16_t*)(ws + WS_H), (const pg8::bf16_t*)(ws + WS_WIN) + (size_t)layer * NIN * (DM / 2), T, NIN, DM / 2, 30, 0}; pg8::StaticOrder S; S.init(T, NIN, F.G, F.cid);
                pg8::EpiStoreI8 E{(pg8::bf16_t*)(ws + WS_PROJ), NIN, (const float*)(ws + WS_HS), (const float*)(ws + WS_WINS) + (size_t)layer * NIN};
                if (__builtin_amdgcn_readfirstlane((int)F.MISC[2]) != 0 && F.G == 256 && REP_MASK == 0 && REP_RET == 1 && REP_ATTN == 1) { GAS unsigned* cp = (GAS unsigned*)F.ctl; asm volatile("" : "+s"(cp));
                    S.sync_ui = 8; S.sctl = (unsigned*)cp; S.sx = (unsigned)__builtin_amdgcn_readfirstlane((int)F.MISC[3]); S.snloc = (unsigned)F.G / 8u; S.stmo = (unsigned*)cp + CW_BAR; }
                pg8::gemm_phase<pg8::EpiStoreI8, pg8::StaticOrder, true, true, 1>(F.lds + RING_OFF, g, S, E, F.tid);
            } else if (k == 1) phase_mix(F, args, layer); else if (k == 2) phase_finalize(F, args);
            else if (k == 3) {
                pg8::Gemm g{(const pg8::bf16_t*)(ws + WS_CAT), (const pg8::bf16_t*)(ws + WS_WCAT + (size_t)layer * DM * CATW), T, DM, CATW / 2, 30, 0}; pg8::StaticOrder S; S.init(T, DM, F.G, F.cid);
                pg8::EpiMerge E{(const pg8::bf16_t*)(ws + WS_PROJ), (pg8::bf16_t*)(ws + WS_MERGED), 1.f / 1024.f};
                pg8::gemm_phase<pg8::EpiMerge, pg8::StaticOrder, true, true, 2>(F.lds + RING_OFF, g, S, E, F.tid);
            } else if (k == 4) {
                pg8::Gemm g{(const pg8::bf16_t*)(ws + WS_MERGED), (const pg8::bf16_t*)(ws + WS_WO) + (size_t)layer * DM * DM, T, DM, DM, 30, 0}; pg8::StaticOrder S; S.init(T, DM, F.G, F.cid);
                if (layer == 0) { pg8::EpiResidB<true> E{(const void*)args.in[0], (pg8::bf16_t*)(ws + WS_XB), 1.f}; pg8::gemm_phase<pg8::EpiResidB<true>, pg8::StaticOrder, true, true>(F.lds + RING_OFF, g, S, E, F.tid); }
                else { pg8::EpiResidB<false> E{(const void*)(ws + WS_XB), (pg8::bf16_t*)(ws + WS_XB), 1.f}; pg8::gemm_phase<pg8::EpiResidB<false>, pg8::StaticOrder, true, true>(F.lds + RING_OFF, g, S, E, F.tid); }
            } else if (k == 5) phase_norm_router(F, args, layer);
            else if (k == 6) phase_topk(F, args);
            else if (k == 7) {
                pg8::Gemm g{(const pg8::bf16_t*)(ws + WS_XIN), (const pg8::bf16_t*)(ws + WS_WGU) + (size_t)layer * NE * 2 * FF * (DM / 2), NROWS_E, 2 * FF, DM / 2, 3, (size_t)2 * FF * DM}; pg8::StaticOrder S; S.init(NROWS_E, 2 * FF, F.G, F.cid);
                pg8::EpiSwigluI8 E{(pg8::bf16_t*)(ws + WS_ACT), (const float*)(ws + WS_XS), (const float*)(ws + WS_WGUS) + (size_t)layer * NE * 2 * FF, 1};
                pg8::gemm_phase<pg8::EpiSwigluI8, pg8::StaticOrder, true, true, 1>(F.lds + RING_OFF, g, S, E, F.tid);
            } else if (k == 8) {
                pg8::StaticOrder S; S.init(NROWS_E, DM, F.G, F.cid);
                {   pg8::Gemm g{(const pg8::bf16_t*)(ws + WS_ACT), (const pg8::bf16_t*)(ws + WS_WDN + (size_t)layer * NE * DM * FF), NROWS_E, DM, FF / 2, 3, (size_t)DM * FF};
                    pg8::EpiDown E{(const float*)(ws + WS_GW), (pg8::bf16_t*)(ws + WS_Y), 1.f / 1024.f};
                    pg8::gemm_phase<pg8::EpiDown, pg8::StaticOrder, true, true, 2>(F.lds + RING_OFF, g, S, E, F.tid); }
            } else phase_combine_norm(F, args, layer);
        }
        }
        const int kk_ = (ph - 1) % NPH_LAYER; const bool local_seam = __builtin_amdgcn_readfirstlane((int)F.MISC[2]) != 0 && ph > 0 && (kk_ == 3 || kk_ == 4 || kk_ == 5 || kk_ == 7) && slot + 1 < args.ph_hi && slot_phase(slot + 1) == ph + 1;
        const bool no_seam = ph > 0 && kk_ == 0 && __builtin_amdgcn_readfirstlane((int)F.MISC[2]) != 0 && F.G == 256 && REP_MASK == 0 && REP_RET == 1 && REP_ATTN == 1;
        if (slot + 1 < args.ph_hi && !no_seam) { if (USE_CG_SYNC || slot - args.ph_lo < args.cg_seams) cooperative_groups::this_grid().sync(); else if (local_seam) { GAS unsigned* cp = (GAS unsigned*)F.ctl; asm volatile("" : "+s"(cp)); xcc_local_barrier((unsigned*)cp, (unsigned)__builtin_amdgcn_readfirstlane((int)F.MISC[3]), (unsigned)F.G / 8u, (unsigned*)cp + CW_BAR); } else { XcdBarrier bb = bar; GAS unsigned* bp = (GAS unsigned*)bb.bar; asm volatile("" : "+s"(bp)); bb.bar = (unsigned*)bp; xcd_barrier(bb); } }
    }
}


extern "C" void kernel_launch(void* const* d_in, const int* in_sizes, int n_in, void* d_out, int out_size, void* d_ws, size_t ws_size, hipStream_t stream) {
    static int grid = 0;
    if (grid == 0) {
        if (n_in != 13 || in_sizes[0] != T * DM || out_size != T * DM || ws_size < WS_END) { fprintf(stderr, "kernel_launch: unexpected shapes (n_in %d, ws %zu)\n", n_in, ws_size); grid = -1; return; }
        if (hipFuncSetAttribute((const void*)mega, hipFuncAttributeMaxDynamicSharedMemorySize, LDS_BYTES) != hipSuccess) { fprintf(stderr, "kernel_launch: hipFuncSetAttribute failed\n"); grid = -1; return; }
        int dev = 0, cus = 0, per_cu = 0;
        if (hipGetDevice(&dev) != hipSuccess || hipDeviceGetAttribute(&cus, hipDeviceAttributeMultiprocessorCount, dev) != hipSuccess) { grid = -1; return; }
        if (hipOccupancyMaxActiveBlocksPerMultiprocessor(&per_cu, (const void*)mega, NWAVES * 64, LDS_BYTES) != hipSuccess || per_cu < 1) { fprintf(stderr, "kernel_launch: occupancy query says %d blocks per CU; nothing launched\n", per_cu); grid = -1; return; }
        (void)hipGetLastError();
        grid = cus;
    }
    if (grid < 0) return;
    unsigned char* ws = (unsigned char*)d_ws;
    hipMemsetAsync(ws + WS_CTL, 0, CTL_ZERO_BYTES, stream);
    Args a{};
    for (int i = 0; i < 13; ++i) a.in[i] = (const float*)d_in[i];
    a.out = (float*)d_out; a.ws = ws; a.ph_lo = 0; a.ph_hi = NSLOTS; a.cg_seams = 0; a.pad = 0;
    void* kargs[] = {&a};
    hipError_t e = hipLaunchCooperativeKernel((const void*)mega, dim3(grid), dim3(NWAVES * 64), kargs, LDS_BYTES, stream);
    if (e != hipSuccess) fprintf(stderr, "kernel_launch: cooperative launch failed: %s (grid %d)\n", hipGetErrorString(e), grid);
}
```

```cpp
#include <hip/hip_runtime.h>
#include <hip/hip_cooperative_groups.h>
#include <cstdio>
#include <cstdint>

constexpr int NB = 8, SEQ = 2048, DM = 1024, T = NB * SEQ, DEPTH = 2;
constexpr int NIN = 10752, ATTN_IN = 4608, AW = 512, RW = 1024, CATW = AW + RW;
constexpr int OFF_RQ = 4608, OFF_RK = 5632, OFF_RV = 6656, OFF_RG = 7680, OFF_GA = 8704, OFF_GR = 9728;
constexpr int NE = 16, FF = 2048, CAP = 256, NROWS_E = NB * NE * CAP;
constexpr float EPS = 1e-6f;

constexpr size_t PO_ATT = 0, PO_RQK = (size_t)9 * T * AW, PO_RV = PO_RQK + (size_t)2 * T * RW, PO_RG = PO_RV + (size_t)T * RW, PO_GATE = PO_RG + (size_t)T * RW, PO_END = PO_GATE + (size_t)2 * T * DM;
static_assert(PO_END == (size_t)T * NIN, "split projection layout covers the PROJ region exactly");
struct ProjCol { size_t base; unsigned bstride, pitch; int dsh; };
__host__ __device__ __forceinline__ ProjCol proj_col(int c) {
    ProjCol p;
    if (c < 4608) { const int g = c / 1536, r = c - g * 1536, which = r >> 9, h = (r >> 6) & 7, dc = r & 63; p.base = PO_ATT + (((size_t)(g * 3 + which) * 64 + h) * 2048) * 64 + dc; p.bstride = 8u * 2048u * 64u; p.pitch = 64; p.dsh = 2 * g; }
    else if (c < 6656) { const int r = c - 4608, which = r >> 10, h = (r >> 8) & 3, dk = r & 255; p.base = PO_RQK + (((size_t)which * 32 + h) * 2048) * 256 + dk; p.bstride = 4u * 2048u * 256u; p.pitch = 256; p.dsh = 0; }
    else if (c < 7680) { const int r = c - 6656, h = r >> 8, dvs = (r >> 6) & 3, dv = r & 63; p.base = PO_RV + (((size_t)h * 4 + dvs) * 2048) * 64 + dv; p.bstride = 16u * 2048u * 64u; p.pitch = 64; p.dsh = 0; }
    else if (c < 8704) { p.base = PO_RG + (c - 7680); p.bstride = 2048u * 1024u; p.pitch = 1024; p.dsh = 0; }
    else { p.base = PO_GATE + (c - 8704); p.bstride = 2048u * 2048u; p.pitch = 2048; p.dsh = 0; }
    return p;
}
__host__ __device__ __forceinline__ size_t proj_row(const ProjCol& p, int t) {
    const unsigned b = (unsigned)t >> 11, s = (unsigned)t & 2047u, sp = ((s & ((1u << p.dsh) - 1u)) << (11 - p.dsh)) | (s >> p.dsh);
    return p.base + (size_t)b * p.bstride + (size_t)sp * p.pitch;
}
__host__ __device__ __forceinline__ size_t proj_off(int t, int c) {
    const int b = t >> 11, s = t & 2047;
    if (c < 4608) { const int g = c / 1536, r = c - g * 1536, which = r >> 9, h = (r >> 6) & 7, dc = r & 63, dsh = 2 * g;
        const int perm = ((s & ((1 << dsh) - 1)) << (11 - dsh)) | (s >> dsh);
        return PO_ATT + ((((size_t)(g * 3 + which) * 8 + b) * 8 + h) * 2048 + perm) * 64 + dc; }
    if (c < 6656) { const int r = c - 4608, which = r >> 10, h = (r >> 8) & 3, dk = r & 255; return PO_RQK + ((((size_t)which * 8 + b) * 4 + h) * 2048 + s) * 256 + dk; }
    if (c < 7680) { const int r = c - 6656, h = r >> 8, dvs = (r >> 6) & 3, dv = r & 63; return PO_RV + ((((size_t)b * 4 + h) * 4 + dvs) * 2048 + s) * 64 + dv; }
    if (c < 8704) return PO_RG + (size_t)t * 1024 + (c - 7680);
    return PO_GATE + (size_t)t * 2048 + (c - 8704);
}

constexpr size_t MiB = 1u << 20;
constexpr size_t WS_CTL = 0;
constexpr size_t WS_WIN = 1 * MiB;
constexpr size_t WS_WCAT = WS_WIN + 42 * MiB;
constexpr size_t WS_WO  = WS_WCAT + 6 * MiB;
constexpr size_t WS_WGU = WS_WO + 4 * MiB;
constexpr size_t WS_WDN = WS_WGU + 256 * MiB;
constexpr size_t WS_XB  = WS_WDN + 64 * MiB;
constexpr size_t WS_H   = WS_WDN + 128 * MiB;
constexpr size_t WS_PROJ = WS_H + 32 * MiB;
constexpr size_t WS_XIN = WS_PROJ;
constexpr size_t WS_ACT = WS_PROJ + 64 * MiB;
constexpr size_t WS_Y   = WS_PROJ + 192 * MiB;
constexpr size_t WS_ATTO = WS_PROJ + 336 * MiB;
constexpr size_t WS_LSE = WS_ATTO + 48 * MiB;
constexpr size_t WS_YF  = WS_LSE + 2 * MiB;
constexpr size_t WS_MERGED = WS_YF;
constexpr size_t WS_YB  = WS_YF + 32 * MiB;
constexpr size_t WS_CAT = WS_YB + 32 * MiB;
constexpr size_t WS_AFF = WS_CAT + 48 * MiB;
constexpr size_t WS_IDX = WS_AFF + 1 * MiB;
constexpr size_t WS_GW  = WS_IDX + 256 * 1024;
constexpr size_t WS_SLOT = WS_GW + 256 * 1024;
constexpr size_t WS_SC  = WS_SLOT + 1 * MiB;
constexpr size_t WS_WINS = WS_SC, WS_WGUS = WS_SC + 128 * 1024, WS_HS = WS_SC + 640 * 1024, WS_XS = WS_SC + 704 * 1024;
constexpr size_t WS_END = WS_SC + 1 * MiB;
constexpr size_t WS_WMAX = 64 * 1024;
constexpr int WMAX_IN = 0, WMAX_G = DEPTH * NIN, WMAX_U = WMAX_G + DEPTH * NE * FF, NWMAX = WMAX_U + DEPTH * NE * FF;
static_assert(WS_WMAX + (size_t)NWMAX * 4 <= 1 * MiB, "WMAX inside the CTL MiB");
static_assert(WS_END <= 1024 * MiB, "workspace map");

#define GAS __attribute__((address_space(1)))
#define LAS __attribute__((address_space(3)))
typedef unsigned short bf16;
typedef unsigned v4u __attribute__((ext_vector_type(4)));
typedef float f32x4 __attribute__((ext_vector_type(4)));
typedef short bf16x8 __attribute__((ext_vector_type(8)));
typedef GAS unsigned gu32;
typedef GAS unsigned long long gu64;
#define RLX_AGENT __ATOMIC_RELAXED, __HIP_MEMORY_SCOPE_AGENT
#define LDS_WAIT() asm volatile("s_waitcnt lgkmcnt(0)" ::: "memory")
#define VM_WAIT() asm volatile("s_waitcnt vmcnt(0)" ::: "memory")
__device__ __forceinline__ unsigned long long rt() { return __builtin_amdgcn_s_memrealtime(); }
__device__ __forceinline__ unsigned f2bf(float f) { unsigned u = __builtin_bit_cast(unsigned, f); return (u + 0x7fffu + ((u >> 16) & 1u)) >> 16; }
typedef float f32x2_t __attribute__((ext_vector_type(2))); typedef __bf16 bf16x2_t __attribute__((ext_vector_type(2)));
__device__ __forceinline__ unsigned pk2(float lo, float hi) { const f32x2_t v = {lo, hi}; return __builtin_bit_cast(unsigned, __builtin_convertvector(v, bf16x2_t)); }

__device__ __forceinline__ float fp8_lim() { float l = 448.f; asm volatile("" : "+v"(l)); return l; }
__device__ __forceinline__ unsigned fp8x4(float a, float b, float c, float d, float lim) { int p = 0; p = __builtin_amdgcn_cvt_pk_fp8_f32(__builtin_amdgcn_fmed3f(a, -lim, lim), __builtin_amdgcn_fmed3f(b, -lim, lim), p, false); p = __builtin_amdgcn_cvt_pk_fp8_f32(__builtin_amdgcn_fmed3f(c, -lim, lim), __builtin_amdgcn_fmed3f(d, -lim, lim), p, true); return (unsigned)p; }

#define XB_TMO      128
#define XB_XCNT(j)  (256  + 64 * (j))
#define XB_XSUB(j)  (1280 + 64 * (j))
#define XB_XGEN(j)  (2304 + 64 * (j))
#define XB_TOP      3328
#define XB_TOPGEN   3392
#define XCD_BAR_WORDS 3456
#define XB_SPIN_CAP (1u << 18)

__device__ __forceinline__ unsigned xb_ld(unsigned* p)              { return __hip_atomic_load(p, __ATOMIC_RELAXED, __HIP_MEMORY_SCOPE_AGENT); }
__device__ __forceinline__ unsigned xb_add(unsigned* p, unsigned v) { return __hip_atomic_fetch_add(p, v, __ATOMIC_RELAXED, __HIP_MEMORY_SCOPE_AGENT); }
__device__ __forceinline__ unsigned xb_xcc_id() { return (unsigned)__builtin_amdgcn_s_getreg((3 << 11) | 20) & 0xFu; }
#define XB_SPIN(cond, bar) do { unsigned _sp = 0; while (cond) { __builtin_amdgcn_s_sleep(1); \
    if ((++_sp & 255u) == 0u) { if (xb_ld(&(bar)[XB_TMO])) break; if (_sp > XB_SPIN_CAP) { atomicAdd(&(bar)[XB_TMO], 1u); break; } } } } while (0)

struct XcdBarrier {
    unsigned* bar; unsigned x;
    volatile LAS unsigned* st;
};

__device__ __forceinline__ XcdBarrier xcd_barrier_post(unsigned* bar, volatile LAS unsigned* st) {
    XcdBarrier b; b.bar = bar; b.x = xb_xcc_id(); b.st = st;
    if (threadIdx.x == 0) (void)xb_add(&bar[XB_XCNT(b.x)], 1u);
    return b;
}
__device__ __forceinline__ void xcd_barrier_complete(unsigned* bar, unsigned x, unsigned& nloc, unsigned& nx) {
    const unsigned G = gridDim.x * gridDim.y * gridDim.z;
    unsigned sum, cnt, mine, sp = 0u;
    for (;;) {
        sum = 0u; cnt = 0u; mine = 0u;
#pragma unroll
        for (unsigned j = 0; j < 16; ++j) { const unsigned c = xb_ld(&bar[XB_XCNT(j)]); sum += c; cnt += (c > 0u) ? 1u : 0u; mine = (j == x) ? c : mine; }
        if (sum == G) break;
        __builtin_amdgcn_s_sleep(1);
        if ((++sp & 255u) == 0u) { if (xb_ld(&bar[XB_TMO])) break; if (sp > XB_SPIN_CAP) { atomicAdd(&bar[XB_TMO], 1u); break; } }
    }
    nloc = mine > 0u ? mine : 1u; nx = cnt > 0u ? cnt : 1u;
}

__device__ __forceinline__ void xcd_barrier(const XcdBarrier& b) {
    asm volatile("s_waitcnt vmcnt(0)" ::: "memory");
    __syncthreads();
    if (threadIdx.x == 0) {
        unsigned* bar = b.bar;
        __builtin_amdgcn_s_waitcnt(0);
        unsigned nloc = b.st[0], nx = b.st[1];
        if (nloc == 0u) { xcd_barrier_complete(bar, b.x, nloc, nx); b.st[0] = nloc; b.st[1] = nx; }
        const unsigned old = xb_add(&bar[XB_XSUB(b.x)], 1u);
        const unsigned gen = old / nloc;
        if (old + 1u == (gen + 1u) * nloc) {
            __builtin_amdgcn_fence(__ATOMIC_RELEASE, "agent");
            asm volatile("s_waitcnt vmcnt(0)" ::: "memory");
            const unsigned og = xb_add(&bar[XB_TOP], 1u);
            const unsigned tg = og / nx;
            if (og + 1u == (tg + 1u) * nx) xb_add(&bar[XB_TOPGEN], 1u);
            else XB_SPIN(xb_ld(&bar[XB_TOPGEN]) == tg, bar);
            __builtin_amdgcn_fence(__ATOMIC_ACQUIRE, "agent");
            xb_add(&bar[XB_XGEN(b.x)], 1u);
            asm volatile("s_waitcnt vmcnt(0)" ::: "memory");
        } else {
            XB_SPIN(xb_ld(&bar[XB_XGEN(b.x)]) == gen, bar);
            __builtin_amdgcn_fence(__ATOMIC_ACQUIRE, "agent");
            asm volatile("s_waitcnt vmcnt(0)" ::: "memory");
        }
    }
    __syncthreads();
}


#define CW_LBAR 8192
#define CW_TQ 13312
#define CW_AQ 12288
__device__ __forceinline__ void xcc_local_barrier(unsigned* ctl, const unsigned x, const unsigned nloc, unsigned* tmo_bar) {
    asm volatile("s_waitcnt vmcnt(0)" ::: "memory");
    __syncthreads();
    if (threadIdx.x == 0) {
        unsigned* w = ctl + CW_LBAR + 64 * x;
        const unsigned old = xb_add(w, 1u); const unsigned target = (old / nloc + 1u) * nloc;
        XB_SPIN(xb_ld(w) < target, tmo_bar);
        __builtin_amdgcn_fence(__ATOMIC_ACQUIRE, "agent");
        asm volatile("s_waitcnt vmcnt(0)" ::: "memory");
    }
    __syncthreads();
}

typedef unsigned u32x2 __attribute__((ext_vector_type(2)));
typedef unsigned u32x4 __attribute__((ext_vector_type(4)));
__device__ __forceinline__ float bf2f(unsigned short h) { return __builtin_bit_cast(float, (unsigned)h << 16); }
__device__ __forceinline__ float sigmoidf_(float v) { return 1.f / (1.f + __expf(-v)); }
__device__ __forceinline__ float siluf_(float v) { return v / (1.f + __expf(-v)); }
namespace pg8 {
#define PG8_LAS __attribute__((address_space(3)))
typedef unsigned short bf16_t;
typedef short bf16x8 __attribute__((ext_vector_type(8)));
typedef float f32x4 __attribute__((ext_vector_type(4)));
typedef unsigned u32x4 __attribute__((ext_vector_type(4)));
constexpr int BM = 256, BK = 64, HALF = 128, HTB = HALF * BK * 2  , STAGE_BYTES = 8 * HTB, NXCD = 8, WGM = 8;

__host__ __device__ __forceinline__ int lds_byte(int r, int c) { const int st = r >> 3, rr = r & 7, ch = c >> 3; return st * 1024 + rr * 128 + ((ch ^ rr) << 4) + (c & 7) * 2; }
__host__ __device__ __forceinline__ void stage_rc(int b, int& R, int& C) { const int st = b / 1024, sb = b % 1024, rr = sb >> 7, slot = (sb >> 4) & 7; R = st * 8 + rr; C = ((slot ^ rr) << 3) + ((sb & 15) >> 1); }
__host__ __device__ __forceinline__ int perm32(int rho) { const int n = rho >> 4, i = rho & 15; return 8 * (i >> 2) + 4 * n + (i & 3); }

struct Unit { int pm, pn; };
struct Gemm { const bf16_t* A; const bf16_t* Bt; int M, N, K; int gshift; size_t gstrideB; };

struct StaticOrder {
    int nM, nN, nwg, G, c;
    int sync_ui; unsigned* sctl; unsigned sx, snloc; unsigned* stmo;
    __host__ __device__ void init(int M, int N, int G_, int c_) { nM = M / BM; nN = N / BM; nwg = nM * nN; G = G_; c = c_; sync_ui = -1; sctl = nullptr; sx = 0; snloc = 1; stmo = nullptr; }
    __device__ __forceinline__ void after_unit(int ui) const { if (ui == sync_ui) xcc_local_barrier(sctl, sx, snloc, stmo); }
    __host__ __device__ bool next(int i, Unit& u) const {
        const long L = (long)i * G + c; if (L >= nwg) return false;
        int wgid = (int)L; { const int q = nwg / NXCD, r = nwg % NXCD, xcd = wgid % NXCD, off = wgid / NXCD; wgid = (xcd < r ? xcd * (q + 1) : r * (q + 1) + (xcd - r) * q) + off; }
        const int nig = WGM * nN, gid = wgid / nig, fm = gid * WGM, gsz = (nM - fm) < WGM ? (nM - fm) : WGM;
        u.pm = fm + ((wgid % nig) % gsz); u.pn = (wgid % nig) / gsz; return true;
    }
    __device__ __forceinline__ void a_ready(const Unit&) const {}
    __device__ __forceinline__ void done(const Unit&) const {}
};

__device__ __forceinline__ unsigned cvt_pk_bf16(float lo, float hi) { unsigned r; asm volatile("v_cvt_pk_bf16_f32 %0, %1, %2" : "=v"(r) : "v"(lo), "v"(hi)); return r; }
typedef float f32x2 __attribute__((ext_vector_type(2)));
typedef unsigned u32x2 __attribute__((ext_vector_type(2)));
constexpr int P_NIN = 10752, P_OFF_GA = 8704, P_OFF_GR = 9728, P_FF = 2048;
__device__ __forceinline__ float bflo(unsigned w) { return __builtin_bit_cast(float, w << 16); }
__device__ __forceinline__ float bfhi(unsigned w) { return __builtin_bit_cast(float, w & 0xffff0000u); }
__device__ __forceinline__ float fsig(float v) { return __builtin_amdgcn_rcpf(1.f + __expf(-v)); }
struct EpiStore {
    static constexpr bool PERM = true, AFTER_DRAIN = false; static constexpr int MID_T = 0;
    bf16_t* O; int ldc;
    __device__ __forceinline__ void operator()(const f32x4 (&acc)[2][2][4][2], const Unit& u, int wr, int wc, int fr, int fq) const {
        int row0 = u.pm * BM + wr * 64 + fr, col0 = u.pn * BM + wc * 64 + 8 * fq; asm volatile("" : "+v"(row0));
#pragma unroll
        for (int ai = 0; ai < 2; ++ai)
#pragma unroll
            for (int m = 0; m < 4; ++m) { bf16_t* rowp = O + (size_t)(row0 + ai * HALF + m * 16) * ldc + col0;
#pragma unroll
                for (int bj = 0; bj < 2; ++bj) { const f32x4 v0 = acc[ai][bj][m][0], v1 = acc[ai][bj][m][1];
                    u32x4 w; w.x = cvt_pk_bf16(v0[0], v0[1]); w.y = cvt_pk_bf16(v0[2], v0[3]); w.z = cvt_pk_bf16(v1[0], v1[1]); w.w = cvt_pk_bf16(v1[2], v1[3]);
                    *(u32x4*)(rowp + bj * 32) = w; } }
    }
};
struct EpiMerge {
    static constexpr bool PERM = true, AFTER_DRAIN = false; static constexpr int MID_T = 4;
    const bf16_t* proj; bf16_t* O; float post;
    __device__ __forceinline__ void mid(f32x4 (&acc)[2][2][4][2], const Unit& u, int wr, int wc, int fr, int fq) const {
        int row0 = u.pm * BM + wr * 64 + fr, col0 = u.pn * BM + wc * 64 + 8 * fq; asm volatile("" : "+v"(row0));
#pragma unroll
        for (int ai = 0; ai < 2; ++ai) { u32x4 ga[4][2], gr[4][2];
#pragma unroll
            for (int m = 0; m < 4; ++m) { const bf16_t* pr = proj + PO_GATE + (size_t)(row0 + ai * HALF + m * 16) * 2048 + col0;
#pragma unroll
                for (int bj = 0; bj < 2; ++bj) { ga[m][bj] = *(const u32x4*)(pr + bj * 32); gr[m][bj] = *(const u32x4*)(pr + 1024 + bj * 32); } }
#pragma unroll
            for (int m = 0; m < 4; ++m)
#pragma unroll
                for (int bj = 0; bj < 2; ++bj) { const u32x4 a = ga[m][bj], r = gr[m][bj]; f32x4 r0, r1;
                    r0[0] = (1.f + __expf(-bflo(r.x))) * __builtin_amdgcn_rcpf(1.f + __expf(-bflo(a.x))); r0[1] = (1.f + __expf(-bfhi(r.x))) * __builtin_amdgcn_rcpf(1.f + __expf(-bfhi(a.x)));
                    r0[2] = (1.f + __expf(-bflo(r.y))) * __builtin_amdgcn_rcpf(1.f + __expf(-bflo(a.y))); r0[3] = (1.f + __expf(-bfhi(r.y))) * __builtin_amdgcn_rcpf(1.f + __expf(-bfhi(a.y)));
                    r1[0] = (1.f + __expf(-bflo(r.z))) * __builtin_amdgcn_rcpf(1.f + __expf(-bflo(a.z))); r1[1] = (1.f + __expf(-bfhi(r.z))) * __builtin_amdgcn_rcpf(1.f + __expf(-bfhi(a.z)));
                    r1[2] = (1.f + __expf(-bflo(r.w))) * __builtin_amdgcn_rcpf(1.f + __expf(-bflo(a.w))); r1[3] = (1.f + __expf(-bfhi(r.w))) * __builtin_amdgcn_rcpf(1.f + __expf(-bfhi(a.w)));
                    acc[ai][bj][m][0] *= r0; acc[ai][bj][m][1] *= r1; } }
    }
    __device__ __forceinline__ void operator()(const f32x4 (&acc)[2][2][4][2], const Unit& u, int wr, int wc, int fr, int fq) const {
        int row0 = u.pm * BM + wr * 64 + fr, col0 = u.pn * BM + wc * 64 + 8 * fq; asm volatile("" : "+v"(row0));
#pragma unroll
        for (int ai = 0; ai < 2; ++ai) { u32x4 gr[4][2];
#pragma unroll
            for (int m = 0; m < 4; ++m)
#pragma unroll
                for (int bj = 0; bj < 2; ++bj) gr[m][bj] = *(const u32x4*)(proj + PO_GATE + (size_t)(row0 + ai * HALF + m * 16) * 2048 + 1024 + col0 + bj * 32);
#pragma unroll
            for (int m = 0; m < 4; ++m) { bf16_t* rowp = O + (size_t)(row0 + ai * HALF + m * 16) * 1024 + col0;
#pragma unroll
                for (int bj = 0; bj < 2; ++bj) { const u32x4 g = gr[m][bj]; const f32x4 v0 = acc[ai][bj][m][0] * post, v1 = acc[ai][bj][m][1] * post;
                    u32x4 w; w.x = cvt_pk_bf16(v0[0] * fsig(bflo(g.x)), v0[1] * fsig(bfhi(g.x))); w.y = cvt_pk_bf16(v0[2] * fsig(bflo(g.y)), v0[3] * fsig(bfhi(g.y)));
                    w.z = cvt_pk_bf16(v1[0] * fsig(bflo(g.z)), v1[1] * fsig(bfhi(g.z))); w.w = cvt_pk_bf16(v1[2] * fsig(bflo(g.w)), v1[3] * fsig(bfhi(g.w)));
                    *(u32x4*)(rowp + bj * 32) = w; } } }
    }
};
__device__ __forceinline__ float i2f(float bits) { return (float)__builtin_bit_cast(int, bits); }
struct EpiStoreI8 {
    static constexpr bool PERM = true, AFTER_DRAIN = false; static constexpr int MID_T = 0;
    bf16_t* O; int ldc; const float* rs; const float* cs;
    __device__ __forceinline__ void operator()(const f32x4 (&acc)[2][2][4][2], const Unit& u, int wr, int wc, int fr, int fq) const {
        int row0 = u.pm * BM + wr * 64 + fr, col0 = u.pn * BM + wc * 64 + 8 * fq; asm volatile("" : "+v"(row0), "+v"(col0));
        const bool odd = fr & 1; const int rowe = row0 & ~1;
        f32x4 c[2][2];
#pragma unroll
        for (int bj = 0; bj < 2; ++bj) { c[bj][0] = *(const f32x4*)(cs + col0 + bj * 32); c[bj][1] = *(const f32x4*)(cs + col0 + bj * 32 + 4); }
        const ProjCol pc = proj_col(col0 + (odd ? 32 : 0));
        bf16_t* const base0 = O + proj_row(pc, rowe); bf16_t* const base1 = O + proj_row(pc, rowe + 1); const unsigned step = (16u * pc.pitch) >> pc.dsh;
        float srv[8];
#pragma unroll
        for (int i = 0; i < 8; ++i) srv[i] = rs[row0 + (i >> 2) * HALF + (i & 3) * 16];
#pragma unroll
        for (int ai = 0; ai < 2; ++ai)
#pragma unroll
            for (int m = 0; m < 4; ++m) { const float sr = srv[ai * 4 + m]; u32x4 w[2];
#pragma unroll
                for (int bj = 0; bj < 2; ++bj) { const f32x4 a0 = acc[ai][bj][m][0], a1 = acc[ai][bj][m][1];
                    const f32x4 v0 = (f32x4){i2f(a0[0]), i2f(a0[1]), i2f(a0[2]), i2f(a0[3])} * (c[bj][0] * sr), v1 = (f32x4){i2f(a1[0]), i2f(a1[1]), i2f(a1[2]), i2f(a1[3])} * (c[bj][1] * sr);
                    w[bj].x = cvt_pk_bf16(v0[0], v0[1]); w[bj].y = cvt_pk_bf16(v0[2], v0[3]); w[bj].z = cvt_pk_bf16(v1[0], v1[1]); w[bj].w = cvt_pk_bf16(v1[2], v1[3]); }
                u32x4 snd, rcv;
                snd.x = odd ? w[0].x : w[1].x; snd.y = odd ? w[0].y : w[1].y; snd.z = odd ? w[0].z : w[1].z; snd.w = odd ? w[0].w : w[1].w;
                rcv.x = (unsigned)__builtin_amdgcn_mov_dpp((int)snd.x, 0xB1, 0xF, 0xF, true); rcv.y = (unsigned)__builtin_amdgcn_mov_dpp((int)snd.y, 0xB1, 0xF, 0xF, true);
                rcv.z = (unsigned)__builtin_amdgcn_mov_dpp((int)snd.z, 0xB1, 0xF, 0xF, true); rcv.w = (unsigned)__builtin_amdgcn_mov_dpp((int)snd.w, 0xB1, 0xF, 0xF, true);
                u32x4 s0, s1;
                s0.x = odd ? rcv.x : w[0].x; s0.y = odd ? rcv.y : w[0].y; s0.z = odd ? rcv.z : w[0].z; s0.w = odd ? rcv.w : w[0].w;
                s1.x = odd ? w[1].x : rcv.x; s1.y = odd ? w[1].y : rcv.y; s1.z = odd ? w[1].z : rcv.z; s1.w = odd ? w[1].w : rcv.w;
                const size_t o = (size_t)((ai * 8 + m) * step);
                *(u32x4*)(base0 + o) = s0; *(u32x4*)(base1 + o) = s1; }
    }
};
struct EpiSwigluI8 {
    static constexpr bool PERM = false, AFTER_DRAIN = false; static constexpr int MID_T = 0;
    bf16_t* O; const float* rs; const float* cs; int fp8;
    __device__ __forceinline__ void operator()(const f32x4 (&acc)[2][2][4][2], const Unit& u, int wr, int wc, int fr, int fq) const {
        int row0 = u.pm * BM + wr * 64 + fr, f0 = u.pn * (BM / 2) + wc * 32 + 8 * fq; asm volatile("" : "+v"(row0));
        int cofs = u.pn * BM + wc * 32 + 4 * fq; asm volatile("" : "+v"(cofs));
        const float* csp = cs + (size_t)(u.pm >> 3) * (2 * P_FF) + cofs;
        f32x4 cg[2], cu[2];
#pragma unroll
        for (int bj = 0; bj < 2; ++bj) { cg[bj] = *(const f32x4*)(csp + bj * HALF); cu[bj] = *(const f32x4*)(csp + bj * HALF + 16); }
        float srv[8];
#pragma unroll
        for (int i = 0; i < 8; ++i) srv[i] = rs[row0 + (i >> 2) * HALF + (i & 3) * 16];
#pragma unroll
        for (int ai = 0; ai < 2; ++ai)
#pragma unroll
            for (int m = 0; m < 4; ++m) { const size_t r = (size_t)(row0 + ai * HALF + m * 16); const float sr = srv[ai * 4 + m];
                float ov[8];
#pragma unroll
                for (int bj = 0; bj < 2; ++bj) { const f32x4 ga = acc[ai][bj][m][0], ua = acc[ai][bj][m][1];
#pragma unroll
                    for (int i = 0; i < 4; ++i) { const float a = i2f(ga[i]) * (cg[bj][i] * sr), b = i2f(ua[i]) * (cu[bj][i] * sr); ov[4 * bj + i] = a * fsig(a) * b; } }
                if (fp8) { const float lim = fp8_lim(); u32x2 w; w.x = fp8x4(ov[0] * 16.f, ov[1] * 16.f, ov[2] * 16.f, ov[3] * 16.f, lim); w.y = fp8x4(ov[4] * 16.f, ov[5] * 16.f, ov[6] * 16.f, ov[7] * 16.f, lim);
                    *(u32x2*)((unsigned char*)O + r * P_FF + f0) = w; }
                else { u32x4 w; w.x = cvt_pk_bf16(ov[0], ov[1]); w.y = cvt_pk_bf16(ov[2], ov[3]); w.z = cvt_pk_bf16(ov[4], ov[5]); w.w = cvt_pk_bf16(ov[6], ov[7]);
                    *(u32x4*)(O + r * P_FF + f0) = w; } }
    }
};

template <bool SRCF32> struct EpiResidB {
    static constexpr bool PERM = true, AFTER_DRAIN = false; static constexpr int MID_T = 0;
    const void* src; bf16_t* out; float post;
    __device__ __forceinline__ void operator()(const f32x4 (&acc)[2][2][4][2], const Unit& u, int wr, int wc, int fr, int fq) const {
        int row0 = u.pm * BM + wr * 64 + fr, col0 = u.pn * BM + wc * 64 + 8 * fq; asm volatile("" : "+v"(row0));
#pragma unroll
        for (int ai = 0; ai < 2; ++ai)
#pragma unroll
            for (int mh = 0; mh < 2; ++mh) {
                u32x4 rb[2][2]; f32x4 rf[2][2][2];
#pragma unroll
                for (int mm = 0; mm < 2; ++mm)
#pragma unroll
                    for (int bj = 0; bj < 2; ++bj) { const size_t o = (size_t)(row0 + ai * HALF + (2 * mh + mm) * 16) * 1024 + col0 + bj * 32;
                        if constexpr (SRCF32) { rf[mm][bj][0] = *(const f32x4*)((const float*)src + o); rf[mm][bj][1] = *(const f32x4*)((const float*)src + o + 4); }
                        else rb[mm][bj] = *(const u32x4*)((const bf16_t*)src + o); }
#pragma unroll
                for (int mm = 0; mm < 2; ++mm)
#pragma unroll
                    for (int bj = 0; bj < 2; ++bj) { const int m = 2 * mh + mm; const size_t o = (size_t)(row0 + ai * HALF + m * 16) * 1024 + col0 + bj * 32;
                        f32x4 s0, s1;
                        if constexpr (SRCF32) { s0 = rf[mm][bj][0]; s1 = rf[mm][bj][1]; }
                        else { const u32x4 r = rb[mm][bj]; s0 = (f32x4){bflo(r.x), bfhi(r.x), bflo(r.y), bfhi(r.y)}; s1 = (f32x4){bflo(r.z), bfhi(r.z), bflo(r.w), bfhi(r.w)}; }
                        const f32x4 v0 = s0 + acc[ai][bj][m][0] * post, v1 = s1 + acc[ai][bj][m][1] * post;
                        u32x4 w; w.x = cvt_pk_bf16(v0[0], v0[1]); w.y = cvt_pk_bf16(v0[2], v0[3]); w.z = cvt_pk_bf16(v1[0], v1[1]); w.w = cvt_pk_bf16(v1[2], v1[3]);
                        *(u32x4*)(out + o) = w; } }
    }
};
struct EpiResid {
    static constexpr bool PERM = false, AFTER_DRAIN = false; static constexpr int MID_T = 0;
    const float* src; float* out;
    __device__ __forceinline__ void operator()(const f32x4 (&acc)[2][2][4][2], const Unit& u, int wr, int wc, int fr, int fq) const {
        int row0 = u.pm * BM + wr * 64 + fr, col0 = u.pn * BM + wc * 32 + 4 * fq; asm volatile("" : "+v"(row0));
#pragma unroll
        for (int ai = 0; ai < 2; ++ai) { f32x4 sv[4][2][2];
#pragma unroll
            for (int m = 0; m < 4; ++m)
#pragma unroll
                for (int bj = 0; bj < 2; ++bj)
#pragma unroll
                    for (int n = 0; n < 2; ++n) sv[m][bj][n] = *(const f32x4*)(src + (size_t)(row0 + ai * HALF + m * 16) * 1024 + col0 + bj * HALF + n * 16);
#pragma unroll
            for (int m = 0; m < 4; ++m)
#pragma unroll
                for (int bj = 0; bj < 2; ++bj)
#pragma unroll
                    for (int n = 0; n < 2; ++n) *(f32x4*)(out + (size_t)(row0 + ai * HALF + m * 16) * 1024 + col0 + bj * HALF + n * 16) = sv[m][bj][n] + acc[ai][bj][m][n]; }
    }
};
struct EpiSwiglu {
    static constexpr bool PERM = false, AFTER_DRAIN = false; static constexpr int MID_T = 0;
    bf16_t* O;
    __device__ __forceinline__ void operator()(const f32x4 (&acc)[2][2][4][2], const Unit& u, int wr, int wc, int fr, int fq) const {
        int row0 = u.pm * BM + wr * 64 + fr, f0 = (u.pn * BM + wc * 32) / 2 + 4 * fq; asm volatile("" : "+v"(row0));
#pragma unroll
        for (int ai = 0; ai < 2; ++ai)
#pragma unroll
            for (int m = 0; m < 4; ++m) { bf16_t* rowp = O + (size_t)(row0 + ai * HALF + m * 16) * P_FF + f0;
#pragma unroll
                for (int bj = 0; bj < 2; ++bj) { const f32x4 a = acc[ai][bj][m][0], b = acc[ai][bj][m][1];
                    u32x2 w; w.x = cvt_pk_bf16(a[0] * fsig(a[0]) * b[0], a[1] * fsig(a[1]) * b[1]); w.y = cvt_pk_bf16(a[2] * fsig(a[2]) * b[2], a[3] * fsig(a[3]) * b[3]);
                    *(u32x2*)(rowp + bj * (HALF / 2)) = w; } }
    }
};
struct EpiDown {
    static constexpr bool PERM = true, AFTER_DRAIN = false; static constexpr int MID_T = 0;
    const float* gw; bf16_t* O; float post;
    __device__ __forceinline__ void operator()(const f32x4 (&acc)[2][2][4][2], const Unit& u, int wr, int wc, int fr, int fq) const {
        int row0 = u.pm * BM + wr * 64 + fr, col0 = u.pn * BM + wc * 64 + 8 * fq; asm volatile("" : "+v"(row0));
        float srv[8];
#pragma unroll
        for (int i = 0; i < 8; ++i) srv[i] = gw[row0 + (i >> 2) * HALF + (i & 3) * 16] * post;
#pragma unroll
        for (int ai = 0; ai < 2; ++ai)
#pragma unroll
            for (int m = 0; m < 4; ++m) { const size_t r = (size_t)(row0 + ai * HALF + m * 16); const float s = srv[ai * 4 + m]; bf16_t* rowp = O + r * 1024 + col0;
#pragma unroll
                for (int bj = 0; bj < 2; ++bj) { const f32x4 v0 = acc[ai][bj][m][0] * s, v1 = acc[ai][bj][m][1] * s;
                    u32x4 w; w.x = cvt_pk_bf16(v0[0], v0[1]); w.y = cvt_pk_bf16(v0[2], v0[3]); w.z = cvt_pk_bf16(v1[0], v1[1]); w.w = cvt_pk_bf16(v1[2], v1[3]);
                    *(u32x4*)(rowp + bj * 32) = w; } }
    }
};
typedef int i32x4 __attribute__((ext_vector_type(4)));
typedef long i64x2 __attribute__((ext_vector_type(2)));
template <int MT> __device__ __forceinline__ f32x4 mma16(const bf16x8 a, const bf16x8 b, const f32x4 c) {
    if constexpr (MT == 1) return __builtin_bit_cast(f32x4, __builtin_amdgcn_mfma_i32_16x16x64_i8(__builtin_bit_cast(i32x4, a), __builtin_bit_cast(i32x4, b), __builtin_bit_cast(i32x4, c), 0, 0, 0));
    else if constexpr (MT == 2) { const i64x2 a2 = __builtin_bit_cast(i64x2, a), b2 = __builtin_bit_cast(i64x2, b);
        return __builtin_amdgcn_mfma_f32_16x16x32_fp8_fp8(a2[1], b2[1], __builtin_amdgcn_mfma_f32_16x16x32_fp8_fp8(a2[0], b2[0], c, 0, 0, 0), 0, 0, 0); }
    else return __builtin_amdgcn_mfma_f32_16x16x32_bf16(a, b, c, 0, 0, 0);
}
typedef int i32x8 __attribute__((ext_vector_type(8))); typedef short bf16x16 __attribute__((ext_vector_type(16)));
__device__ __forceinline__ i32x8 cat8(const bf16x8 lo, const bf16x8 hi) { const i32x4 l = __builtin_bit_cast(i32x4, lo), h = __builtin_bit_cast(i32x4, hi); return __builtin_shufflevector(l, h, 0, 1, 2, 3, 4, 5, 6, 7); }
__device__ __forceinline__ void mma_f8x128(f32x4& c, const i32x8 a, const i32x8 b, const int one) {
    asm volatile("s_nop 1\n\tv_mfma_scale_f32_16x16x128_f8f6f4 %0, %1, %2, %0, %3, %3 op_sel_hi:[0,0,0]" : "+v"(c) : "v"(a), "v"(b), "v"(one));
}
template <class Epi, class Sched, bool ALIGN_EPI = false, bool SP2 = false, int MT = 0>
__device__ __forceinline__ void gemm_phase(PG8_LAS unsigned char* lds, const Gemm g, const Sched& S, const Epi& E, const int tid) {
    const int wid = __builtin_amdgcn_readfirstlane(tid >> 6), lane = tid & 63, wr = wid >> 2, wc = wid & 3, fr = lane & 15, fq = lane >> 4;
    const int K = g.K, nt = K / BK;
    unsigned voffA[2], voffB[2];
#pragma unroll
    for (int i = 0; i < 2; ++i) { int R, C; stage_rc(tid * 16 + i * 8192, R, C); const int Rb = Epi::PERM ? ((R & ~31) * 2 + perm32(R & 31)) : R;
        voffA[i] = (unsigned)(R * K + C) * 2u; voffB[i] = (unsigned)(Rb * K + C) * 2u; }
    const size_t kstep = (size_t)(BK * 2);
    const size_t hstep = (size_t)HALF * K * 2;
    const size_t tstep = 2 * hstep;
    const size_t hstepB = Epi::PERM ? (size_t)32 * K * 2 : hstep;
    const unsigned ldsw = (unsigned)wid * 1024u;
    const int aoff = lds_byte(wr * 64 + fr, fq * 8), boff = lds_byte(wc * 32 + fr, fq * 8);
#define PG8_SA(b, h) (((b) * 2 + (h)) * HTB)
#define PG8_SB(b, h) ((4 + (b) * 2 + (h)) * HTB)
#define PG8_STAGE(bufoff, gbase, voff) do { _Pragma("unroll") for (int _i = 0; _i < 2; ++_i) \
        __builtin_amdgcn_global_load_lds((const unsigned*)((const char*)(gbase) + (voff)[_i]), (PG8_LAS unsigned*)(lds + (bufoff) + ldsw + _i * 8192), 16, 0, 0); } while (0)
#define PG8_LDA(dst, b, h) do { _Pragma("unroll") for (int m = 0; m < 4; ++m) _Pragma("unroll") for (int k = 0; k < 2; ++k) dst[m][k] = *(const PG8_LAS bf16x8*)(lds + PG8_SA(b, h) + (aoff ^ (k * 64)) + m * 2048); } while (0)
#define PG8_LDB(dst, b, h) do { _Pragma("unroll") for (int n = 0; n < 2; ++n) _Pragma("unroll") for (int k = 0; k < 2; ++k) dst[n][k] = *(const PG8_LAS bf16x8*)(lds + PG8_SB(b, h) + (boff ^ (k * 64)) + n * 2048); } while (0)
#define PG8_MMA(ai, bj, At, Bt) do { __builtin_amdgcn_s_setprio(1); _Pragma("unroll") for (int m = 0; m < 4; ++m) _Pragma("unroll") for (int n = 0; n < 2; ++n) { \
        if constexpr (MT == 2) mma_f8x128(acc[ai][bj][m][n], cat8(Bt[n][0], Bt[n][1]), cat8(At[m][0], At[m][1]), mxone); \
        else { _Pragma("unroll") for (int k = 0; k < 2; ++k) acc[ai][bj][m][n] = mma16<MT>(Bt[n][k], At[m][k], acc[ai][bj][m][n]); } } __builtin_amdgcn_s_setprio(0); } while (0)
#define PG8_WAIT_V(n) asm volatile("s_waitcnt vmcnt(" #n ")" ::: "memory")
#define PG8_WAIT_L(n) asm volatile("s_waitcnt lgkmcnt(" #n ")" ::: "memory")
#define PG8_BAR __builtin_amdgcn_s_barrier()
#define PG8_SCHED __builtin_amdgcn_sched_barrier(0)
    Unit cur, nxt; int ui = 0;
    if (!S.next(0, cur)) return;
    f32x4 acc[2][2][4][2];
#pragma unroll
    for (int a = 0; a < 2; ++a)
#pragma unroll
        for (int b = 0; b < 2; ++b)
#pragma unroll
            for (int m = 0; m < 4; ++m)
#pragma unroll
                for (int n = 0; n < 2; ++n) acc[a][b][m][n] = (f32x4){0.f, 0.f, 0.f, 0.f};
    bf16x8 At[4][2], B0[2][2], B1[2][2]; const int mxone = 0x7f7f7f7f;
    const char* cA = (const char*)g.A + (size_t)cur.pm * tstep; const char* cB = (const char*)g.Bt + (size_t)(cur.pm >> g.gshift) * g.gstrideB + (size_t)cur.pn * tstep;
    S.a_ready(cur);
    if constexpr (SP2) {
        PG8_STAGE(PG8_SB(0, 0), cB, voffB); PG8_STAGE(PG8_SB(0, 1), cB + hstepB, voffB); PG8_STAGE(PG8_SA(0, 0), cA, voffA); PG8_STAGE(PG8_SA(0, 1), cA + hstep, voffA);
        if (wr == 1) PG8_BAR;
        PG8_WAIT_V(2); PG8_BAR;
        PG8_STAGE(PG8_SB(1, 0), cB + kstep, voffB); PG8_STAGE(PG8_SA(1, 0), cA + kstep, voffA); PG8_STAGE(PG8_SB(1, 1), cB + hstepB + kstep, voffB);
        PG8_WAIT_V(6); PG8_BAR;
    } else {
        PG8_STAGE(PG8_SB(0, 0), cB, voffB); PG8_STAGE(PG8_SA(0, 0), cA, voffA); PG8_STAGE(PG8_SB(0, 1), cB + hstepB, voffB); PG8_STAGE(PG8_SA(0, 1), cA + hstep, voffA);
        if (wr == 1) PG8_BAR;
        PG8_WAIT_V(4); PG8_BAR;
        PG8_STAGE(PG8_SB(1, 0), cB + kstep, voffB); PG8_STAGE(PG8_SA(1, 0), cA + kstep, voffA); PG8_STAGE(PG8_SB(1, 1), cB + hstepB + kstep, voffB);
        PG8_WAIT_V(6); PG8_BAR;
    }
    for (;;) {
        const bool has_next = S.next(ui + 1, nxt);
        const char* nA = has_next ? (const char*)g.A + (size_t)nxt.pm * tstep : cA; const char* nB = has_next ? (const char*)g.Bt + (size_t)(nxt.pm >> g.gshift) * g.gstrideB + (size_t)nxt.pn * tstep : cB;
        for (int t = 0; t < nt; t += 2) {
            const bool last = (t == nt - 2);
            if constexpr (Epi::MID_T > 0) { if (t == Epi::MID_T) { if constexpr (MT == 2) asm volatile("s_nop 15\n\ts_nop 7" ::: "memory"); E.mid(acc, cur, wr, wc, fr, fq); } }
            const char* a1 = cA + (size_t)(t + 1) * kstep;
            const char* a2 = last ? nA : cA + (size_t)(t + 2) * kstep; const char* b2 = last ? nB : cB + (size_t)(t + 2) * kstep;
            const char* a3 = a2 + kstep; const char* b3 = b2 + kstep;
            if (last && has_next) S.a_ready(nxt);
            if constexpr (SP2) {
            PG8_LDB(B0, 0, 0); PG8_LDB(B1, 0, 1); PG8_SCHED; PG8_LDA(At, 0, 0); PG8_STAGE(PG8_SA(1, 1), a1 + hstep, voffA);
            PG8_WAIT_V(8); PG8_WAIT_L(0); PG8_BAR; PG8_MMA(0, 0, At, B0); PG8_MMA(0, 1, At, B1); PG8_BAR; PG8_SCHED;
            PG8_LDA(At, 0, 1); PG8_STAGE(PG8_SB(0, 0), b2, voffB); PG8_STAGE(PG8_SB(0, 1), b2 + hstepB, voffB); PG8_STAGE(PG8_SA(0, 0), a2, voffA);
            PG8_WAIT_V(8); PG8_WAIT_L(0); PG8_BAR; PG8_MMA(1, 0, At, B0); PG8_MMA(1, 1, At, B1); PG8_BAR; PG8_SCHED;
            PG8_LDB(B0, 1, 0); PG8_LDB(B1, 1, 1); PG8_SCHED; PG8_LDA(At, 1, 0); PG8_STAGE(PG8_SA(0, 1), a2 + hstep, voffA);
            PG8_WAIT_V(8); PG8_WAIT_L(0); PG8_BAR; PG8_MMA(0, 0, At, B0); PG8_MMA(0, 1, At, B1); PG8_BAR; PG8_SCHED;
            PG8_LDA(At, 1, 1); PG8_STAGE(PG8_SB(1, 0), b3, voffB); PG8_STAGE(PG8_SB(1, 1), b3 + hstepB, voffB); PG8_STAGE(PG8_SA(1, 0), a3, voffA);
            PG8_WAIT_V(8); PG8_WAIT_L(0); PG8_BAR; PG8_MMA(1, 0, At, B0); PG8_MMA(1, 1, At, B1); PG8_BAR; PG8_SCHED;
            } else {
            PG8_LDB(B0, 0, 0); PG8_SCHED; PG8_LDA(At, 0, 0); PG8_STAGE(PG8_SA(1, 1), a1 + hstep, voffA);
            PG8_WAIT_L(8); PG8_BAR; PG8_WAIT_L(0); PG8_MMA(0, 0, At, B0); PG8_BAR; PG8_SCHED;
            PG8_LDB(B1, 0, 1); PG8_STAGE(PG8_SB(0, 0), b2, voffB);
            PG8_BAR; PG8_WAIT_L(0); PG8_MMA(0, 1, At, B1); PG8_BAR;
            PG8_LDA(At, 0, 1); PG8_STAGE(PG8_SA(0, 0), a2, voffA);
            PG8_BAR; PG8_WAIT_L(0); PG8_MMA(1, 0, At, B0); PG8_BAR; PG8_SCHED;
            PG8_STAGE(PG8_SB(0, 1), b2 + hstepB, voffB);
            PG8_WAIT_V(6); PG8_BAR; PG8_MMA(1, 1, At, B1); PG8_BAR;
            PG8_LDB(B0, 1, 0); PG8_SCHED; PG8_LDA(At, 1, 0); PG8_STAGE(PG8_SA(0, 1), a2 + hstep, voffA);
            PG8_WAIT_L(8); PG8_BAR; PG8_WAIT_L(0); PG8_MMA(0, 0, At, B0); PG8_BAR; PG8_SCHED;
            PG8_LDB(B1, 1, 1); PG8_STAGE(PG8_SB(1, 0), b3, voffB);
            PG8_BAR; PG8_WAIT_L(0); PG8_MMA(0, 1, At, B1); PG8_BAR;
            PG8_LDA(At, 1, 1); PG8_STAGE(PG8_SA(1, 0), a3, voffA);
            PG8_BAR; PG8_WAIT_L(0); PG8_MMA(1, 0, At, B0); PG8_BAR; PG8_SCHED;
            PG8_STAGE(PG8_SB(1, 1), b3 + hstepB, voffB);
            PG8_WAIT_V(6); PG8_BAR; PG8_MMA(1, 1, At, B1); PG8_BAR;
            }
        }
        if constexpr (MT == 2) asm volatile("s_nop 15\n\ts_nop 7" ::: "memory");
        if constexpr (ALIGN_EPI) { if (wr == 0) PG8_BAR; }
        if constexpr (!Epi::AFTER_DRAIN) { E(acc, cur, wr, wc, fr, fq); S.done(cur); S.after_unit(ui); }
        if (!has_next) break;
#pragma unroll
        for (int a = 0; a < 2; ++a)
#pragma unroll
            for (int b = 0; b < 2; ++b)
#pragma unroll
                for (int m = 0; m < 4; ++m)
#pragma unroll
                    for (int n = 0; n < 2; ++n) acc[a][b][m][n] = (f32x4){0.f, 0.f, 0.f, 0.f};
        cur = nxt; cA = nA; cB = nB; ++ui;
        if constexpr (ALIGN_EPI) { if (wr == 1) PG8_BAR; }
    }
    PG8_WAIT_V(0);
    if constexpr (!ALIGN_EPI) { if (wr == 0) PG8_BAR; }
    PG8_BAR;
    if constexpr (Epi::AFTER_DRAIN) { E.fused(acc, cur, wr, wc, fr, fq, lds, wid, lane); S.done(cur); }
#undef PG8_SA
#undef PG8_SB
#undef PG8_STAGE
#undef PG8_LDA
#undef PG8_LDB
#undef PG8_MMA
#undef PG8_WAIT_V
#undef PG8_WAIT_L
#undef PG8_BAR
#undef PG8_SCHED
}
}


constexpr int NWAVES = 8;
constexpr bool USE_CG_SYNC = false;
#ifndef REP_MASK
#define REP_MASK 0
#endif
constexpr int RING_OFF = 0, RING_BYTES = 131072;
constexpr int LDSCTL_OFF = RING_BYTES, MISC_OFF = LDSCTL_OFF + 320;
constexpr int LDS_BYTES = 147456;
constexpr int CW_CENSUS = 1024;
constexpr int CW_BAR = 4096;
constexpr size_t CTL_ZERO_BYTES = 1 * MiB;
constexpr int NPH_LAYER = 10, NPHASES = 1 + DEPTH * NPH_LAYER;

struct Frame {
    LAS unsigned char* lds; volatile LAS unsigned* MISC; unsigned* ctl;
    int tid, lane, wave, G, vcu, cid;
    unsigned char* ws;
};
struct Args { const float* in[13]; float* out; unsigned char* ws; int ph_lo, ph_hi, cg_seams, pad; };

__device__ __forceinline__ float wave_sum(float v) {
#pragma unroll
    for (int o = 1; o < 64; o <<= 1) v += __shfl_xor(v, o);
    return v;
}
__device__ __forceinline__ float bflo(unsigned w) { return __builtin_bit_cast(float, w << 16); }
__device__ __forceinline__ float bfhi(unsigned w) { return __builtin_bit_cast(float, w & 0xffff0000u); }

__device__ __forceinline__ unsigned q8x4(float a, float b, float c, float d) {
    const int ia = (int)__builtin_rintf(a), ib = (int)__builtin_rintf(b), ic = (int)__builtin_rintf(c), id = (int)__builtin_rintf(d);
    return (unsigned)(ia & 0xff) | ((unsigned)(ib & 0xff) << 8) | ((unsigned)(ic & 0xff) << 16) | ((unsigned)id << 24);
}
__device__ __forceinline__ float wave_max(float v) {
#pragma unroll
    for (int o = 1; o < 64; o <<= 1) v = fmaxf(v, __shfl_xor(v, o));
    return v;
}
__device__ __forceinline__ void quant_row_store(const f32x4 (&h)[4], signed char* orow, float* scale_out, int lane) {
    float m = 0.f;
#pragma unroll
    for (int j = 0; j < 4; ++j) m = fmaxf(fmaxf(m, fmaxf(fabsf(h[j].x), fabsf(h[j].y))), fmaxf(fabsf(h[j].z), fabsf(h[j].w)));
    m = wave_max(m);
    const float inv = m > 0.f ? 127.f / m : 0.f;
    unsigned* o4 = (unsigned*)orow + lane;
#pragma unroll
    for (int j = 0; j < 4; ++j) o4[64 * j] = q8x4(h[j].x * inv, h[j].y * inv, h[j].z * inv, h[j].w * inv);
    if (lane == 0) *scale_out = m * (1.f / 127.f);
}
__device__ __forceinline__ void rms_row_to_i8(const float* xrow, const float* gain, signed char* orow, float* scale_out, int lane) {
    const f32x4* xr = (const f32x4*)xrow + lane; const f32x4* gr = (const f32x4*)gain + lane;
    f32x4 v[4]; float s = 0.f;
#pragma unroll
    for (int j = 0; j < 4; ++j) { v[j] = xr[64 * j]; s += (v[j].x * v[j].x + v[j].y * v[j].y) + (v[j].z * v[j].z + v[j].w * v[j].w); }
    const float rstd = rsqrtf(wave_sum(s) * (1.f / DM) + EPS);
#pragma unroll
    for (int j = 0; j < 4; ++j) { const f32x4 g = gr[64 * j]; v[j].x *= rstd * g.x; v[j].y *= rstd * g.y; v[j].z *= rstd * g.z; v[j].w *= rstd * g.w; }
    quant_row_store(v, orow, scale_out, lane);
}
__device__ __forceinline__ void p0_q8_block_item(Frame& F, const float* W, int N, int n0, signed char* WQ, float* wsc, int mode, LAS float* red) {
    const int lane = F.lane, w = F.wave;
    const float* p = W + (size_t)(128 * w) * N + n0 + lane;
    float v[128]; float m = 0.f;
#pragma unroll
    for (int i = 0; i < 128; ++i) v[i] = __builtin_nontemporal_load(p + (size_t)i * N);
#pragma unroll
    for (int i = 0; i < 128; ++i) m = fmaxf(m, fabsf(v[i]));
    red[w * 64 + lane] = m;
    __syncthreads();
    float M = red[lane];
#pragma unroll
    for (int j = 1; j < 8; ++j) M = fmaxf(M, red[j * 64 + lane]);
    const float inv = M > 0.f ? 127.f / M : 0.f;
    const int ng = n0 + lane;
    const int np = (mode == 0) ? ng : ((ng >> 7) * 256 + ((ng >> 2) & 1) * 128 + ((ng >> 5) & 3) * 32 + (mode == 2 ? 16 : 0) + ((ng >> 3) & 3) * 4 + (ng & 3));
    v4u* o = (v4u*)(WQ + (size_t)np * 1024 + 128 * w);
#pragma unroll
    for (int i = 0; i < 8; ++i) { v4u q; q.x = q8x4(v[16 * i] * inv, v[16 * i + 1] * inv, v[16 * i + 2] * inv, v[16 * i + 3] * inv); q.y = q8x4(v[16 * i + 4] * inv, v[16 * i + 5] * inv, v[16 * i + 6] * inv, v[16 * i + 7] * inv);
        q.z = q8x4(v[16 * i + 8] * inv, v[16 * i + 9] * inv, v[16 * i + 10] * inv, v[16 * i + 11] * inv); q.w = q8x4(v[16 * i + 12] * inv, v[16 * i + 13] * inv, v[16 * i + 14] * inv, v[16 * i + 15] * inv); o[i] = q; }
    if (w == 0) wsc[np] = M * (1.f / 127.f);
    __syncthreads();
}
__device__ __forceinline__ void p0_tr16_item(const float* W, int K, int N, bf16* WT, int ldo, int koff, int item, int lane) {
    const int nblk = N / 128, kb = item / nblk, nb = item % nblk, k0 = 32 * kb, n0 = 128 * nb;
    const f32x2_t* p = (const f32x2_t*)(W + (size_t)k0 * N + n0) + lane; const size_t rstep = (size_t)N / 2;
    f32x2_t v[32];
#pragma unroll
    for (int i = 0; i < 32; ++i) v[i] = p[(size_t)i * rstep];
    v4u* o0 = (v4u*)(WT + (size_t)(n0 + 2 * lane) * ldo + koff + k0); v4u* o1 = (v4u*)(WT + (size_t)(n0 + 2 * lane + 1) * ldo + koff + k0);
#pragma unroll
    for (int i = 0; i < 4; ++i) { v4u q0, q1;
        q0.x = pk2(v[8 * i].x, v[8 * i + 1].x); q0.y = pk2(v[8 * i + 2].x, v[8 * i + 3].x); q0.z = pk2(v[8 * i + 4].x, v[8 * i + 5].x); q0.w = pk2(v[8 * i + 6].x, v[8 * i + 7].x);
        q1.x = pk2(v[8 * i].y, v[8 * i + 1].y); q1.y = pk2(v[8 * i + 2].y, v[8 * i + 3].y); q1.z = pk2(v[8 * i + 4].y, v[8 * i + 5].y); q1.w = pk2(v[8 * i + 6].y, v[8 * i + 7].y);
        o0[i] = q0; o1[i] = q1; }
}
struct TrTile { const float* W; bf16* WT; int N, ldo, koff, k0, n0, fp8; };
__device__ __forceinline__ void p0_tr_load(const TrTile& t, f32x4 (&v)[8], const int w, const int lane) {
    const float* p = t.W + (size_t)(t.k0 + 8 * w) * t.N + t.n0 + 4 * lane;
#pragma unroll
    for (int i = 0; i < 8; ++i) v[i] = __builtin_nontemporal_load((const f32x4*)(p + (size_t)i * t.N));
}
__device__ __forceinline__ void p0_tr_store(Frame& F, const TrTile& t, const f32x4 (&v)[8], LAS float* buf) {
    const int w = F.wave, lane = F.lane, tid = F.tid;
#pragma unroll
    for (int i = 0; i < 8; ++i) *(LAS f32x4*)(buf + (8 * w + i) * 256 + 4 * lane) = v[i];
    __syncthreads();
    const int n = tid & 255;
#pragma unroll
    for (int j = 0; j < 4; ++j) { const int kc = (tid >> 8) + 2 * j; const LAS float* sp = buf + (8 * kc) * 256 + n;
        v4u o; o.x = pk2(sp[0], sp[256]); o.y = pk2(sp[2 * 256], sp[3 * 256]); o.z = pk2(sp[4 * 256], sp[5 * 256]); o.w = pk2(sp[6 * 256], sp[7 * 256]);
        *(v4u*)(t.WT + (size_t)(t.n0 + n) * t.ldo + t.koff + t.k0 + 8 * kc) = o; }
}
__device__ __forceinline__ void p0_tr_store_fp8(Frame& F, const TrTile& t, const f32x4 (&v)[8], LAS float* buf) {
    const int w = F.wave, lane = F.lane;
#pragma unroll
    for (int i = 0; i < 8; ++i) *(LAS f32x4*)(buf + (8 * w + i) * 256 + 4 * (lane ^ (4 * (w >> 1)))) = v[i];
    __syncthreads();
    unsigned char* W8 = (unsigned char*)t.WT; const float lim = fp8_lim(); const int kq = lane & 3;
#pragma unroll
    for (int jj = 0; jj < 2; ++jj) { const int n = 32 * w + 16 * jj + (lane >> 2); const LAS float* sp = buf + (16 * kq) * 256 + 4 * ((n >> 2) ^ (4 * kq)) + (n & 3);
        u32x4 o;
        o.x = fp8x4(sp[0] * 64.f, sp[256] * 64.f, sp[2 * 256] * 64.f, sp[3 * 256] * 64.f, lim); o.y = fp8x4(sp[4 * 256] * 64.f, sp[5 * 256] * 64.f, sp[6 * 256] * 64.f, sp[7 * 256] * 64.f, lim);
        o.z = fp8x4(sp[8 * 256] * 64.f, sp[9 * 256] * 64.f, sp[10 * 256] * 64.f, sp[11 * 256] * 64.f, lim); o.w = fp8x4(sp[12 * 256] * 64.f, sp[13 * 256] * 64.f, sp[14 * 256] * 64.f, sp[15 * 256] * 64.f, lim);
        *(u32x4*)(W8 + (size_t)(t.n0 + n) * t.ldo + t.koff + t.k0 + 16 * kq) = o; }
}
__device__ __forceinline__ void phase_p0(Frame& F, const Args& a) {
    const int gw = F.vcu * NWAVES + F.wave, NGW = F.G * NWAVES;
    unsigned char* ws = F.ws;
    {   constexpr int B_IN = NIN / 64, B_G = FF / 64, B_TOT = DEPTH * B_IN + 2 * DEPTH * NE * B_G;
        LAS float* red = (LAS float*)(F.lds + RING_OFF);
        struct Q8Item { const float* W; signed char* WQ; float* wsc; int N, n0, mode; };
        auto decode = [&](int it, Q8Item& q) { int r = it;
            if (r < DEPTH * B_IN) { const int l = r / B_IN; r %= B_IN; q.W = a.in[1] + (size_t)l * DM * NIN; q.N = NIN; q.n0 = 64 * r; q.WQ = (signed char*)(ws + WS_WIN) + (size_t)l * NIN * DM; q.wsc = (float*)(ws + WS_WINS) + l * NIN; q.mode = 0; return; }
            r -= DEPTH * B_IN; const int which = r / (DEPTH * NE * B_G); r %= (DEPTH * NE * B_G); const int le = r / B_G; r %= B_G;
            q.W = a.in[which ? 10 : 9] + (size_t)le * DM * FF; q.N = FF; q.n0 = 64 * r; q.WQ = (signed char*)(ws + WS_WGU) + (size_t)le * 2 * FF * DM; q.wsc = (float*)(ws + WS_WGUS) + (size_t)le * 2 * FF; q.mode = which ? 2 : 1; };
        float v[128]; Q8Item cur, nxt; const int lane = F.lane, w = F.wave;
#define P0_Q8_LOAD(q_) do { const float* p_ = (q_).W + (size_t)(128 * w) * (q_).N + (q_).n0 + lane; _Pragma("unroll") for (int i = 0; i < 128; ++i) v[i] = __builtin_nontemporal_load(p_ + (size_t)i * (q_).N); } while (0)
        int it = F.vcu, par = 0;
        if (it < B_TOT) { decode(it, cur); P0_Q8_LOAD(cur); }
#pragma unroll 1
        for (; it < B_TOT; it += F.G, par ^= 1) {
            const bool more = it + F.G < B_TOT; if (more) decode(it + F.G, nxt);
            float m = 0.f;
#pragma unroll
            for (int i = 0; i < 128; ++i) m = fmaxf(m, fabsf(v[i]));
            red[par * 512 + w * 64 + lane] = m;
            __syncthreads();
            float M = red[par * 512 + lane];
#pragma unroll
            for (int j = 1; j < 8; ++j) M = fmaxf(M, red[par * 512 + j * 64 + lane]);
            const float inv = M > 0.f ? 127.f / M : 0.f;
            v4u q[8];
#pragma unroll
            for (int i = 0; i < 8; ++i) { q[i].x = q8x4(v[16 * i] * inv, v[16 * i + 1] * inv, v[16 * i + 2] * inv, v[16 * i + 3] * inv); q[i].y = q8x4(v[16 * i + 4] * inv, v[16 * i + 5] * inv, v[16 * i + 6] * inv, v[16 * i + 7] * inv);
                q[i].z = q8x4(v[16 * i + 8] * inv, v[16 * i + 9] * inv, v[16 * i + 10] * inv, v[16 * i + 11] * inv); q[i].w = q8x4(v[16 * i + 12] * inv, v[16 * i + 13] * inv, v[16 * i + 14] * inv, v[16 * i + 15] * inv); }
#define P0_NP(ng_) ((cur.mode == 0) ? (ng_) : (((ng_) >> 7) * 256 + (((ng_) >> 2) & 1) * 128 + (((ng_) >> 5) & 3) * 32 + (cur.mode == 2 ? 16 : 0) + (((ng_) >> 3) & 3) * 4 + ((ng_) & 3)))
            {   LAS unsigned char* tb = F.lds + RING_OFF + 8192 + w * (64 * 144);
#pragma unroll
                for (int i = 0; i < 8; ++i) *(LAS v4u*)(tb + lane * 144 + i * 16) = q[i];
                const int g8 = lane >> 3, j8 = lane & 7;
#pragma unroll
                for (int i = 0; i < 8; ++i) { const int c = 8 * g8 + i; const v4u r = *(const LAS v4u*)(tb + c * 144 + j8 * 16); const int ngc = cur.n0 + c, npc = P0_NP(ngc);
                    *(v4u*)(cur.WQ + (size_t)npc * 1024 + 128 * w + 16 * j8) = r; } }
            if (w == 0) { const int ng = cur.n0 + lane; cur.wsc[P0_NP(ng)] = M * (1.f / 127.f); }
#undef P0_NP
            if (more) { cur = nxt; P0_Q8_LOAD(cur); }
        }
#undef P0_Q8_LOAD
        __syncthreads();
    }
    {   constexpr int T_AO = (AW / 64) * (DM / 256), T_RO = (RW / 64) * (DM / 256), T_O = (DM / 64) * (DM / 256), T_D = (FF / 64) * (DM / 256);
        constexpr int T_LAYER = T_AO + T_RO + T_O + NE * T_D, T_TOT = DEPTH * T_LAYER;
        LAS float* buf = (LAS float*)(F.lds + RING_OFF);
        auto decode = [&](int it, TrTile& t) {
            const int l = it / T_LAYER; int r = it % T_LAYER; t.fp8 = 0;
            if (r < T_AO) { t.W = a.in[2] + (size_t)l * AW * DM; t.N = DM; t.WT = (bf16*)(ws + WS_WCAT + (size_t)l * DM * CATW); t.ldo = CATW; t.koff = 0; t.fp8 = 1; }
            else if ((r -= T_AO) < T_RO) { t.W = a.in[3] + (size_t)l * RW * DM; t.N = DM; t.WT = (bf16*)(ws + WS_WCAT + (size_t)l * DM * CATW); t.ldo = CATW; t.koff = AW; t.fp8 = 1; }
            else if ((r -= T_RO) < T_O) { t.W = a.in[4] + (size_t)l * DM * DM; t.N = DM; t.WT = (bf16*)(ws + WS_WO) + (size_t)l * DM * DM; t.ldo = DM; t.koff = 0; }
            else { r -= T_O; const int e = r / T_D; r %= T_D; const size_t le = (size_t)l * NE + e; t.W = a.in[11] + le * FF * DM; t.N = DM; t.ldo = FF; t.koff = 0;
                t.WT = (bf16*)(ws + WS_WDN + le * DM * FF); t.fp8 = 1; }
            t.k0 = 64 * (r >> 2); t.n0 = 256 * (r & 3);
        };
        TrTile cur, nx1, nx2; f32x4 v[8], v1[8], v2[8];
        GAS unsigned* qg = (GAS unsigned*)F.ctl; asm volatile("" : "+s"(qg)); unsigned* tq = (unsigned*)qg + CW_TQ; volatile LAS unsigned* aq = F.MISC + 40;
        if (F.tid == 0) { aq[0] = xb_add(tq, 1u); aq[1] = xb_add(tq, 1u); aq[2] = xb_add(tq, 1u); }
        __syncthreads();
        int i0 = __builtin_amdgcn_readfirstlane((int)aq[0]), i1 = __builtin_amdgcn_readfirstlane((int)aq[1]), i2 = __builtin_amdgcn_readfirstlane((int)aq[2]), tpar = 0;
        if (i0 < T_TOT) { decode(i0, cur); p0_tr_load(cur, v, F.wave, F.lane); }
        if (i1 < T_TOT) { decode(i1, nx1); p0_tr_load(nx1, v1, F.wave, F.lane); }
#pragma unroll 1
        while (i0 < T_TOT) {
            unsigned f = (unsigned)T_TOT; if (F.tid == 0 && i2 < T_TOT) f = xb_add(tq, 1u);
            if (i2 < T_TOT) { decode(i2, nx2); p0_tr_load(nx2, v2, F.wave, F.lane); }
            if (F.tid == 0) aq[4 + tpar] = f;
            if (cur.fp8) p0_tr_store_fp8(F, cur, v, buf + tpar * 16384); else p0_tr_store(F, cur, v, buf + tpar * 16384);
            const int i3 = __builtin_amdgcn_readfirstlane((int)aq[4 + tpar]);
            tpar ^= 1; cur = nx1; nx1 = nx2; i0 = i1; i1 = i2; i2 = i3;
#pragma unroll
            for (int i = 0; i < 8; ++i) { v[i] = v1[i]; v1[i] = v2[i]; }
        }
        __syncthreads();
    }
#pragma unroll 1
    for (int m = gw; m < T; m += 4 * NGW) {
        f32x4 xv[4][4];
#pragma unroll
        for (int r = 0; r < 4; ++r) { const int mr = (m + r * NGW < T) ? m + r * NGW : m; const f32x4* xr = (const f32x4*)(a.in[0] + (size_t)mr * DM) + F.lane;
#pragma unroll
            for (int j = 0; j < 4; ++j) xv[r][j] = xr[64 * j]; }
#pragma unroll
        for (int r = 0; r < 4; ++r) { const int mr = m + r * NGW; if (mr < T) {
            float ss = 0.f;
#pragma unroll
            for (int j = 0; j < 4; ++j) ss += (xv[r][j].x * xv[r][j].x + xv[r][j].y * xv[r][j].y) + (xv[r][j].z * xv[r][j].z + xv[r][j].w * xv[r][j].w);
            const float rstd = rsqrtf(wave_sum(ss) * (1.f / DM) + EPS); const f32x4* gr = (const f32x4*)a.in[6] + F.lane;
#pragma unroll
            for (int j = 0; j < 4; ++j) { const f32x4 g = gr[64 * j]; xv[r][j].x *= rstd * g.x; xv[r][j].y *= rstd * g.y; xv[r][j].z *= rstd * g.z; xv[r][j].w *= rstd * g.w; }
            quant_row_store(xv[r], (signed char*)(ws + WS_H) + (size_t)mr * DM, (float*)(ws + WS_HS) + mr, F.lane); } }
    }
}

struct FinIn { u32x2 yf[4], yb[4], gq[4]; float l0, l1, l2; v4u p0, p1, p2; };
__device__ __forceinline__ void fin_load(FinIn& I, const int t, const int lane, const bf16* PROJ, const bf16* YF, const bf16* YB, const bf16* ATTO, const float* LSE) {
#pragma unroll
    for (int j = 0; j < 4; ++j) { const int c = 256 * j + 4 * lane;
        I.yf[j] = *(const u32x2*)(YF + (size_t)t * RW + c); I.yb[j] = *(const u32x2*)(YB + (size_t)t * RW + c); I.gq[j] = *(const u32x2*)(PROJ + PO_RG + (size_t)t * RW + c); }
    const int hh = lane >> 3, c = 8 * lane;
    I.l0 = LSE[((size_t)0 * T + t) * 8 + hh]; I.l1 = LSE[((size_t)1 * T + t) * 8 + hh]; I.l2 = LSE[((size_t)2 * T + t) * 8 + hh];
    I.p0 = *(const v4u*)(ATTO + ((size_t)0 * T + t) * AW + c); I.p1 = *(const v4u*)(ATTO + ((size_t)1 * T + t) * AW + c); I.p2 = *(const v4u*)(ATTO + ((size_t)2 * T + t) * AW + c);
}
__device__ __forceinline__ void fin_compute(const FinIn& I, const int t, const int lane, unsigned char* CAT) {
    unsigned char* crow = CAT + (size_t)t * CATW; const float lim = fp8_lim();
#pragma unroll
    for (int j = 0; j < 4; ++j) {
        const int c = 256 * j + 4 * lane; const u32x2 yf = I.yf[j], yb = I.yb[j], gq = I.gq[j];
        const float r0 = bflo(yf.x) + bflo(yb.x), r1 = bfhi(yf.x) + bfhi(yb.x), r2 = bflo(yf.y) + bflo(yb.y), r3 = bfhi(yf.y) + bfhi(yb.y);
        const float rstd = rsqrtf(wave_sum((r0 * r0 + r1 * r1) + (r2 * r2 + r3 * r3)) * (1.f / 256.f) + EPS);
        const float g0 = bflo(gq.x), g1 = bfhi(gq.x), g2 = bflo(gq.y), g3 = bfhi(gq.y);
        const float rs16 = rstd * 16.f;
        *(unsigned*)(crow + AW + c) = fp8x4(siluf_(g0) * r0 * rs16, siluf_(g1) * r1 * rs16, siluf_(g2) * r2 * rs16, siluf_(g3) * r3 * rs16, lim);
    }
    {
        const int c = 8 * lane; const float l0 = I.l0, l1 = I.l1, l2 = I.l2; const v4u p0 = I.p0, p1 = I.p1, p2 = I.p2;
        const float mx = fmaxf(l0, fmaxf(l1, l2)); float w0 = __expf(l0 - mx), w1 = __expf(l1 - mx), w2 = __expf(l2 - mx); const float inv = 16.f / (w0 + w1 + w2); w0 *= inv; w1 *= inv; w2 *= inv;
        u32x2 o;
        o.x = fp8x4(w0 * bflo(p0.x) + w1 * bflo(p1.x) + w2 * bflo(p2.x), w0 * bfhi(p0.x) + w1 * bfhi(p1.x) + w2 * bfhi(p2.x), w0 * bflo(p0.y) + w1 * bflo(p1.y) + w2 * bflo(p2.y), w0 * bfhi(p0.y) + w1 * bfhi(p1.y) + w2 * bfhi(p2.y), lim);
        o.y = fp8x4(w0 * bflo(p0.z) + w1 * bflo(p1.z) + w2 * bflo(p2.z), w0 * bfhi(p0.z) + w1 * bfhi(p1.z) + w2 * bfhi(p2.z), w0 * bflo(p0.w) + w1 * bflo(p1.w) + w2 * bflo(p2.w), w0 * bfhi(p0.w) + w1 * bfhi(p1.w) + w2 * bfhi(p2.w), lim);
        *(u32x2*)(crow + c) = o;
    }
}
__device__ __forceinline__ void phase_finalize(Frame& F, const Args& a) {
    unsigned char* ws = F.ws; const bf16* PROJ = (const bf16*)(ws + WS_PROJ); const bf16* YF = (const bf16*)(ws + WS_YF); const bf16* YB = (const bf16*)(ws + WS_YB);
    const bf16* ATTO = (const bf16*)(ws + WS_ATTO); const float* LSE = (const float*)(ws + WS_LSE); unsigned char* CAT = ws + WS_CAT;
    const int gw = F.vcu * NWAVES + F.wave, NGW = F.G * NWAVES, lane = F.lane;
#pragma unroll 1
    for (int t = gw; t < T; t += 2 * NGW) {
        FinIn A, B; const int t2 = t + NGW; const bool two = t2 < T;
        fin_load(A, t, lane, PROJ, YF, YB, ATTO, LSE); fin_load(B, two ? t2 : t, lane, PROJ, YF, YB, ATTO, LSE);
        fin_compute(A, t, lane, CAT); if (two) fin_compute(B, t2, lane, CAT);
    }
}

__device__ __forceinline__ void phase_norm_router(Frame& F, const Args& a, int layer) {
    unsigned char* ws = F.ws; const bf16* x = (const bf16*)(ws + WS_XB); const float* gain = a.in[7] + (size_t)layer * DM; const float* wr = a.in[8] + (size_t)layer * DM * NE;
    signed char* H8 = (signed char*)(ws + WS_H); float* HS = (float*)(ws + WS_HS); float* AFF = (float*)(ws + WS_AFF);
    LAS unsigned short* WH = (LAS unsigned short*)(F.lds + RING_OFF);
    LAS unsigned short* WL = WH + 16384;
    LAS float* GL = (LAS float*)(F.lds + RING_OFF + 65536);
    const int lane = F.lane, tq = lane & 15, kg = lane >> 4, kh = F.wave & 1, c0 = 2 * kh, c1 = 2 * kh + 1, tfirst = F.vcu * 4;
    LAS float* EX = (LAS float*)(F.lds + RING_OFF + 73728);
    v4u xa[8], xb[8];
#define RT_LOAD(buf, c) do { _Pragma("unroll") for (int s8 = 0; s8 < 8; ++s8) buf[s8] = *(const v4u*)(xr + 32 * (8 * (c) + s8)); } while (0)
#define RT_X0(r_) ((f32x4){bflo((r_).x), bfhi((r_).x), bflo((r_).y), bfhi((r_).y)})
#define RT_X1(r_) ((f32x4){bflo((r_).z), bfhi((r_).z), bflo((r_).w), bfhi((r_).w)})
#define RT_P1(buf, c) do { _Pragma("unroll") for (int s8 = 0; s8 < 8; ++s8) { const int sk = 8 * (c) + s8; \
                const f32x4 g0 = *(const LAS f32x4*)(GL + 32 * sk + 8 * kg), g1 = *(const LAS f32x4*)(GL + 32 * sk + 8 * kg + 4); \
                const f32x4 x0 = RT_X0(buf[s8]), x1 = RT_X1(buf[s8]); \
                ss += ((x0.x * x0.x + x0.y * x0.y) + (x0.z * x0.z + x0.w * x0.w)) + ((x1.x * x1.x + x1.y * x1.y) + (x1.z * x1.z + x1.w * x1.w)); \
                const f32x4 v0 = x0 * g0, v1 = x1 * g1; \
                mx = fmaxf(mx, fmaxf(fmaxf(fmaxf(fabsf(v0.x), fabsf(v0.y)), fmaxf(fabsf(v0.z), fabsf(v0.w))), fmaxf(fmaxf(fabsf(v1.x), fabsf(v1.y)), fmaxf(fabsf(v1.z), fabsf(v1.w))))); \
                v4u hi; hi.x = pk2(v0.x, v0.y); hi.y = pk2(v0.z, v0.w); hi.z = pk2(v1.x, v1.y); hi.w = pk2(v1.z, v1.w); \
                v4u lo; lo.x = pk2(v0.x - bflo(hi.x), v0.y - bfhi(hi.x)); lo.y = pk2(v0.z - bflo(hi.y), v0.w - bfhi(hi.y)); lo.z = pk2(v1.x - bflo(hi.z), v1.y - bfhi(hi.z)); lo.w = pk2(v1.z - bflo(hi.w), v1.w - bfhi(hi.w)); \
                const bf16x8 wh = *(const LAS bf16x8*)(WH + ((sk * 4 + kg) * 16 + tq) * 8), wl = *(const LAS bf16x8*)(WL + ((sk * 4 + kg) * 16 + tq) * 8); \
                const bf16x8 ah = __builtin_bit_cast(bf16x8, hi), al = __builtin_bit_cast(bf16x8, lo); \
                acc = __builtin_amdgcn_mfma_f32_16x16x32_bf16(ah, wh, acc, 0, 0, 0); acc = __builtin_amdgcn_mfma_f32_16x16x32_bf16(al, wh, acc, 0, 0, 0); acc = __builtin_amdgcn_mfma_f32_16x16x32_bf16(ah, wl, acc, 0, 0, 0); } } while (0)
#define RT_P2(buf, c) do { _Pragma("unroll") for (int s8 = 0; s8 < 8; ++s8) { const int sk = 8 * (c) + s8; \
                const f32x4 g0 = *(const LAS f32x4*)(GL + 32 * sk + 8 * kg) * qi, g1 = *(const LAS f32x4*)(GL + 32 * sk + 8 * kg + 4) * qi; \
                v4u r_ = buf[s8]; asm volatile("" : "+v"(r_.x), "+v"(r_.y), "+v"(r_.z), "+v"(r_.w));        \
                const f32x4 x0 = RT_X0(r_), x1 = RT_X1(r_); u32x2 o; o.x = q8x4(x0.x * g0.x, x0.y * g0.y, x0.z * g0.z, x0.w * g0.w); o.y = q8x4(x1.x * g1.x, x1.y * g1.y, x1.z * g1.z, x1.w * g1.w); \
                *(u32x2*)(orow + 32 * sk) = o; } } while (0)
#define SB __builtin_amdgcn_sched_barrier(0)
    if (tfirst < T / 16) { const bf16* xr = x + (size_t)(16 * (tfirst + (F.wave >> 1)) + tq) * DM + 8 * kg; RT_LOAD(xa, c0); RT_LOAD(xb, c1); }
    SB;
#pragma unroll
    for (int kh = 0; kh < 2; ++kh) {   f32x4 wv[4];
#pragma unroll
        for (int k = 0; k < 4; ++k) wv[k] = ((const f32x4*)wr)[F.tid + 512 * (4 * kh + k)];
#pragma unroll
        for (int k = 0; k < 4; ++k) { const int i4 = F.tid + 512 * (4 * kh + k), d = i4 >> 2, e0 = (i4 & 3) * 4; const int base = (((d >> 5) * 4 + ((d >> 3) & 3)) * 16) * 8 + (d & 7);
#pragma unroll
            for (int c = 0; c < 4; ++c) { const float w = wv[k][c]; const unsigned hi = pk2(w, 0.f) & 0xffffu; const float lo = w - bflo(hi);
                WH[base + (e0 + c) * 8] = (unsigned short)hi; WL[base + (e0 + c) * 8] = (unsigned short)(pk2(lo, 0.f) & 0xffffu); } } }
    for (int i = F.tid; i < DM / 4; i += NWAVES * 64) ((LAS f32x4*)GL)[i] = ((const f32x4*)gain)[i];
    __syncthreads();
#pragma unroll 1
    for (int t0 = tfirst; t0 < T / 16; t0 += F.G * 4) {
        const int tile = t0 + (F.wave >> 1), token = 16 * tile + tq; const bf16* xr = x + (size_t)token * DM + 8 * kg;
        if (t0 != tfirst) { RT_LOAD(xa, c0); RT_LOAD(xb, c1); }
        f32x4 acc = {0.f, 0.f, 0.f, 0.f}; float ss = 0.f, mx = 0.f;
        SB; RT_P1(xa, c0); SB; RT_P1(xb, c1); SB;
        ss += __shfl_xor(ss, 16); ss += __shfl_xor(ss, 32); mx = fmaxf(mx, __shfl_xor(mx, 16)); mx = fmaxf(mx, __shfl_xor(mx, 32));
        {   LAS float* ex = EX + (F.wave * 64 + lane) * 8; *(LAS f32x4*)ex = acc; *(LAS f32x2_t*)(ex + 4) = (f32x2_t){ss, mx}; }
        __syncthreads();
        {   const LAS float* ex = EX + ((F.wave ^ 1) * 64 + lane) * 8; const f32x4 pa = *(const LAS f32x4*)ex; const f32x2_t pm = *(const LAS f32x2_t*)(ex + 4); acc += pa; ss += pm.x; mx = fmaxf(mx, pm.y); }
        const float rstd = rsqrtf(ss * (1.f / DM) + EPS);
#pragma unroll
        for (int rr = 0; rr < 2; ++rr) { const int r = 2 * kh + rr; const float l = (kh ? acc[2 + rr] : acc[rr]) * __shfl(rstd, 4 * kg + r);
            float m = l; m = fmaxf(m, __shfl_xor(m, 1)); m = fmaxf(m, __shfl_xor(m, 2)); m = fmaxf(m, __shfl_xor(m, 4)); m = fmaxf(m, __shfl_xor(m, 8));
            const float p = __expf(l - m); float den = p; den += __shfl_xor(den, 1); den += __shfl_xor(den, 2); den += __shfl_xor(den, 4); den += __shfl_xor(den, 8);
            AFF[(size_t)(16 * tile + 4 * kg + r) * 16 + tq] = p / den; }
        const float qi = mx > 0.f ? 127.f / mx : 0.f;
        signed char* orow = H8 + (size_t)token * DM + 8 * kg;
        SB; RT_P2(xa, c0); SB; RT_P2(xb, c1);
        if (kg == 0 && kh == 0) HS[token] = mx * rstd * (1.f / 127.f);
        __syncthreads();
    }
#undef SB
#undef RT_LOAD
#undef RT_X0
#undef RT_X1
#undef RT_P1
#undef RT_P2
}

__device__ __forceinline__ int block_excl_scan(Frame& F, const int v, LAS int* wsum) {
    int inc = v;
#pragma unroll
    for (int o = 1; o < 64; o <<= 1) { const int t = __shfl_up(inc, o); if (F.lane >= o) inc += t; }
    if (F.lane == 63) wsum[F.wave] = inc;
    __syncthreads();
    int off = 0;
#pragma unroll
    for (int w = 0; w < NWAVES; ++w) off += (w < F.wave) ? wsum[w] : 0;
    __syncthreads();
    return off + inc - v;
}
__device__ __forceinline__ void phase_topk(Frame& F, const Args& a) {
    unsigned char* ws = F.ws; const float* AFF = (const float*)(ws + WS_AFF); const signed char* H8 = (const signed char*)(ws + WS_H); const float* HS = (const float*)(ws + WS_HS);
    int* IDX = (int*)(ws + WS_IDX); float* GW = (float*)(ws + WS_GW); int* SLOT = (int*)(ws + WS_SLOT); signed char* XIN = (signed char*)(ws + WS_XIN); float* XS = (float*)(ws + WS_XS);
    LAS int* hist = (LAS int*)(F.lds + RING_OFF);
    LAS int* res = hist + 256;
    LAS int* wsum = hist + 272;
    LAS int* cnt = hist + 288;
    LAS int* selt = hist + 512;
    LAS int* selr = hist + 1024;
    const int tid = F.tid, lane = F.lane;
#pragma unroll 1
    for (int u = F.vcu; u < NB * NE * 2; u += F.G) {
        const int half = u & 1, be = u >> 1, b = be >> 4, e = be & 15;
        unsigned key[4];
#pragma unroll
        for (int i = 0; i < 4; ++i) key[i] = __float_as_uint(AFF[(size_t)(b * SEQ + 4 * tid + i) * 16 + e]);
        unsigned prefix = 0; int k = CAP; int one = 1; asm volatile("" : "+v"(one));
#pragma unroll
        for (int pass = 0; pass < 4; ++pass) { const int shift = 24 - 8 * pass;
            __syncthreads();
            if (tid < 256) hist[tid] = 0;
            if (tid == 0) cnt[0] = 0;
            __syncthreads();
#pragma unroll
            for (int i = 0; i < 4; ++i) if (pass == 0 || (key[i] >> (shift + 8)) == prefix) __hip_atomic_fetch_add(&hist[(key[i] >> shift) & 255], one, __ATOMIC_RELAXED, __HIP_MEMORY_SCOPE_WORKGROUP);
            __syncthreads();
            if (F.wave == 0) {
                const int c0 = hist[4 * lane], c1 = hist[4 * lane + 1], c2 = hist[4 * lane + 2], c3 = hist[4 * lane + 3]; const int t = (c0 + c1) + (c2 + c3);
                int suf = t;
#pragma unroll
                for (int o = 1; o < 64; o <<= 1) { const int v = __shfl_down(suf, o); if (lane + o < 64) suf += v; }
                int cum = suf - t;
                if (cum < k && cum + t >= k) { int d = 3;
                    if (cum + c3 >= k) d = 3; else { cum += c3; if (cum + c2 >= k) d = 2; else { cum += c2; if (cum + c1 >= k) d = 1; else { cum += c1; d = 0; } } }
                    res[0] = 4 * lane + d; res[1] = k - cum; }
            }
            __syncthreads();
            prefix = (prefix << 8) | (unsigned)res[0]; k = res[1];
        }
        int eqc = 0;
#pragma unroll
        for (int i = 0; i < 4; ++i) eqc += (key[i] == prefix) ? 1 : 0;
        int eqpre = block_excl_scan(F, eqc, wsum);
        int selc = 0; bool sel[4];
#pragma unroll
        for (int i = 0; i < 4; ++i) { const bool eq = key[i] == prefix; sel[i] = key[i] > prefix || (eq && eqpre < k); eqpre += eq ? 1 : 0; selc += sel[i] ? 1 : 0; }
        int pre = block_excl_scan(F, selc, wsum);
        if ((tid >> 8) == half) {
            int sl[4];
#pragma unroll
            for (int i = 0; i < 4; ++i) { sl[i] = -1;
                if (sel[i]) { sl[i] = pre; const int row = (e * NB + b) * CAP + pre, tok = b * SEQ + 4 * tid + i; IDX[row] = tok; GW[row] = __uint_as_float(key[i]);
                    const int p = __hip_atomic_fetch_add(cnt, 1, __ATOMIC_RELAXED, __HIP_MEMORY_SCOPE_WORKGROUP); selt[p] = tok; selr[p] = row; ++pre; } }
            *(int4*)(SLOT + (size_t)(b * NE + e) * SEQ + 4 * tid) = make_int4(sl[0], sl[1], sl[2], sl[3]);
        }
        __syncthreads();
        const int n = cnt[0];
#pragma unroll 1
        for (int i0 = 4 * F.wave; i0 < n; i0 += 4 * NWAVES) {
            v4u r[4]; float sc[4]; int row[4];
#pragma unroll
            for (int j = 0; j < 4; ++j) { const int ii = (i0 + j < n) ? i0 + j : n - 1; const int tok = selt[ii]; row[j] = selr[ii]; r[j] = ((const v4u*)(H8 + (size_t)tok * DM))[lane]; sc[j] = HS[tok]; }
#pragma unroll
            for (int j = 0; j < 4; ++j) { ((v4u*)(XIN + (size_t)row[j] * DM))[lane] = r[j]; if (lane == 0) XS[row[j]] = sc[j]; }
        }
    }
    __syncthreads();
}

struct CmbIn { f32x4 v[4]; int sl; };
__device__ __forceinline__ void cmb_load(CmbIn& I, const int t, const int lane, const bf16* x, const int* SLOT) {
    const int b = t / SEQ, s = t % SEQ; const u32x2* xr = (const u32x2*)(x + (size_t)t * DM) + lane;
#pragma unroll
    for (int j = 0; j < 4; ++j) { const u32x2 r = xr[64 * j]; I.v[j] = (f32x4){bflo(r.x), bfhi(r.x), bflo(r.y), bfhi(r.y)}; }
    I.sl = SLOT[(size_t)(b * NE + (lane & 15)) * SEQ + s];
}
__device__ __forceinline__ void cmb_add_rows(CmbIn& I, const int t, const int lane, const bf16* Y) {
    const int b = t / SEQ;
    unsigned m = (unsigned)(__ballot(I.sl >= 0) & 0xffffull);
    while (m) {
        const int e0 = __builtin_ctz(m); m &= m - 1; const int e1 = m ? __builtin_ctz(m) : e0; const bool two = m != 0; m &= m - 1;
        const int s0 = __builtin_amdgcn_readlane(I.sl, e0), s1 = __builtin_amdgcn_readlane(I.sl, e1);
        const u32x2* y0 = (const u32x2*)(Y + ((size_t)(e0 * NB + b) * CAP + s0) * DM) + lane; const u32x2* y1 = (const u32x2*)(Y + ((size_t)(e1 * NB + b) * CAP + s1) * DM) + lane;
        u32x2 a[4], c[4];
#pragma unroll
        for (int j = 0; j < 4; ++j) { a[j] = y0[64 * j]; c[j] = y1[64 * j]; }
#pragma unroll
        for (int j = 0; j < 4; ++j) { I.v[j].x += bflo(a[j].x); I.v[j].y += bfhi(a[j].x); I.v[j].z += bflo(a[j].y); I.v[j].w += bfhi(a[j].y);
            if (two) { I.v[j].x += bflo(c[j].x); I.v[j].y += bfhi(c[j].x); I.v[j].z += bflo(c[j].y); I.v[j].w += bfhi(c[j].y); } }
    }
}
__device__ __forceinline__ void cmb_finish(CmbIn& I, const int t, const int lane, bf16* x, float* outf, const float* gain, const bool final_, signed char* H8, float* HS) {
    u32x2* xr = (u32x2*)(x + (size_t)t * DM) + lane; f32x4* fr_ = (f32x4*)(outf + (size_t)t * DM) + lane; const f32x4* gr = (const f32x4*)gain + lane;
    float ss = 0.f;
#pragma unroll
    for (int j = 0; j < 4; ++j) ss += (I.v[j].x * I.v[j].x + I.v[j].y * I.v[j].y) + (I.v[j].z * I.v[j].z + I.v[j].w * I.v[j].w);
    const float rstd = rsqrtf(wave_sum(ss) * (1.f / DM) + EPS);
    if (!final_) {
#pragma unroll
        for (int j = 0; j < 4; ++j) { const f32x4 g = gr[64 * j]; u32x2 xo; xo.x = pk2(I.v[j].x, I.v[j].y); xo.y = pk2(I.v[j].z, I.v[j].w); xr[64 * j] = xo; I.v[j].x *= rstd * g.x; I.v[j].y *= rstd * g.y; I.v[j].z *= rstd * g.z; I.v[j].w *= rstd * g.w; }
        quant_row_store(I.v, H8 + (size_t)t * DM, HS + t, lane); }
    else {
#pragma unroll
        for (int j = 0; j < 4; ++j) { const f32x4 g = gr[64 * j]; f32x4 o; o.x = I.v[j].x * rstd * g.x; o.y = I.v[j].y * rstd * g.y; o.z = I.v[j].z * rstd * g.z; o.w = I.v[j].w * rstd * g.w; fr_[64 * j] = o; } }
}
__device__ __forceinline__ void phase_combine_norm(Frame& F, const Args& a, int layer) {
    unsigned char* ws = F.ws; bf16* x = (bf16*)(ws + WS_XB); const bf16* Y = (const bf16*)(ws + WS_Y); const int* SLOT = (const int*)(ws + WS_SLOT); signed char* H8 = (signed char*)(ws + WS_H); float* HS = (float*)(ws + WS_HS);
    const bool final_ = (layer + 1 == DEPTH); const float* gain = final_ ? a.in[12] : a.in[6] + (size_t)(layer + 1) * DM;
    const int gw = F.vcu * NWAVES + F.wave, NGW = F.G * NWAVES, lane = F.lane;
#pragma unroll 1
    for (int t = gw; t < T; t += 2 * NGW) {
        CmbIn A, B; const int t2 = t + NGW; const bool two = t2 < T;
        cmb_load(A, t, lane, x, SLOT); cmb_load(B, two ? t2 : t, lane, x, SLOT);
        cmb_add_rows(A, t, lane, Y); if (two) cmb_add_rows(B, t2, lane, Y);
        cmb_finish(A, t, lane, x, a.out, gain, final_, H8, HS); if (two) cmb_finish(B, t2, lane, x, a.out, gain, final_, H8, HS);
    }
}

typedef short s16x4 __attribute__((ext_vector_type(4)));
constexpr int AT_ROWB = 128;
constexpr int AT_KOFF = 0, AT_VOFF = 256 * AT_ROWB, AT_BUF = 2 * 256 * AT_ROWB;
#define LDS_BAR() do { asm volatile("s_waitcnt lgkmcnt(0)" ::: "memory"); __builtin_amdgcn_s_barrier(); asm volatile("" ::: "memory"); } while (0)
struct AttnPre { v4u k[4], v[4]; bf16x8 q0, q1; };
__device__ __forceinline__ void attn_decode(const int su, int& g, int& b, int& h, int& r, int& u, int& dsh) {
    const int x = su & 15; h = (su >> 4) & 7; b = (su >> 7) & 7; g = su >> 10; dsh = 2 * g; r = x & ((1 << dsh) - 1); u = x >> dsh;
}
__device__ __forceinline__ void attn_issue(Frame& F, const int su, const bf16* __restrict__ PROJ, AttnPre& P) {
    int g, b, h, r, u, dsh; attn_decode(su, g, b, h, r, u, dsh); const int d = 1 << dsh, L = SEQ >> dsh;
    const bf16* kbase = PROJ + PO_ATT + ((((size_t)(g * 3 + 1) * 8 + b) * 8 + h) * 2048 + (size_t)r * L) * 64;
    constexpr size_t PART = (size_t)8 * 8 * 2048 * 64;
#pragma unroll
    for (int p = 0; p < 4; ++p) { const int idx = F.tid + 512 * p, kk = idx >> 3, ch = idx & 7;
        int lp = 128 * u - 64 + kk; lp = lp < 0 ? 0 : (lp > L - 1 ? L - 1 : lp);
        const bf16* src = kbase + (size_t)lp * 64 + ch * 8;
        P.k[p] = *(const v4u*)src; P.v[p] = *(const v4u*)(src + PART); }
    const int lq = 128 * u + 16 * F.wave + (F.lane & 15);
    const bf16* qp = kbase - PART + (size_t)lq * 64 + 8 * (F.lane >> 4);
    P.q0 = *(const bf16x8*)qp; P.q1 = *(const bf16x8*)(qp + 32);
}
__device__ __forceinline__ void attn_stage(Frame& F, const AttnPre& P, const int boff) {
    LAS unsigned char* Ks = F.lds + RING_OFF + boff + AT_KOFF; LAS unsigned char* Vs = F.lds + RING_OFF + boff + AT_VOFF;
#pragma unroll
    for (int p = 0; p < 4; ++p) { const int idx = F.tid + 512 * p, kk = idx >> 3, ch = idx & 7, o = kk * AT_ROWB + ((ch ^ (kk & 7)) << 4);
        *(LAS v4u*)(Ks + o) = P.k[p]; *(LAS v4u*)(Vs + o) = P.v[p]; }
}
__device__ __forceinline__ void attn_compute(Frame& F, const int su, const bf16x8 qf0, const bf16x8 qf1, bf16* __restrict__ ATTO, float* __restrict__ LSEb, const int boff) {
    int g, b, h, r, u, dsh; attn_decode(su, g, b, h, r, u, dsh); const int d = 1 << dsh, L = SEQ >> dsh;
    const int lane = F.lane, w = F.wave, q = lane & 15, kg = lane >> 4;
    LAS unsigned char* Ks = F.lds + RING_OFF + boff + AT_KOFF; LAS unsigned char* Vs = F.lds + RING_OFF + boff + AT_VOFF;
    const int lq = 128 * u + 16 * w + q; const size_t tokq = (size_t)(b * SEQ + lq * d + r);
    f32x4 sc[9];
    {   const LAS unsigned char* kp = Ks + (16 * w + q) * AT_ROWB; const int ko0 = (kg ^ (q & 7)) << 4, ko1 = ko0 ^ 64;
#pragma unroll
        for (int hb = 0; hb < 2; ++hb) { bf16x8 kf[5][2];
#pragma unroll
            for (int i = 0; i < 5; ++i) if (5 * hb + i < 9) { kf[i][0] = *(const LAS bf16x8*)(kp + (5 * hb + i) * 16 * AT_ROWB + ko0); kf[i][1] = *(const LAS bf16x8*)(kp + (5 * hb + i) * 16 * AT_ROWB + ko1); }
            __builtin_amdgcn_sched_barrier(0);
#pragma unroll
            for (int i = 0; i < 5; ++i) if (5 * hb + i < 9) sc[5 * hb + i] = __builtin_amdgcn_mfma_f32_16x16x32_bf16(kf[i][0], qf0, (f32x4){0.f, 0.f, 0.f, 0.f}, 0, 0, 0);
#pragma unroll
            for (int i = 0; i < 5; ++i) if (5 * hb + i < 9) sc[5 * hb + i] = __builtin_amdgcn_mfma_f32_16x16x32_bf16(kf[i][1], qf1, sc[5 * hb + i], 0, 0, 0);
            __builtin_amdgcn_sched_barrier(0); } }
    const float c1 = 0.125f * 1.4426950408889634f, c2 = __builtin_amdgcn_exp2f(-(float)(h + 1)) * (float)d * 1.4426950408889634f;
    float ce[4], ae[4]; bool ge0[4], le0[4];
#pragma unroll
    for (int rr = 0; rr < 4; ++rr) { const int e = 4 * kg + rr - q; ce[rr] = c2 * (float)e; ae[rr] = -c2 * (float)(e < 0 ? -e : e); ge0[rr] = e >= 0; le0[rr] = e <= 0; }
    float mx = -INFINITY;
#pragma unroll
    for (int i = 0; i < 9; ++i) { const bool ok = (unsigned)(128 * u - 64 + 16 * (w + i)) < (unsigned)L;
        const float ki = -c2 * (float)(i < 4 ? 64 - 16 * i : 16 * i - 64);
#pragma unroll
        for (int rr = 0; rr < 4; ++rr) { float v = (i < 4) ? (sc[i][rr] * c1 + ce[rr]) + ki : (i == 4) ? sc[i][rr] * c1 + ae[rr] : (sc[i][rr] * c1 - ce[rr]) + ki;
            bool val = ok; if (i == 0) val = val && ge0[rr]; if (i == 8) val = val && le0[rr];
            v = val ? v : -INFINITY; sc[i][rr] = v; mx = fmaxf(mx, v); } }
    mx = fmaxf(mx, __shfl_xor(mx, 16)); mx = fmaxf(mx, __shfl_xor(mx, 32));
    float sum = 0.f; s16x4 pf[9];
#pragma unroll
    for (int i = 0; i < 9; ++i) { const float p0 = __builtin_amdgcn_exp2f(sc[i][0] - mx), p1 = __builtin_amdgcn_exp2f(sc[i][1] - mx), p2 = __builtin_amdgcn_exp2f(sc[i][2] - mx), p3 = __builtin_amdgcn_exp2f(sc[i][3] - mx);
        sum += (p0 + p1) + (p2 + p3); const unsigned lo = pk2(p0, p1), hi = pk2(p2, p3);
        pf[i] = (s16x4){(short)(lo & 0xffff), (short)(lo >> 16), (short)(hi & 0xffff), (short)(hi >> 16)}; }
    sum += __shfl_xor(sum, 16); sum += __shfl_xor(sum, 32);
    const float inv = 1.f / sum;
    const LAS unsigned char* vp = Vs + (16 * w + 4 * kg + (q >> 2)) * AT_ROWB + 8 * (q & 1); const int vm = (4 * kg + (q >> 2)) & 7, vc = (q & 3) >> 1;
    bf16* op = ATTO + ((size_t)g * T + tokq) * AW + h * 64 + 4 * kg;
#pragma unroll
    for (int dh = 0; dh < 2; ++dh) { s16x4 vf[2][9];
#pragma unroll
        for (int dd = 0; dd < 2; ++dd)
#pragma unroll
            for (int i = 0; i < 9; ++i) vf[dd][i] = __builtin_bit_cast(s16x4, __builtin_amdgcn_ds_read_tr16_b64_v4i16((LAS s16x4*)(vp + i * 16 * AT_ROWB + (((2 * (2 * dh + dd) + vc) ^ vm) << 4))));
        __builtin_amdgcn_sched_barrier(0);
        f32x4 acc[2] = {{0.f, 0.f, 0.f, 0.f}, {0.f, 0.f, 0.f, 0.f}};
#pragma unroll
        for (int i = 0; i < 9; ++i) { acc[0] = __builtin_amdgcn_mfma_f32_16x16x16bf16_1k(vf[0][i], pf[i], acc[0], 0, 0, 0); acc[1] = __builtin_amdgcn_mfma_f32_16x16x16bf16_1k(vf[1][i], pf[i], acc[1], 0, 0, 0); }
#pragma unroll
        for (int dd = 0; dd < 2; ++dd) { u32x2 o; o.x = pk2(acc[dd][0] * inv, acc[dd][1] * inv); o.y = pk2(acc[dd][2] * inv, acc[dd][3] * inv);
            *(u32x2*)(op + 16 * (2 * dh + dd)) = o; } }
    if (kg == 0) LSEb[((size_t)g * T + tokq) * 8 + h] = (mx + __log2f(sum)) * 0.6931471805599453f;
}
__device__ __forceinline__ void phase_attn(Frame& F, const Args& a, const int layer, const bool dyn) {
    unsigned char* ws = F.ws; const bf16* PROJ = (const bf16*)(ws + WS_PROJ);
    constexpr int NSU = 3 * NB * 8 * 16;
    AttnPre P;
    bf16x8 qc0, qc1;
    if (dyn) {
        constexpr int NQ = 3 * 8 * 16;
        GAS unsigned* qg = (GAS unsigned*)F.ctl; asm volatile("" : "+s"(qg)); unsigned* qctr = (unsigned*)qg + CW_AQ + 64 * (unsigned)__builtin_amdgcn_readfirstlane((int)F.MISC[3]) + layer;
        const int xb = F.vcu >> 5; volatile LAS unsigned* aq = F.MISC + 32;
        auto su_of = [&](int li) { return ((li >> 7) << 10) | (xb << 7) | (li & 127); };
        if (F.tid == 0) { aq[0] = xb_add(qctr, 1u); aq[1] = xb_add(qctr, 1u); aq[2] = xb_add(qctr, 1u); }
        __syncthreads();
        int u0 = __builtin_amdgcn_readfirstlane((int)aq[0]), u1 = __builtin_amdgcn_readfirstlane((int)aq[1]), u2 = __builtin_amdgcn_readfirstlane((int)aq[2]);
        if (u0 < NQ) { attn_issue(F, su_of(u0), PROJ, P); attn_stage(F, P, 0); qc0 = P.q0; qc1 = P.q1; if (u1 < NQ) attn_issue(F, su_of(u1), PROJ, P); }
        LDS_BAR();
#pragma unroll 1
        for (int par = 0; u0 < NQ; par ^= 1) {
            unsigned f = (unsigned)NQ; if (F.tid == 0 && u2 < NQ) f = xb_add(qctr, 1u);
            bf16x8 qn0 = qc0, qn1 = qc1;
            if (u1 < NQ) { attn_stage(F, P, (par ^ 1) * AT_BUF); qn0 = P.q0; qn1 = P.q1; if (u2 < NQ) attn_issue(F, su_of(u2), PROJ, P); }
            attn_compute(F, su_of(u0), qc0, qc1, (bf16*)(ws + WS_ATTO), (float*)(ws + WS_LSE), par * AT_BUF);
            if (F.tid == 0) aq[4 + par] = f;
            LDS_BAR();
            const int u3 = __builtin_amdgcn_readfirstlane((int)aq[4 + par]);
            u0 = u1; u1 = u2; u2 = u3; qc0 = qn0; qc1 = qn1;
        }
        __syncthreads();
        return;
    }
    if (F.vcu < NSU) { attn_issue(F, F.vcu, PROJ, P); attn_stage(F, P, 0); qc0 = P.q0; qc1 = P.q1; if (F.vcu + F.G < NSU) attn_issue(F, F.vcu + F.G, PROJ, P); }
    LDS_BAR();
#pragma unroll 1
    for (int su = F.vcu, par = 0; su < NSU; su += F.G, par ^= 1) {
        bf16x8 qn0 = qc0, qn1 = qc1;
        if (su + F.G < NSU) { attn_stage(F, P, (par ^ 1) * AT_BUF); qn0 = P.q0; qn1 = P.q1;
            if (su + 2 * F.G < NSU) attn_issue(F, su + 2 * F.G, PROJ, P); }
        attn_compute(F, su, qc0, qc1, (bf16*)(ws + WS_ATTO), (float*)(ws + WS_LSE), par * AT_BUF);
        LDS_BAR();
        qc0 = qn0; qc1 = qn1;
    }
    __syncthreads();
}
constexpr int RT_ROWB = 528, RT_ROWS = 144, RT_KB = 64 * RT_ROWB, RT_VB = 64 * RT_ROWS;
constexpr int RT_K = 0, RT_S = 2 * RT_KB, RT_V = 3 * RT_KB, RT_P = RT_V + 2 * RT_VB, RT_END = RT_P + RT_VB;
static_assert(RT_END <= RING_BYTES, "retention LDS map");
__device__ __forceinline__ void ret_unit(Frame& F, const int unit, const bf16* __restrict__ PROJ, const float* __restrict__ dlog, bf16* __restrict__ YF, bf16* __restrict__ YB) {
    const int dvs = unit & 3, dir = (unit >> 2) & 1, h = (unit >> 3) & 3, b = unit >> 5;
    const int tid = F.tid, lane = F.lane, w = F.wave, fr = lane & 15, kg = lane >> 4;
    LAS unsigned char* L0 = F.lds + RING_OFF;
    const float lg = -log1pf(expf(-dlog[dir * 4 + h]));
    const float gC = __expf(lg * 64.f);
    const int srow = tid >> 5, sch = tid & 31, vrow = tid >> 3, vch = tid & 7;
    float zeta[4];
#pragma unroll
    for (int p = 0; p < 4; ++p) { const int m = srow + 16 * p; zeta[p] = __expf(lg * (float)(dir ? m : 63 - m)); }
    const int qt = w >> 1, half = w & 1;
    const int nq = 16 * qt + fr;
    const float rho = __expf(lg * (float)(dir ? -nq : nq - 63)) * 0.0625f;
    const bf16* qbase = PROJ + PO_RQK + ((size_t)(b * 4 + h) * 2048 + nq) * 256 + 8 * kg;
    const bf16* colk = PROJ + PO_RQK + (size_t)T * RW + ((size_t)(b * 4 + h) * 2048) * 256 + sch * 8; const bf16* colv = PROJ + PO_RV + (((size_t)(b * 4 + h) * 4 + dvs) * 2048) * 64 + vch * 8;
    bf16* Yo = (dir ? YB : YF) + h * 256 + dvs * 64;
    __syncthreads();
    { unsigned z = 0u; asm volatile("" : "+v"(z));
      for (int i = tid; i < 64 * RT_ROWB / 16; i += NWAVES * 64) ((LAS v4u*)(L0 + RT_S))[i] = (v4u){z, z, z, z}; }
    f32x4 st[2][4];
#pragma unroll
    for (int a = 0; a < 2; ++a)
#pragma unroll
        for (int c = 0; c < 4; ++c) st[a][c] = (f32x4){0.f, 0.f, 0.f, 0.f};
    v4u pk[4], pv; bf16x8 qc[8], qn[8];
#define RET_LOADKV(ci_) do { const size_t t0_ = (size_t)64 * (ci_); _Pragma("unroll") for (int p = 0; p < 4; ++p) pk[p] = *(const v4u*)(colk + (t0_ + srow + 16 * p) * 256); pv = *(const v4u*)(colv + (t0_ + vrow) * 64); } while (0)
#define RET_LOADQ(dst, ci_) do { const bf16* qg_ = qbase + ((size_t)64 * (ci_)) * 256; _Pragma("unroll") for (int s = 0; s < 8; ++s) dst[s] = *(const bf16x8*)(qg_ + 32 * s); } while (0)
#define RET_STAGE(bf_) do { LAS unsigned char* kb_ = L0 + RT_K + (bf_) * RT_KB; _Pragma("unroll") for (int p = 0; p < 4; ++p) { const int row = srow + 16 * p; const float z = zeta[p]; v4u kk = pk[p]; \
            kk.x = pk2(bflo(kk.x) * z, bfhi(kk.x) * z); kk.y = pk2(bflo(kk.y) * z, bfhi(kk.y) * z); kk.z = pk2(bflo(kk.z) * z, bfhi(kk.z) * z); kk.w = pk2(bflo(kk.w) * z, bfhi(kk.w) * z); \
            *(LAS v4u*)(kb_ + row * RT_ROWB + sch * 16) = kk; } \
        LAS unsigned short* vt = (LAS unsigned short*)(L0 + RT_V + (bf_) * RT_VB) + vrow; \
        vt[(8 * vch + 0) * 72] = (unsigned short)(pv.x & 0xffff); vt[(8 * vch + 1) * 72] = (unsigned short)(pv.x >> 16); \
        vt[(8 * vch + 2) * 72] = (unsigned short)(pv.y & 0xffff); vt[(8 * vch + 3) * 72] = (unsigned short)(pv.y >> 16); \
        vt[(8 * vch + 4) * 72] = (unsigned short)(pv.z & 0xffff); vt[(8 * vch + 5) * 72] = (unsigned short)(pv.z >> 16); \
        vt[(8 * vch + 6) * 72] = (unsigned short)(pv.w & 0xffff); vt[(8 * vch + 7) * 72] = (unsigned short)(pv.w >> 16); } while (0)
    {   const int cf = dir ? 31 : 0, cs = dir ? 30 : 1;
        RET_LOADKV(cf); RET_LOADQ(qc, cf); RET_STAGE(0); RET_LOADKV(cs); }
    LDS_BAR();
#pragma unroll 1
    for (int step = 0; step < 32; ++step) {
        const int ci = dir ? 31 - step : step, cur = step & 1;
        const LAS unsigned char* Kc = L0 + RT_K + cur * RT_KB; const LAS unsigned char* Vc = L0 + RT_V + cur * RT_VB;
        if (step + 1 < 32) { RET_STAGE(cur ^ 1); if (step + 2 < 32) RET_LOADKV(dir ? ci - 2 : ci + 2); RET_LOADQ(qn, dir ? ci - 1 : ci + 1); }
        {   bf16x8 kf[2][8];
            const LAS unsigned char* kp = Kc + (32 * half + fr) * RT_ROWB + 16 * kg;
#pragma unroll
            for (int s = 0; s < 8; ++s) { kf[0][s] = *(const LAS bf16x8*)(kp + 64 * s); kf[1][s] = *(const LAS bf16x8*)(kp + 16 * RT_ROWB + 64 * s); }
            f32x4 acc[2] = {{0.f, 0.f, 0.f, 0.f}, {0.f, 0.f, 0.f, 0.f}};
#pragma unroll
            for (int s = 0; s < 8; ++s) { acc[0] = __builtin_amdgcn_mfma_f32_16x16x32_bf16(kf[0][s], qc[s], acc[0], 0, 0, 0); acc[1] = __builtin_amdgcn_mfma_f32_16x16x32_bf16(kf[1][s], qc[s], acc[1], 0, 0, 0); }
#pragma unroll
            for (int j = 0; j < 2; ++j) { const int m0 = 32 * half + 16 * j + 4 * kg;
                float p0 = acc[j][0], p1 = acc[j][1], p2 = acc[j][2], p3 = acc[j][3];
                if (dir) { p0 = (m0 + 0 > nq) ? p0 : 0.f; p1 = (m0 + 1 > nq) ? p1 : 0.f; p2 = (m0 + 2 > nq) ? p2 : 0.f; p3 = (m0 + 3 > nq) ? p3 : 0.f; }
                else     { p0 = (m0 + 0 <= nq) ? p0 : 0.f; p1 = (m0 + 1 <= nq) ? p1 : 0.f; p2 = (m0 + 2 <= nq) ? p2 : 0.f; p3 = (m0 + 3 <= nq) ? p3 : 0.f; }
                u32x2 o; o.x = pk2(p0, p1); o.y = pk2(p2, p3);
                *(LAS u32x2*)(L0 + RT_P + nq * RT_ROWS + m0 * 2) = o; } }
        {   bf16x8 vf[4][2], kf[2][2];
#pragma unroll
            for (int c = 0; c < 4; ++c)
#pragma unroll
                for (int s = 0; s < 2; ++s) vf[c][s] = *(const LAS bf16x8*)(Vc + (16 * c + fr) * RT_ROWS + 64 * s + 16 * kg);
#pragma unroll
            for (int a = 0; a < 2; ++a)
#pragma unroll
                for (int s = 0; s < 2; ++s) {
                    const LAS unsigned char* tp = Kc + (32 * s + 8 * kg + (fr >> 2)) * RT_ROWB + (16 * (2 * w + a) + 4 * (fr & 3)) * 2;
                    const s16x4 lo = __builtin_bit_cast(s16x4, __builtin_amdgcn_ds_read_tr16_b64_v4i16((LAS s16x4*)tp));
                    const s16x4 hi = __builtin_bit_cast(s16x4, __builtin_amdgcn_ds_read_tr16_b64_v4i16((LAS s16x4*)(tp + 4 * RT_ROWB)));
                    kf[a][s] = (bf16x8){lo[0], lo[1], lo[2], lo[3], hi[0], hi[1], hi[2], hi[3]}; }
            __builtin_amdgcn_sched_barrier(0);
#pragma unroll
            for (int s = 0; s < 2; ++s)
#pragma unroll
                for (int a = 0; a < 2; ++a)
#pragma unroll
                    for (int c = 0; c < 4; ++c) st[a][c] = __builtin_amdgcn_mfma_f32_16x16x32_bf16(kf[a][s], vf[c][s], st[a][c], 0, 0, 0); }
        LDS_BAR();
        {   bf16x8 pf[2], vf[2][2];
            const LAS unsigned char* pp = L0 + RT_P + (16 * qt + fr) * RT_ROWS + 16 * kg; pf[0] = *(const LAS bf16x8*)pp; pf[1] = *(const LAS bf16x8*)(pp + 64);
            const LAS unsigned char* vp = Vc + (32 * half + fr) * RT_ROWS + 16 * kg;
            const LAS unsigned char* sp = L0 + RT_S + (32 * half + fr) * RT_ROWB + 16 * kg;
#pragma unroll
            for (int j = 0; j < 2; ++j) { vf[j][0] = *(const LAS bf16x8*)(vp + j * 16 * RT_ROWS); vf[j][1] = *(const LAS bf16x8*)(vp + j * 16 * RT_ROWS + 64); }
            f32x4 acc[2] = {{0.f, 0.f, 0.f, 0.f}, {0.f, 0.f, 0.f, 0.f}};
#pragma unroll
            for (int hs = 0; hs < 2; ++hs) { bf16x8 sf[2][4];
#pragma unroll
                for (int s = 0; s < 4; ++s) { sf[0][s] = *(const LAS bf16x8*)(sp + 64 * (4 * hs + s)); sf[1][s] = *(const LAS bf16x8*)(sp + 16 * RT_ROWB + 64 * (4 * hs + s)); }
                __builtin_amdgcn_sched_barrier(0);
                if (hs == 0) {
#pragma unroll
                    for (int s = 0; s < 2; ++s) { acc[0] = __builtin_amdgcn_mfma_f32_16x16x32_bf16(vf[0][s], pf[s], acc[0], 0, 0, 0); acc[1] = __builtin_amdgcn_mfma_f32_16x16x32_bf16(vf[1][s], pf[s], acc[1], 0, 0, 0); } }
#pragma unroll
                for (int s = 0; s < 4; ++s) { acc[0] = __builtin_amdgcn_mfma_f32_16x16x32_bf16(sf[0][s], qc[4 * hs + s], acc[0], 0, 0, 0); acc[1] = __builtin_amdgcn_mfma_f32_16x16x32_bf16(sf[1][s], qc[4 * hs + s], acc[1], 0, 0, 0); }
                __builtin_amdgcn_sched_barrier(0); }
            const size_t tok = (size_t)b * SEQ + 64 * ci + nq;
#pragma unroll
            for (int j = 0; j < 2; ++j) { u32x2 o; o.x = pk2(acc[j][0] * rho, acc[j][1] * rho); o.y = pk2(acc[j][2] * rho, acc[j][3] * rho);
                *(u32x2*)(Yo + tok * RW + 16 * (2 * half + j) + 4 * kg) = o; } }
        LDS_BAR();
#pragma unroll
        for (int a = 0; a < 2; ++a)
#pragma unroll
            for (int c = 0; c < 4; ++c) { st[a][c] *= gC; u32x2 o; o.x = pk2(st[a][c][0], st[a][c][1]); o.y = pk2(st[a][c][2], st[a][c][3]);
                *(LAS u32x2*)(L0 + RT_S + (16 * c + fr) * RT_ROWB + (16 * (2 * w + a) + 4 * kg) * 2) = o; }
        if (step + 1 < 32) {
#pragma unroll
            for (int s = 0; s < 8; ++s) qc[s] = qn[s]; }
    }
#undef RET_LOADKV
#undef RET_LOADQ
#undef RET_STAGE
    __syncthreads();
}
__device__ __forceinline__ void phase_mix(Frame& F, const Args& a, int layer) {
    unsigned char* ws = F.ws; const bf16* PROJ = (const bf16*)(ws + WS_PROJ);
#ifndef REP_RET
#define REP_RET 1
#define REP_ATTN 1
#endif
#pragma unroll 1
    for (int rr = 0; rr < REP_RET; ++rr)
#pragma unroll 1
    for (int unit = F.vcu; unit < NB * 4 * 4 * 2; unit += F.G) ret_unit(F, unit, PROJ, a.in[5] + layer * 8, (bf16*)(ws + WS_YF), (bf16*)(ws + WS_YB));
    const bool dyn = __builtin_amdgcn_readfirstlane((int)F.MISC[2]) != 0 && F.G == 256 && REP_MASK == 0 && REP_RET == 1 && REP_ATTN == 1;
#pragma unroll 1
    for (int rr = 0; rr < REP_ATTN; ++rr) phase_attn(F, a, layer, dyn);
}


constexpr int popc10(int m) { int c = 0; for (int k = 0; k < 10; ++k) c += (m >> k) & 1; return c; }
constexpr int REP0 = (REP_MASK >> 10) & 1, SLOTS_LAYER = NPH_LAYER + popc10(REP_MASK), NSLOTS = 1 + REP0 + DEPTH * SLOTS_LAYER;
__device__ __forceinline__ int slot_phase(int slot) {
#if REP_MASK
    if (slot <= REP0) return 0;
    const int s = slot - 1 - REP0, layer = s / SLOTS_LAYER; int j = s % SLOTS_LAYER, k = 0;
    for (;;) { const int n = 1 + ((REP_MASK >> k) & 1); if (j < n) break; j -= n; ++k; }
    return 1 + layer * NPH_LAYER + k;
#else
    return slot;
#endif
}
__global__ void __launch_bounds__(NWAVES * 64, 2) mega(Args args) {
    extern __shared__ __attribute__((aligned(16))) unsigned char lds[];
    Frame F;
    F.lds = (LAS unsigned char*)lds; F.MISC = (volatile LAS unsigned*)(F.lds + MISC_OFF);
    F.tid = threadIdx.x; F.lane = F.tid & 63; F.wave = __builtin_amdgcn_readfirstlane(F.tid >> 6);
    F.G = gridDim.x;
    unsigned char* ws = args.ws; F.ctl = (unsigned*)(ws + WS_CTL);
    for (int u = F.tid; u < (LDS_BYTES - LDSCTL_OFF) / 4; u += NWAVES * 64) ((LAS unsigned*)(F.lds + LDSCTL_OFF))[u] = 0u;
    __syncthreads();
    if (F.tid == 0) {
        unsigned* cen = F.ctl + CW_CENSUS; const unsigned x = xb_xcc_id(); const unsigned slot = xb_add(&cen[64 * x], 1u);
        unsigned cnt[16]; unsigned sum = 0, sp = 0;
        for (;;) { sum = 0;
#pragma unroll
            for (int j = 0; j < 16; ++j) { cnt[j] = xb_ld(&cen[64 * j]); sum += cnt[j]; }
            if (sum == (unsigned)F.G || ++sp > (1u << 20)) break; __builtin_amdgcn_s_sleep(1); }
        unsigned pop = 0, ord = 0; bool even = (sum == (unsigned)F.G) && (F.G % 8 == 0);
#pragma unroll
        for (int j = 0; j < 16; ++j) { if (cnt[j]) { ++pop; if ((unsigned)j < x) ++ord; if (cnt[j] != (unsigned)F.G / 8) even = false; } }
        even = even && pop == 8;
        F.MISC[0] = even ? slot * 8 + ord : blockIdx.x;
        F.MISC[1] = even ? ord * (F.G / 8) + slot : blockIdx.x;
        F.MISC[2] = even ? 1u : 0u; F.MISC[3] = x;
    }
    __syncthreads();
    const int cid0 = __builtin_amdgcn_readfirstlane((int)F.MISC[0]), vcu0 = __builtin_amdgcn_readfirstlane((int)F.MISC[1]); F.cid = cid0; F.vcu = vcu0;
    const bool multi = !USE_CG_SYNC && (args.ph_hi - args.ph_lo) > 1;
    XcdBarrier bar; bar.bar = F.ctl + CW_BAR; bar.x = 0; bar.st = nullptr;
    if (multi) bar = xcd_barrier_post(F.ctl + CW_BAR, F.MISC + 8);
#pragma unroll 1
    for (int slot = args.ph_lo; slot < args.ph_hi; ++slot) {
        const int ph = slot_phase(slot);
        GAS unsigned char* wsg = (GAS unsigned char*)args.ws; asm volatile("" : "+s"(wsg)); unsigned char* ws = (unsigned char*)wsg; F.ws = ws;
        { int v_ = vcu0, c_ = cid0, g_ = (int)gridDim.x; asm volatile("" : "+s"(v_), "+s"(c_), "+s"(g_)); F.vcu = v_; F.cid = c_; F.G = g_; }
        { int tid_ = threadIdx.x; asm volatile("" : "+v"(tid_)); F.tid = tid_; F.lane = tid_ & 63; F.wave = __builtin_amdgcn_readfirstlane(tid_ >> 6); }
        {
        if (ph == 0) phase_p0(F, args);
        else {
            const int layer = (ph - 1) / NPH_LAYER, k = (ph - 1) % NPH_LAYER;
            if (k == 0) {
                pg8::Gemm g{(const pg8::bf16_t*)(ws + WS_H), (const pg8::bf16_t*)(ws + WS_WIN) + (size_t)layer * NIN * (DM / 2), T, NIN, DM / 2, 30, 0}; pg8::StaticOrder S; S.init(T, NIN, F.G, F.cid);
                pg8::EpiStoreI8 E{(pg8::bf16_t*)(ws + WS_PROJ), NIN, (const float*)(ws + WS_HS), (const float*)(ws + WS_WINS) + (size_t)layer * NIN};
                if (__builtin_amdgcn_readfirstlane((int)F.MISC[2]) != 0 && F.G == 256 && REP_MASK == 0 && REP_RET == 1 && REP_ATTN == 1) { GAS unsigned* cp = (GAS unsigned*)F.ctl; asm volatile("" : "+s"(cp));
                    S.sync_ui = 8; S.sctl = (unsigned*)cp; S.sx = (unsigned)__builtin_amdgcn_readfirstlane((int)F.MISC[3]); S.snloc = (unsigned)F.G / 8u; S.stmo = (unsigned*)cp + CW_BAR; }
                pg8::gemm_phase<pg8::EpiStoreI8, pg8::StaticOrder, true, true, 1>(F.lds + RING_OFF, g, S, E, F.tid);
            } else if (k == 1) phase_mix(F, args, layer); else if (k == 2) phase_finalize(F, args);
            else if (k == 3) {
                pg8::Gemm g{(const pg8::bf16_t*)(ws + WS_CAT), (const pg8::bf16_t*)(ws + WS_WCAT + (size_t)layer * DM * CATW), T, DM, CATW / 2, 30, 0}; pg8::StaticOrder S; S.init(T, DM, F.G, F.cid);
                pg8::EpiMerge E{(const pg8::bf16_t*)(ws + WS_PROJ), (pg8::bf16_t*)(ws + WS_MERGED), 1.f / 1024.f};
                pg8::gemm_phase<pg8::EpiMerge, pg8::StaticOrder, true, true, 2>(F.lds + RING_OFF, g, S, E, F.tid);
            } else if (k == 4) {
                pg8::Gemm g{(const pg8::bf16_t*)(ws + WS_MERGED), (const pg8::bf16_t*)(ws + WS_WO) + (size_t)layer * DM * DM, T, DM, DM, 30, 0}; pg8::StaticOrder S; S.init(T, DM, F.G, F.cid);
                if (layer == 0) { pg8::EpiResidB<true> E{(const void*)args.in[0], (pg8::bf16_t*)(ws + WS_XB), 1.f}; pg8::gemm_phase<pg8::EpiResidB<true>, pg8::StaticOrder, true, true>(F.lds + RING_OFF, g, S, E, F.tid); }
                else { pg8::EpiResidB<false> E{(const void*)(ws + WS_XB), (pg8::bf16_t*)(ws + WS_XB), 1.f}; pg8::gemm_phase<pg8::EpiResidB<false>, pg8::StaticOrder, true, true>(F.lds + RING_OFF, g, S, E, F.tid); }
            } else if (k == 5) phase_norm_router(F, args, layer);
            else if (k == 6) phase_topk(F, args);
            else if (k == 7) {
                pg8::Gemm g{(const pg8::bf16_t*)(ws + WS_XIN), (const pg8::bf16_t*)(ws + WS_WGU) + (size_t)layer * NE * 2 * FF * (DM / 2), NROWS_E, 2 * FF, DM / 2, 3, (size_t)2 * FF * DM}; pg8::StaticOrder S; S.init(NROWS_E, 2 * FF, F.G, F.cid);
                pg8::EpiSwigluI8 E{(pg8::bf16_t*)(ws + WS_ACT), (const float*)(ws + WS_XS), (const float*)(ws + WS_WGUS) + (size_t)layer * NE * 2 * FF, 1};
                pg8::gemm_phase<pg8::EpiSwigluI8, pg8::StaticOrder, true, true, 1>(F.lds + RING_OFF, g, S, E, F.tid);
            } else if (k == 8) {
                pg8::StaticOrder S; S.init(NROWS_E, DM, F.G, F.cid);
                {   pg8::Gemm g{(const pg8::bf16_t*)(ws + WS_ACT), (const pg8::bf16_t*)(ws + WS_WDN + (size_t)layer * NE * DM * FF), NROWS_E, DM, FF / 2, 3, (size_t)DM * FF};
                    pg8::EpiDown E{(const float*)(ws + WS_GW), (pg8::bf16_t*)(ws + WS_Y), 1.f / 1024.f};
                    pg8::gemm_phase<pg8::EpiDown, pg8::StaticOrder, true, true, 2>(F.lds + RING_OFF, g, S, E, F.tid); }
            } else phase_combine_norm(F, args, layer);
        }
        }
        const int kk_ = (ph - 1) % NPH_LAYER; const bool local_seam = __builtin_amdgcn_readfirstlane((int)F.MISC[2]) != 0 && ph > 0 && (kk_ == 3 || kk_ == 4 || kk_ == 5 || kk_ == 7) && slot + 1 < args.ph_hi && slot_phase(slot + 1) == ph + 1;
        const bool no_seam = ph > 0 && kk_ == 0 && __builtin_amdgcn_readfirstlane((int)F.MISC[2]) != 0 && F.G == 256 && REP_MASK == 0 && REP_RET == 1 && REP_ATTN == 1;
        if (slot + 1 < args.ph_hi && !no_seam) { if (USE_CG_SYNC || slot - args.ph_lo < args.cg_seams) cooperative_groups::this_grid().sync(); else if (local_seam) { GAS unsigned* cp = (GAS unsigned*)F.ctl; asm volatile("" : "+s"(cp)); xcc_local_barrier((unsigned*)cp, (unsigned)__builtin_amdgcn_readfirstlane((int)F.MISC[3]), (unsigned)F.G / 8u, (unsigned*)cp + CW_BAR); } else { XcdBarrier bb = bar; GAS unsigned* bp = (GAS unsigned*)bb.bar; asm volatile("" : "+s"(bp)); bb.bar = (unsigned*)bp; xcd_barrier(bb); } }
    }
}


extern "C" void kernel_launch(void* const* d_in, const int* in_sizes, int n_in, void* d_out, int out_size, void* d_ws, size_t ws_size, hipStream_t stream) {
    static int grid = 0;
    if (grid == 0) {
        if (n_in != 13 || in_sizes[0] != T * DM || out_size != T * DM || ws_size < WS_END) { fprintf(stderr, "kernel_launch: unexpected shapes (n_in %d, ws %zu)\n", n_in, ws_size); grid = -1; return; }
        if (hipFuncSetAttribute((const void*)mega, hipFuncAttributeMaxDynamicSharedMemorySize, LDS_BYTES) != hipSuccess) { fprintf(stderr, "kernel_launch: hipFuncSetAttribute failed\n"); grid = -1; return; }
        int dev = 0, cus = 0, per_cu = 0;
        if (hipGetDevice(&dev) != hipSuccess || hipDeviceGetAttribute(&cus, hipDeviceAttributeMultiprocessorCount, dev) != hipSuccess) { grid = -1; return; }
        if (hipOccupancyMaxActiveBlocksPerMultiprocessor(&per_cu, (const void*)mega, NWAVES * 64, LDS_BYTES) != hipSuccess || per_cu < 1) { fprintf(stderr, "kernel_launch: occupancy query says %d blocks per CU; nothing launched\n", per_cu); grid = -1; return; }
        (void)hipGetLastError();
        grid = cus;
    }
    if (grid < 0) return;
    unsigned char* ws = (unsigned char*)d_ws;
    hipMemsetAsync(ws + WS_CTL, 0, CTL_ZERO_BYTES, stream);
    Args a{};
    for (int i = 0; i < 13; ++i) a.in[i] = (const float*)d_in[i];
    a.out = (float*)d_out; a.ws = ws; a.ph_lo = 0; a.ph_hi = NSLOTS; a.cg_seams = 0; a.pad = 0;
    void* kargs[] = {&a};
    hipError_t e = hipLaunchCooperativeKernel((const void*)mega, dim3(grid), dim3(NWAVES * 64), kargs, LDS_BYTES, stream);
    if (e != hipSuccess) fprintf(stderr, "kernel_launch: cooperative launch failed: %s (grid %d)\n", hipGetErrorString(e), grid);
}
```

```cpp
#include <hip/hip_runtime.h>
#include <hip/hip_cooperative_groups.h>
#include <cstdio>
#include <cstdint>

constexpr int NB = 8, SEQ = 2048, DM = 1024, T = NB * SEQ, DEPTH = 2;
constexpr int NIN = 10752, ATTN_IN = 4608, AW = 512, RW = 1024, CATW = AW + RW;
constexpr int OFF_RQ = 4608, OFF_RK = 5632, OFF_RV = 6656, OFF_RG = 7680, OFF_GA = 8704, OFF_GR = 9728;
constexpr int NE = 16, FF = 2048, CAP = 256, NROWS_E = NB * NE * CAP;
constexpr float EPS = 1e-6f;

constexpr size_t PO_ATT = 0, PO_RQK = (size_t)9 * T * AW, PO_RV = PO_RQK + (size_t)2 * T * RW, PO_RG = PO_RV + (size_t)T * RW, PO_GATE = PO_RG + (size_t)T * RW, PO_END = PO_GATE + (size_t)2 * T * DM;
static_assert(PO_END == (size_t)T * NIN, "split projection layout covers the PROJ region exactly");
struct ProjCol { size_t base; unsigned bstride, pitch; int dsh; };
__host__ __device__ __forceinline__ ProjCol proj_col(int c) {
    ProjCol p;
    if (c < 4608) { const int g = c / 1536, r = c - g * 1536, which = r >> 9, h = (r >> 6) & 7, dc = r & 63; p.base = PO_ATT + (((size_t)(g * 3 + which) * 64 + h) * 2048) * 64 + dc; p.bstride = 8u * 2048u * 64u; p.pitch = 64; p.dsh = 2 * g; }
    else if (c < 6656) { const int r = c - 4608, which = r >> 10, h = (r >> 8) & 3, dk = r & 255; p.base = PO_RQK + (((size_t)which * 32 + h) * 2048) * 256 + dk; p.bstride = 4u * 2048u * 256u; p.pitch = 256; p.dsh = 0; }
    else if (c < 7680) { const int r = c - 6656, h = r >> 8, dvs = (r >> 6) & 3, dv = r & 63; p.base = PO_RV + (((size_t)h * 4 + dvs) * 2048) * 64 + dv; p.bstride = 16u * 2048u * 64u; p.pitch = 64; p.dsh = 0; }
    else if (c < 8704) { p.base = PO_RG + (c - 7680); p.bstride = 2048u * 1024u; p.pitch = 1024; p.dsh = 0; }
    else { p.base = PO_GATE + (c - 8704); p.bstride = 2048u * 2048u; p.pitch = 2048; p.dsh = 0; }
    return p;
}
__host__ __device__ __forceinline__ size_t proj_row(const ProjCol& p, int t) {
    const unsigned b = (unsigned)t >> 11, s = (unsigned)t & 2047u, sp = ((s & ((1u << p.dsh) - 1u)) << (11 - p.dsh)) | (s >> p.dsh);
    return p.base + (size_t)b * p.bstride + (size_t)sp * p.pitch;
}
__host__ __device__ __forceinline__ size_t proj_off(int t, int c) {
    const int b = t >> 11, s = t & 2047;
    if (c < 4608) { const int g = c / 1536, r = c - g * 1536, which = r >> 9, h = (r >> 6) & 7, dc = r & 63, dsh = 2 * g;
        const int perm = ((s & ((1 << dsh) - 1)) << (11 - dsh)) | (s >> dsh);
        return PO_ATT + ((((size_t)(g * 3 + which) * 8 + b) * 8 + h) * 2048 + perm) * 64 + dc; }
    if (c < 6656) { const int r = c - 4608, which = r >> 10, h = (r >> 8) & 3, dk = r & 255; return PO_RQK + ((((size_t)which * 8 + b) * 4 + h) * 2048 + s) * 256 + dk; }
    if (c < 7680) { const int r = c - 6656, h = r >> 8, dvs = (r >> 6) & 3, dv = r & 63; return PO_RV + ((((size_t)b * 4 + h) * 4 + dvs) * 2048 + s) * 64 + dv; }
    if (c < 8704) return PO_RG + (size_t)t * 1024 + (c - 7680);
    return PO_GATE + (size_t)t * 2048 + (c - 8704);
}

constexpr size_t MiB = 1u << 20;
constexpr size_t WS_CTL = 0;
constexpr size_t WS_WIN = 1 * MiB;
constexpr size_t WS_WCAT = WS_WIN + 42 * MiB;
constexpr size_t WS_WO  = WS_WCAT + 6 * MiB;
constexpr size_t WS_WGU = WS_WO + 4 * MiB;
constexpr size_t WS_WDN = WS_WGU + 256 * MiB;
constexpr size_t WS_XB  = WS_WDN + 64 * MiB;
constexpr size_t WS_H   = WS_WDN + 128 * MiB;
constexpr size_t WS_PROJ = WS_H + 32 * MiB;
constexpr size_t WS_XIN = WS_WDN + 96 * MiB;
constexpr size_t WS_ACT = WS_PROJ + 64 * MiB;
constexpr size_t WS_Y   = WS_WGU + 128 * MiB;
constexpr size_t WS_ATTO = WS_PROJ + 336 * MiB;
constexpr size_t WS_LSE = WS_ATTO + 48 * MiB;
constexpr size_t WS_YF  = WS_LSE + 2 * MiB;
constexpr size_t WS_MERGED = WS_YF;
constexpr size_t WS_YB  = WS_YF + 32 * MiB;
constexpr size_t WS_CAT = WS_YB + 32 * MiB;
constexpr size_t WS_AFF = WS_CAT + 48 * MiB;
constexpr size_t WS_IDX = WS_AFF + 1 * MiB;
constexpr size_t WS_GW  = WS_IDX + 256 * 1024;
constexpr size_t WS_SLOT = WS_GW + 256 * 1024;
constexpr size_t WS_SC  = WS_SLOT + 1 * MiB;
constexpr size_t WS_WINS = WS_SC, WS_WGUS = WS_SC + 128 * 1024, WS_HS = WS_SC + 640 * 1024, WS_XS = WS_SC + 704 * 1024;
constexpr size_t WS_END = WS_SC + 1 * MiB;
constexpr size_t WS_WMAX = 64 * 1024;
constexpr int WMAX_IN = 0, WMAX_G = DEPTH * NIN, WMAX_U = WMAX_G + DEPTH * NE * FF, NWMAX = WMAX_U + DEPTH * NE * FF;
static_assert(WS_WMAX + (size_t)NWMAX * 4 <= 1 * MiB, "WMAX inside the CTL MiB");
static_assert(WS_END <= 1024 * MiB, "workspace map");

#define GAS __attribute__((address_space(1)))
#define LAS __attribute__((address_space(3)))
typedef unsigned short bf16;
typedef unsigned v4u __attribute__((ext_vector_type(4)));
typedef float f32x4 __attribute__((ext_vector_type(4)));
typedef short bf16x8 __attribute__((ext_vector_type(8)));
typedef GAS unsigned gu32;
typedef GAS unsigned long long gu64;
#define RLX_AGENT __ATOMIC_RELAXED, __HIP_MEMORY_SCOPE_AGENT
#define LDS_WAIT() asm volatile("s_waitcnt lgkmcnt(0)" ::: "memory")
#define VM_WAIT() asm volatile("s_waitcnt vmcnt(0)" ::: "memory")
__device__ __forceinline__ unsigned long long rt() { return __builtin_amdgcn_s_memrealtime(); }
__device__ __forceinline__ unsigned f2bf(float f) { unsigned u = __builtin_bit_cast(unsigned, f); return (u + 0x7fffu + ((u >> 16) & 1u)) >> 16; }
typedef float f32x2_t __attribute__((ext_vector_type(2))); typedef __bf16 bf16x2_t __attribute__((ext_vector_type(2)));
__device__ __forceinline__ unsigned pk2(float lo, float hi) { const f32x2_t v = {lo, hi}; return __builtin_bit_cast(unsigned, __builtin_convertvector(v, bf16x2_t)); }

__device__ __forceinline__ float fp8_lim() { float l = 448.f; asm volatile("" : "+v"(l)); return l; }
__device__ __forceinline__ unsigned fp8x4(float a, float b, float c, float d, float lim) { int p = 0; p = __builtin_amdgcn_cvt_pk_fp8_f32(__builtin_amdgcn_fmed3f(a, -lim, lim), __builtin_amdgcn_fmed3f(b, -lim, lim), p, false); p = __builtin_amdgcn_cvt_pk_fp8_f32(__builtin_amdgcn_fmed3f(c, -lim, lim), __builtin_amdgcn_fmed3f(d, -lim, lim), p, true); return (unsigned)p; }

#define XB_TMO      128
#define XB_XCNT(j)  (256  + 64 * (j))
#define XB_XSUB(j)  (1280 + 64 * (j))
#define XB_XGEN(j)  (2304 + 64 * (j))
#define XB_TOP      3328
#define XB_TOPGEN   3392
#define XCD_BAR_WORDS 3456
#define XB_SPIN_CAP (1u << 18)

__device__ __forceinline__ unsigned xb_ld(unsigned* p)              { return __hip_atomic_load(p, __ATOMIC_RELAXED, __HIP_MEMORY_SCOPE_AGENT); }
__device__ __forceinline__ unsigned xb_add(unsigned* p, unsigned v) { return __hip_atomic_fetch_add(p, v, __ATOMIC_RELAXED, __HIP_MEMORY_SCOPE_AGENT); }
__device__ __forceinline__ unsigned xb_xcc_id() { return (unsigned)__builtin_amdgcn_s_getreg((3 << 11) | 20) & 0xFu; }
#define XB_SPIN(cond, bar) do { unsigned _sp = 0; while (cond) { __builtin_amdgcn_s_sleep(1); \
    if ((++_sp & 255u) == 0u) { if (xb_ld(&(bar)[XB_TMO])) break; if (_sp > XB_SPIN_CAP) { atomicAdd(&(bar)[XB_TMO], 1u); break; } } } } while (0)

struct XcdBarrier {
    unsigned* bar; unsigned x;
    volatile LAS unsigned* st;
};

__device__ __forceinline__ XcdBarrier xcd_barrier_post(unsigned* bar, volatile LAS unsigned* st) {
    XcdBarrier b; b.bar = bar; b.x = xb_xcc_id(); b.st = st;
    if (threadIdx.x == 0) (void)xb_add(&bar[XB_XCNT(b.x)], 1u);
    return b;
}
__device__ __forceinline__ void xcd_barrier_complete(unsigned* bar, unsigned x, unsigned& nloc, unsigned& nx) {
    const unsigned G = gridDim.x * gridDim.y * gridDim.z;
    unsigned sum, cnt, mine, sp = 0u;
    for (;;) {
        sum = 0u; cnt = 0u; mine = 0u;
#pragma unroll
        for (unsigned j = 0; j < 16; ++j) { const unsigned c = xb_ld(&bar[XB_XCNT(j)]); sum += c; cnt += (c > 0u) ? 1u : 0u; mine = (j == x) ? c : mine; }
        if (sum == G) break;
        __builtin_amdgcn_s_sleep(1);
        if ((++sp & 255u) == 0u) { if (xb_ld(&bar[XB_TMO])) break; if (sp > XB_SPIN_CAP) { atomicAdd(&bar[XB_TMO], 1u); break; } }
    }
    nloc = mine > 0u ? mine : 1u; nx = cnt > 0u ? cnt : 1u;
}

__device__ __forceinline__ void xcd_barrier(const XcdBarrier& b) {
    asm volatile("s_waitcnt vmcnt(0)" ::: "memory");
    __syncthreads();
    if (threadIdx.x == 0) {
        unsigned* bar = b.bar;
        __builtin_amdgcn_s_waitcnt(0);
        unsigned nloc = b.st[0], nx = b.st[1];
        if (nloc == 0u) { xcd_barrier_complete(bar, b.x, nloc, nx); b.st[0] = nloc; b.st[1] = nx; }
        const unsigned old = xb_add(&bar[XB_XSUB(b.x)], 1u);
        const unsigned gen = old / nloc;
        if (old + 1u == (gen + 1u) * nloc) {
            __builtin_amdgcn_fence(__ATOMIC_RELEASE, "agent");
            asm volatile("s_waitcnt vmcnt(0)" ::: "memory");
            const unsigned og = xb_add(&bar[XB_TOP], 1u);
            const unsigned tg = og / nx;
            if (og + 1u == (tg + 1u) * nx) xb_add(&bar[XB_TOPGEN], 1u);
            else XB_SPIN(xb_ld(&bar[XB_TOPGEN]) == tg, bar);
            xb_add(&bar[XB_XGEN(b.x)], 1u);
            asm volatile("s_waitcnt vmcnt(0)" ::: "memory");
        } else {
            XB_SPIN(xb_ld(&bar[XB_XGEN(b.x)]) == gen, bar);
        }
    } else if (threadIdx.x == 64) {
        __builtin_amdgcn_fence(__ATOMIC_ACQUIRE, "agent");
        asm volatile("s_waitcnt vmcnt(0)" ::: "memory");
    }
    __syncthreads();
}


#define CW_LBAR 8192
#define CW_TQ 13312
#define CW_AQ 12288
__device__ __forceinline__ void xcc_local_barrier(unsigned* ctl, const unsigned x, const unsigned nloc, unsigned* tmo_bar) {
    asm volatile("s_waitcnt vmcnt(0)" ::: "memory");
    __syncthreads();
    if (threadIdx.x == 0) {
        unsigned* w = ctl + CW_LBAR + 64 * x;
        const unsigned old = xb_add(w, 1u); const unsigned target = (old / nloc + 1u) * nloc;
        XB_SPIN(xb_ld(w) < target, tmo_bar);
    } else if (threadIdx.x == 64) {
        __builtin_amdgcn_fence(__ATOMIC_ACQUIRE, "agent");
        asm volatile("s_waitcnt vmcnt(0)" ::: "memory");
    }
    __syncthreads();
}

typedef unsigned u32x2 __attribute__((ext_vector_type(2)));
typedef unsigned u32x4 __attribute__((ext_vector_type(4)));
__device__ __forceinline__ float bf2f(unsigned short h) { return __builtin_bit_cast(float, (unsigned)h << 16); }
__device__ __forceinline__ float sigmoidf_(float v) { return 1.f / (1.f + __expf(-v)); }
__device__ __forceinline__ float siluf_(float v) { return v * __builtin_amdgcn_rcpf(1.f + __expf(-v)); }
namespace pg8 {
#define PG8_LAS __attribute__((address_space(3)))
typedef unsigned short bf16_t;
typedef short bf16x8 __attribute__((ext_vector_type(8)));
typedef float f32x4 __attribute__((ext_vector_type(4)));
typedef unsigned u32x4 __attribute__((ext_vector_type(4)));
constexpr int BM = 256, BK = 64, HALF = 128, HTB = HALF * BK * 2  , STAGE_BYTES = 8 * HTB, NXCD = 8, WGM = 8;

__host__ __device__ __forceinline__ int lds_byte(int r, int c) { const int st = r >> 3, rr = r & 7, ch = c >> 3; return st * 1024 + rr * 128 + ((ch ^ rr) << 4) + (c & 7) * 2; }
__host__ __device__ __forceinline__ void stage_rc(int b, int& R, int& C) { const int st = b / 1024, sb = b % 1024, rr = sb >> 7, slot = (sb >> 4) & 7; R = st * 8 + rr; C = ((slot ^ rr) << 3) + ((sb & 15) >> 1); }
__host__ __device__ __forceinline__ int perm32(int rho) { const int n = rho >> 4, i = rho & 15; return 8 * (i >> 2) + 4 * n + (i & 3); }

struct Unit { int pm, pn; };
struct Gemm { const bf16_t* A; const bf16_t* Bt; int M, N, K; int gshift; size_t gstrideB; };

struct StaticOrder {
    int nM, nN, nwg, G, c;
    int sync_ui; unsigned* sctl; unsigned sx, snloc; unsigned* stmo;
    __host__ __device__ void init(int M, int N, int G_, int c_) { nM = M / BM; nN = N / BM; nwg = nM * nN; G = G_; c = c_; sync_ui = -1; sctl = nullptr; sx = 0; snloc = 1; stmo = nullptr; }
    __device__ __forceinline__ void after_unit(int ui) const { if (ui == sync_ui) xcc_local_barrier(sctl, sx, snloc, stmo); }
    __host__ __device__ bool next(int i, Unit& u) const {
        const long L = (long)i * G + c; if (L >= nwg) return false;
        int wgid = (int)L; { const int q = nwg / NXCD, r = nwg % NXCD, xcd = wgid % NXCD, off = wgid / NXCD; wgid = (xcd < r ? xcd * (q + 1) : r * (q + 1) + (xcd - r) * q) + off; }
        const int nig = WGM * nN, gid = wgid / nig, fm = gid * WGM, gsz = (nM - fm) < WGM ? (nM - fm) : WGM;
        u.pm = fm + ((wgid % nig) % gsz); u.pn = (wgid % nig) / gsz; return true;
    }
    __device__ __forceinline__ void a_ready(const Unit&) const {}
    __device__ __forceinline__ void done(const Unit&) const {}
};

__device__ __forceinline__ unsigned cvt_pk_bf16(float lo, float hi) { unsigned r; asm volatile("v_cvt_pk_bf16_f32 %0, %1, %2" : "=v"(r) : "v"(lo), "v"(hi)); return r; }
typedef float f32x2 __attribute__((ext_vector_type(2)));
typedef unsigned u32x2 __attribute__((ext_vector_type(2)));
constexpr int P_NIN = 10752, P_OFF_GA = 8704, P_OFF_GR = 9728, P_FF = 2048;
__device__ __forceinline__ float bflo(unsigned w) { return __builtin_bit_cast(float, w << 16); }
__device__ __forceinline__ float bfhi(unsigned w) { return __builtin_bit_cast(float, w & 0xffff0000u); }
__device__ __forceinline__ float fsig(float v) { return __builtin_amdgcn_rcpf(1.f + __expf(-v)); }
struct EpiStore {
    static constexpr bool PERM = true, AFTER_DRAIN = false; static constexpr int MID_T = 0;
    bf16_t* O; int ldc;
    __device__ __forceinline__ void operator()(const f32x4 (&acc)[2][2][4][2], const Unit& u, int wr, int wc, int fr, int fq) const {
        int row0 = u.pm * BM + wr * 64 + fr, col0 = u.pn * BM + wc * 64 + 8 * fq; asm volatile("" : "+v"(row0));
#pragma unroll
        for (int ai = 0; ai < 2; ++ai)
#pragma unroll
            for (int m = 0; m < 4; ++m) { bf16_t* rowp = O + (size_t)(row0 + ai * HALF + m * 16) * ldc + col0;
#pragma unroll
                for (int bj = 0; bj < 2; ++bj) { const f32x4 v0 = acc[ai][bj][m][0], v1 = acc[ai][bj][m][1];
                    u32x4 w; w.x = cvt_pk_bf16(v0[0], v0[1]); w.y = cvt_pk_bf16(v0[2], v0[3]); w.z = cvt_pk_bf16(v1[0], v1[1]); w.w = cvt_pk_bf16(v1[2], v1[3]);
                    *(u32x4*)(rowp + bj * 32) = w; } }
    }
};
struct EpiMerge {
    static constexpr bool PERM = true, AFTER_DRAIN = false; static constexpr int MID_T = 4;
    const bf16_t* proj; bf16_t* O; float post;
    static __device__ __forceinline__ void dec8(const unsigned lo, const unsigned hi, float (&f)[8]) {
        const auto p0 = __builtin_amdgcn_cvt_pk_f32_fp8((int)lo, false), p1 = __builtin_amdgcn_cvt_pk_f32_fp8((int)lo, true), p2 = __builtin_amdgcn_cvt_pk_f32_fp8((int)hi, false), p3 = __builtin_amdgcn_cvt_pk_f32_fp8((int)hi, true);
        f[0] = p0[0]; f[1] = p0[1]; f[2] = p1[0]; f[3] = p1[1]; f[4] = p2[0]; f[5] = p2[1]; f[6] = p3[0]; f[7] = p3[1]; }
    static __device__ __forceinline__ void dec8v(const unsigned lo, const unsigned hi, f32x4& v0, f32x4& v1) {
        const auto p0 = __builtin_amdgcn_cvt_pk_f32_fp8((int)lo, false), p1 = __builtin_amdgcn_cvt_pk_f32_fp8((int)lo, true), p2 = __builtin_amdgcn_cvt_pk_f32_fp8((int)hi, false), p3 = __builtin_amdgcn_cvt_pk_f32_fp8((int)hi, true);
        v0 = (f32x4){p0[0], p0[1], p1[0], p1[1]}; v1 = (f32x4){p2[0], p2[1], p3[0], p3[1]}; }
    static __device__ __forceinline__ f32x4 den4(const f32x4 g, const f32x4 nl4, const f32x4 one4) { const f32x4 t = g * nl4; return (f32x4){__builtin_amdgcn_exp2f(t[0]), __builtin_amdgcn_exp2f(t[1]), __builtin_amdgcn_exp2f(t[2]), __builtin_amdgcn_exp2f(t[3])} + one4; }
    static __device__ __forceinline__ f32x4 rcp4(const f32x4 d) { return (f32x4){__builtin_amdgcn_rcpf(d[0]), __builtin_amdgcn_rcpf(d[1]), __builtin_amdgcn_rcpf(d[2]), __builtin_amdgcn_rcpf(d[3])}; }
    __device__ __forceinline__ void mid(f32x4 (&acc)[2][2][4][2], const Unit& u, int wr, int wc, int fr, int fq) const {
        int row0 = u.pm * BM + wr * 64 + fr, colg = u.pn * BM + wc * 64 + 16 * fq; asm volatile("" : "+v"(row0));
        const unsigned char* g8 = (const unsigned char*)(proj + PO_GATE);
        float nl = -1.4426950408889634f, one = 1.f; asm volatile("" : "+v"(nl), "+v"(one)); const f32x4 nl4 = {nl, nl, nl, nl}, one4 = {one, one, one, one};
        u32x4 ga[2][4], gr[2][4];
#pragma unroll
        for (int ai = 0; ai < 2; ++ai)
#pragma unroll
            for (int m = 0; m < 4; ++m) { const unsigned char* pr = g8 + (size_t)(row0 + ai * HALF + m * 16) * 2048 + colg; ga[ai][m] = *(const u32x4*)pr; gr[ai][m] = *(const u32x4*)(pr + 1024); }
#pragma unroll
        for (int ai = 0; ai < 2; ++ai)
#pragma unroll
            for (int m = 0; m < 4; ++m)
#pragma unroll
                for (int bj = 0; bj < 2; ++bj) { f32x4 a0, a1, r0, r1; dec8v(bj ? ga[ai][m].z : ga[ai][m].x, bj ? ga[ai][m].w : ga[ai][m].y, a0, a1); dec8v(bj ? gr[ai][m].z : gr[ai][m].x, bj ? gr[ai][m].w : gr[ai][m].y, r0, r1);
                    acc[ai][bj][m][0] *= den4(r0, nl4, one4) * rcp4(den4(a0, nl4, one4)); acc[ai][bj][m][1] *= den4(r1, nl4, one4) * rcp4(den4(a1, nl4, one4)); }
    }
    __device__ __forceinline__ void operator()(const f32x4 (&acc)[2][2][4][2], const Unit& u, int wr, int wc, int fr, int fq) const {
        int row0 = u.pm * BM + wr * 64 + fr, col0 = u.pn * BM + wc * 64 + 8 * fq; asm volatile("" : "+v"(row0));
        const unsigned char* g8 = (const unsigned char*)(proj + PO_GATE) + 1024 + u.pn * BM + wc * 64 + 16 * fq;
        float nl = -1.4426950408889634f, one = 1.f, ps = post; asm volatile("" : "+v"(nl), "+v"(one), "+v"(ps)); const f32x4 nl4 = {nl, nl, nl, nl}, one4 = {one, one, one, one}, post4 = {ps, ps, ps, ps};
        u32x4 grr[2][4];
#pragma unroll
        for (int ai = 0; ai < 2; ++ai)
#pragma unroll
            for (int m = 0; m < 4; ++m) grr[ai][m] = *(const u32x4*)(g8 + (size_t)(row0 + ai * HALF + m * 16) * 2048);
#pragma unroll
        for (int ai = 0; ai < 2; ++ai) { const u32x4 (&gr)[4] = grr[ai];
#pragma unroll
            for (int m = 0; m < 4; ++m) { bf16_t* rowp = O + (size_t)(row0 + ai * HALF + m * 16) * 1024 + col0;
#pragma unroll
                for (int bj = 0; bj < 2; ++bj) { f32x4 g0, g1; dec8v(bj ? gr[m].z : gr[m].x, bj ? gr[m].w : gr[m].y, g0, g1);
                    const f32x4 v0 = (acc[ai][bj][m][0] * post4) * rcp4(den4(g0, nl4, one4)), v1 = (acc[ai][bj][m][1] * post4) * rcp4(den4(g1, nl4, one4));
                    u32x4 w; w.x = cvt_pk_bf16(v0[0], v0[1]); w.y = cvt_pk_bf16(v0[2], v0[3]); w.z = cvt_pk_bf16(v1[0], v1[1]); w.w = cvt_pk_bf16(v1[2], v1[3]);
                    *(u32x4*)(rowp + bj * 32) = w; } } }
    }
};
__device__ __forceinline__ float i2f(float bits) { return (float)__builtin_bit_cast(int, bits); }
struct EpiStoreI8 {
    static constexpr bool PERM = true, AFTER_DRAIN = false; static constexpr int MID_T = 0;
    bf16_t* O; int ldc; const float* rs; const float* cs;
    __device__ __forceinline__ void operator()(const f32x4 (&acc)[2][2][4][2], const Unit& u, int wr, int wc, int fr, int fq) const {
        int row0 = u.pm * BM + wr * 64 + fr, col0 = u.pn * BM + wc * 64 + 8 * fq; asm volatile("" : "+v"(row0), "+v"(col0));
        const bool odd = fr & 1; const int rowe = row0 & ~1;
        f32x4 c[2][2];
#pragma unroll
        for (int bj = 0; bj < 2; ++bj) { c[bj][0] = *(const f32x4*)(cs + col0 + bj * 32); c[bj][1] = *(const f32x4*)(cs + col0 + bj * 32 + 4); }
        const ProjCol pc = proj_col(col0 + (odd ? 32 : 0));
        bf16_t* const base0 = O + proj_row(pc, rowe); bf16_t* const base1 = O + proj_row(pc, rowe + 1); const unsigned step = (16u * pc.pitch) >> pc.dsh;
        float srv[8];
#pragma unroll
        for (int i = 0; i < 8; ++i) srv[i] = rs[row0 + (i >> 2) * HALF + (i & 3) * 16];
        if (u.pn >= 34) {
            unsigned char* const g0 = (unsigned char*)(O + PO_GATE) + (size_t)row0 * 2048 + (u.pn * BM + wc * 64 - 8704) + 16 * fq; const float lim = fp8_lim();
#pragma unroll
            for (int ai = 0; ai < 2; ++ai)
#pragma unroll
                for (int m = 0; m < 4; ++m) { const float sr = srv[ai * 4 + m]; u32x4 w;
#pragma unroll
                    for (int bj = 0; bj < 2; ++bj) { const f32x4 a0 = acc[ai][bj][m][0], a1 = acc[ai][bj][m][1];
                        const f32x4 v0 = (f32x4){i2f(a0[0]), i2f(a0[1]), i2f(a0[2]), i2f(a0[3])} * (c[bj][0] * sr), v1 = (f32x4){i2f(a1[0]), i2f(a1[1]), i2f(a1[2]), i2f(a1[3])} * (c[bj][1] * sr);
                        const unsigned lo = fp8x4(v0[0], v0[1], v0[2], v0[3], lim), hi = fp8x4(v1[0], v1[1], v1[2], v1[3], lim);
                        if (bj == 0) { w.x = lo; w.y = hi; } else { w.z = lo; w.w = hi; } }
                    __builtin_nontemporal_store(w, (u32x4*)(g0 + (size_t)(ai * HALF + m * 16) * 2048)); }
            return; }
#pragma unroll
        for (int ai = 0; ai < 2; ++ai)
#pragma unroll
            for (int m = 0; m < 4; ++m) { const float sr = srv[ai * 4 + m]; u32x4 w[2];
#pragma unroll
                for (int bj = 0; bj < 2; ++bj) { const f32x4 a0 = acc[ai][bj][m][0], a1 = acc[ai][bj][m][1];
                    const f32x4 v0 = (f32x4){i2f(a0[0]), i2f(a0[1]), i2f(a0[2]), i2f(a0[3])} * (c[bj][0] * sr), v1 = (f32x4){i2f(a1[0]), i2f(a1[1]), i2f(a1[2]), i2f(a1[3])} * (c[bj][1] * sr);
                    w[bj].x = cvt_pk_bf16(v0[0], v0[1]); w[bj].y = cvt_pk_bf16(v0[2], v0[3]); w[bj].z = cvt_pk_bf16(v1[0], v1[1]); w[bj].w = cvt_pk_bf16(v1[2], v1[3]); }
                u32x4 snd, rcv;
                snd.x = odd ? w[0].x : w[1].x; snd.y = odd ? w[0].y : w[1].y; snd.z = odd ? w[0].z : w[1].z; snd.w = odd ? w[0].w : w[1].w;
                rcv.x = (unsigned)__builtin_amdgcn_mov_dpp((int)snd.x, 0xB1, 0xF, 0xF, true); rcv.y = (unsigned)__builtin_amdgcn_mov_dpp((int)snd.y, 0xB1, 0xF, 0xF, true);
                rcv.z = (unsigned)__builtin_amdgcn_mov_dpp((int)snd.z, 0xB1, 0xF, 0xF, true); rcv.w = (unsigned)__builtin_amdgcn_mov_dpp((int)snd.w, 0xB1, 0xF, 0xF, true);
                u32x4 s0, s1;
                s0.x = odd ? rcv.x : w[0].x; s0.y = odd ? rcv.y : w[0].y; s0.z = odd ? rcv.z : w[0].z; s0.w = odd ? rcv.w : w[0].w;
                s1.x = odd ? w[1].x : rcv.x; s1.y = odd ? w[1].y : rcv.y; s1.z = odd ? w[1].z : rcv.z; s1.w = odd ? w[1].w : rcv.w;
                const size_t o = (size_t)((ai * 8 + m) * step);
                __builtin_nontemporal_store(s0, (u32x4*)(base0 + o)); __builtin_nontemporal_store(s1, (u32x4*)(base1 + o)); }
    }
};
struct EpiSwigluI8 {
    static constexpr bool PERM = false, AFTER_DRAIN = false; static constexpr int MID_T = 0;
    bf16_t* O; const float* rs; const float* cs; int fp8;
    __device__ __forceinline__ void operator()(const f32x4 (&acc)[2][2][4][2], const Unit& u, int wr, int wc, int fr, int fq) const {
        int row0 = u.pm * BM + wr * 64 + fr, f0 = u.pn * (BM / 2) + wc * 32 + 8 * fq; asm volatile("" : "+v"(row0));
        int cofs = u.pn * BM + wc * 32 + 4 * fq; asm volatile("" : "+v"(cofs));
        const float* csp = cs + (size_t)(u.pm >> 3) * (2 * P_FF) + cofs;
        f32x4 cg[2], cu[2];
#pragma unroll
        for (int bj = 0; bj < 2; ++bj) { cg[bj] = *(const f32x4*)(csp + bj * HALF); cu[bj] = *(const f32x4*)(csp + bj * HALF + 16); }
        float srv[8];
#pragma unroll
        for (int i = 0; i < 8; ++i) srv[i] = rs[row0 + (i >> 2) * HALF + (i & 3) * 16];
        asm volatile("" : "+v"(cg[0]), "+v"(cg[1]), "+v"(cu[0]), "+v"(cu[1]), "+v"(srv[0]), "+v"(srv[1]), "+v"(srv[2]), "+v"(srv[3]), "+v"(srv[4]), "+v"(srv[5]), "+v"(srv[6]), "+v"(srv[7]));
        cu[0] *= 16.f; cu[1] *= 16.f;
        const float lim = fp8_lim(); float nl = -1.4426950408889634f; asm volatile("" : "+v"(nl)); const f32x4 nl2e = {nl, nl, nl, nl}; float one = 1.f; asm volatile("" : "+v"(one)); const f32x4 one4 = {one, one, one, one};
#pragma unroll
        for (int ai = 0; ai < 2; ++ai)
#pragma unroll
            for (int m = 0; m < 4; ++m) { const size_t r = (size_t)(row0 + ai * HALF + m * 16); const float sr = srv[ai * 4 + m];
                u32x2 w;
#pragma unroll
                for (int bj = 0; bj < 2; ++bj) { const f32x4 ga = acc[ai][bj][m][0], ua = acc[ai][bj][m][1];
                    const f32x4 fa = (f32x4){i2f(ga[0]), i2f(ga[1]), i2f(ga[2]), i2f(ga[3])} * (cg[bj] * sr), fb = (f32x4){i2f(ua[0]), i2f(ua[1]), i2f(ua[2]), i2f(ua[3])} * (cu[bj] * sr);
                    const f32x4 t = fa * nl2e;
                    const f32x4 d = (f32x4){__builtin_amdgcn_exp2f(t[0]), __builtin_amdgcn_exp2f(t[1]), __builtin_amdgcn_exp2f(t[2]), __builtin_amdgcn_exp2f(t[3])} + one4;
                    const f32x4 rc = {__builtin_amdgcn_rcpf(d[0]), __builtin_amdgcn_rcpf(d[1]), __builtin_amdgcn_rcpf(d[2]), __builtin_amdgcn_rcpf(d[3])};
                    const f32x4 o = (fa * fb) * rc;
                    const unsigned pk = fp8x4(o[0], o[1], o[2], o[3], lim);
                    if (bj == 0) w.x = pk; else w.y = pk; }
                *(u32x2*)((unsigned char*)O + r * P_FF + f0) = w; }
    }
};

template <bool SRCF32> struct EpiResidB {
    static constexpr bool PERM = true, AFTER_DRAIN = false; static constexpr int MID_T = 0;
    const void* src; bf16_t* out; float post;
    __device__ __forceinline__ void operator()(const f32x4 (&acc)[2][2][4][2], const Unit& u, int wr, int wc, int fr, int fq) const {
        int row0 = u.pm * BM + wr * 64 + fr, col0 = u.pn * BM + wc * 64 + 8 * fq; asm volatile("" : "+v"(row0));
        if constexpr (SRCF32) {
#pragma unroll
            for (int ai = 0; ai < 2; ++ai) { f32x4 rf[4][2][2];
#pragma unroll
                for (int m = 0; m < 4; ++m)
#pragma unroll
                    for (int bj = 0; bj < 2; ++bj) { const size_t o = (size_t)(row0 + ai * HALF + m * 16) * 1024 + col0 + bj * 32; rf[m][bj][0] = *(const f32x4*)((const float*)src + o); rf[m][bj][1] = *(const f32x4*)((const float*)src + o + 4); }
#pragma unroll
                for (int m = 0; m < 4; ++m)
#pragma unroll
                    for (int bj = 0; bj < 2; ++bj) { const size_t o = (size_t)(row0 + ai * HALF + m * 16) * 1024 + col0 + bj * 32;
                        const f32x4 v0 = rf[m][bj][0] + acc[ai][bj][m][0] * post, v1 = rf[m][bj][1] + acc[ai][bj][m][1] * post;
                        u32x4 w; w.x = cvt_pk_bf16(v0[0], v0[1]); w.y = cvt_pk_bf16(v0[2], v0[3]); w.z = cvt_pk_bf16(v1[0], v1[1]); w.w = cvt_pk_bf16(v1[2], v1[3]);
                        *(u32x4*)(out + o) = w; } }
        } else {
            u32x4 rb[2][4][2];
#pragma unroll
            for (int ai = 0; ai < 2; ++ai)
#pragma unroll
                for (int m = 0; m < 4; ++m)
#pragma unroll
                    for (int bj = 0; bj < 2; ++bj) rb[ai][m][bj] = *(const u32x4*)((const bf16_t*)src + (size_t)(row0 + ai * HALF + m * 16) * 1024 + col0 + bj * 32);
#pragma unroll
            for (int ai = 0; ai < 2; ++ai)
#pragma unroll
                for (int m = 0; m < 4; ++m)
#pragma unroll
                    for (int bj = 0; bj < 2; ++bj) { const size_t o = (size_t)(row0 + ai * HALF + m * 16) * 1024 + col0 + bj * 32; const u32x4 r = rb[ai][m][bj];
                        const f32x4 s0 = (f32x4){bflo(r.x), bfhi(r.x), bflo(r.y), bfhi(r.y)}, s1 = (f32x4){bflo(r.z), bfhi(r.z), bflo(r.w), bfhi(r.w)};
                        const f32x4 v0 = s0 + acc[ai][bj][m][0] * post, v1 = s1 + acc[ai][bj][m][1] * post;
                        u32x4 w; w.x = cvt_pk_bf16(v0[0], v0[1]); w.y = cvt_pk_bf16(v0[2], v0[3]); w.z = cvt_pk_bf16(v1[0], v1[1]); w.w = cvt_pk_bf16(v1[2], v1[3]);
                        *(u32x4*)(out + o) = w; }
        }
    }
};
struct EpiResid {
    static constexpr bool PERM = false, AFTER_DRAIN = false; static constexpr int MID_T = 0;
    const float* src; float* out;
    __device__ __forceinline__ void operator()(const f32x4 (&acc)[2][2][4][2], const Unit& u, int wr, int wc, int fr, int fq) const {
        int row0 = u.pm * BM + wr * 64 + fr, col0 = u.pn * BM + wc * 32 + 4 * fq; asm volatile("" : "+v"(row0));
#pragma unroll
        for (int ai = 0; ai < 2; ++ai) { f32x4 sv[4][2][2];
#pragma unroll
            for (int m = 0; m < 4; ++m)
#pragma unroll
                for (int bj = 0; bj < 2; ++bj)
#pragma unroll
                    for (int n = 0; n < 2; ++n) sv[m][bj][n] = *(const f32x4*)(src + (size_t)(row0 + ai * HALF + m * 16) * 1024 + col0 + bj * HALF + n * 16);
#pragma unroll
            for (int m = 0; m < 4; ++m)
#pragma unroll
                for (int bj = 0; bj < 2; ++bj)
#pragma unroll
                    for (int n = 0; n < 2; ++n) *(f32x4*)(out + (size_t)(row0 + ai * HALF + m * 16) * 1024 + col0 + bj * HALF + n * 16) = sv[m][bj][n] + acc[ai][bj][m][n]; }
    }
};
struct EpiSwiglu {
    static constexpr bool PERM = false, AFTER_DRAIN = false; static constexpr int MID_T = 0;
    bf16_t* O;
    __device__ __forceinline__ void operator()(const f32x4 (&acc)[2][2][4][2], const Unit& u, int wr, int wc, int fr, int fq) const {
        int row0 = u.pm * BM + wr * 64 + fr, f0 = (u.pn * BM + wc * 32) / 2 + 4 * fq; asm volatile("" : "+v"(row0));
#pragma unroll
        for (int ai = 0; ai < 2; ++ai)
#pragma unroll
            for (int m = 0; m < 4; ++m) { bf16_t* rowp = O + (size_t)(row0 + ai * HALF + m * 16) * P_FF + f0;
#pragma unroll
                for (int bj = 0; bj < 2; ++bj) { const f32x4 a = acc[ai][bj][m][0], b = acc[ai][bj][m][1];
                    u32x2 w; w.x = cvt_pk_bf16(a[0] * fsig(a[0]) * b[0], a[1] * fsig(a[1]) * b[1]); w.y = cvt_pk_bf16(a[2] * fsig(a[2]) * b[2], a[3] * fsig(a[3]) * b[3]);
                    *(u32x2*)(rowp + bj * (HALF / 2)) = w; } }
    }
};
struct EpiDown {
    static constexpr bool PERM = true, AFTER_DRAIN = false; static constexpr int MID_T = 0;
    const float* gw; bf16_t* O; float post;
    __device__ __forceinline__ void operator()(const f32x4 (&acc)[2][2][4][2], const Unit& u, int wr, int wc, int fr, int fq) const {
        int row0 = u.pm * BM + wr * 64 + fr, col0 = u.pn * BM + wc * 64 + 8 * fq; asm volatile("" : "+v"(row0));
        float srv[8];
#pragma unroll
        for (int i = 0; i < 8; ++i) srv[i] = gw[row0 + (i >> 2) * HALF + (i & 3) * 16];
        asm volatile("" : "+v"(srv[0]), "+v"(srv[1]), "+v"(srv[2]), "+v"(srv[3]), "+v"(srv[4]), "+v"(srv[5]), "+v"(srv[6]), "+v"(srv[7]));
#pragma unroll
        for (int i = 0; i < 8; ++i) srv[i] *= post;
        const bool odd = fr & 1; const float lim = fp8_lim();
        unsigned char* const g0 = (unsigned char*)O + (size_t)(row0 & ~1) * 1024 + col0 + (odd ? 32 : 0);
#pragma unroll
        for (int ai = 0; ai < 2; ++ai)
#pragma unroll
            for (int m = 0; m < 4; ++m) { const float s = srv[ai * 4 + m]; u32x2 w[2];
#pragma unroll
                for (int bj = 0; bj < 2; ++bj) { const f32x4 v0 = acc[ai][bj][m][0] * s, v1 = acc[ai][bj][m][1] * s;
                    w[bj].x = fp8x4(v0[0], v0[1], v0[2], v0[3], lim); w[bj].y = fp8x4(v1[0], v1[1], v1[2], v1[3], lim); }
                u32x2 snd, rcv; snd.x = odd ? w[0].x : w[1].x; snd.y = odd ? w[0].y : w[1].y;
                rcv.x = (unsigned)__builtin_amdgcn_mov_dpp((int)snd.x, 0xB1, 0xF, 0xF, true); rcv.y = (unsigned)__builtin_amdgcn_mov_dpp((int)snd.y, 0xB1, 0xF, 0xF, true);
                u32x2 s0, s1; s0.x = odd ? rcv.x : w[0].x; s0.y = odd ? rcv.y : w[0].y; s1.x = odd ? w[1].x : rcv.x; s1.y = odd ? w[1].y : rcv.y;
                unsigned char* const gp = g0 + (size_t)(ai * HALF + m * 16) * 1024;
                *(u32x2*)gp = s0; *(u32x2*)(gp + 1024) = s1; }
    }
};
typedef int i32x4 __attribute__((ext_vector_type(4)));
typedef long i64x2 __attribute__((ext_vector_type(2)));
template <int MT> __device__ __forceinline__ f32x4 mma16(const bf16x8 a, const bf16x8 b, const f32x4 c) {
    if constexpr (MT == 1) return __builtin_bit_cast(f32x4, __builtin_amdgcn_mfma_i32_16x16x64_i8(__builtin_bit_cast(i32x4, a), __builtin_bit_cast(i32x4, b), __builtin_bit_cast(i32x4, c), 0, 0, 0));
    else if constexpr (MT == 2) { const i64x2 a2 = __builtin_bit_cast(i64x2, a), b2 = __builtin_bit_cast(i64x2, b);
        return __builtin_amdgcn_mfma_f32_16x16x32_fp8_fp8(a2[1], b2[1], __builtin_amdgcn_mfma_f32_16x16x32_fp8_fp8(a2[0], b2[0], c, 0, 0, 0), 0, 0, 0); }
    else return __builtin_amdgcn_mfma_f32_16x16x32_bf16(a, b, c, 0, 0, 0);
}
typedef int i32x8 __attribute__((ext_vector_type(8))); typedef short bf16x16 __attribute__((ext_vector_type(16)));
__device__ __forceinline__ i32x8 cat8(const bf16x8 lo, const bf16x8 hi) { const i32x4 l = __builtin_bit_cast(i32x4, lo), h = __builtin_bit_cast(i32x4, hi); return __builtin_shufflevector(l, h, 0, 1, 2, 3, 4, 5, 6, 7); }
__device__ __forceinline__ void mma_f8x128(f32x4& c, const i32x8 a, const i32x8 b, const int one) {
    asm volatile("s_nop 1\n\tv_mfma_scale_f32_16x16x128_f8f6f4 %0, %1, %2, %0, %3, %3 op_sel_hi:[0,0,0]" : "+v"(c) : "v"(a), "v"(b), "v"(one));
}
template <class Epi, class Sched, bool ALIGN_EPI = false, bool SP2 = false, int MT = 0>
__device__ __forceinline__ void gemm_phase(PG8_LAS unsigned char* lds, const Gemm g, const Sched& S, const Epi& E, const int tid) {
    const int wid = __builtin_amdgcn_readfirstlane(tid >> 6), lane = tid & 63, wr = wid >> 2, wc = wid & 3, fr = lane & 15, fq = lane >> 4;
    const int K = g.K, nt = K / BK;
    unsigned voffA[2], voffB[2];
#pragma unroll
    for (int i = 0; i < 2; ++i) { int R, C; stage_rc(tid * 16 + i * 8192, R, C); const int Rb = Epi::PERM ? ((R & ~31) * 2 + perm32(R & 31)) : R;
        voffA[i] = (unsigned)(R * K + C) * 2u; voffB[i] = (unsigned)(Rb * K + C) * 2u; }
    const size_t kstep = (size_t)(BK * 2);
    const size_t hstep = (size_t)HALF * K * 2;
    const size_t tstep = 2 * hstep;
    const size_t hstepB = Epi::PERM ? (size_t)32 * K * 2 : hstep;
    const unsigned ldsw = (unsigned)wid * 1024u;
    const int aoff = lds_byte(wr * 64 + fr, fq * 8), boff = lds_byte(wc * 32 + fr, fq * 8);
#define PG8_SA(b, h) (((b) * 2 + (h)) * HTB)
#define PG8_SB(b, h) ((4 + (b) * 2 + (h)) * HTB)
#define PG8_STAGE(bufoff, gbase, voff) do { _Pragma("unroll") for (int _i = 0; _i < 2; ++_i) \
        __builtin_amdgcn_global_load_lds((const unsigned*)((const char*)(gbase) + (voff)[_i]), (PG8_LAS unsigned*)(lds + (bufoff) + ldsw + _i * 8192), 16, 0, 0); } while (0)
#define PG8_LDA(dst, b, h) do { _Pragma("unroll") for (int m = 0; m < 4; ++m) _Pragma("unroll") for (int k = 0; k < 2; ++k) dst[m][k] = *(const PG8_LAS bf16x8*)(lds + PG8_SA(b, h) + (aoff ^ (k * 64)) + m * 2048); } while (0)
#define PG8_LDB(dst, b, h) do { _Pragma("unroll") for (int n = 0; n < 2; ++n) _Pragma("unroll") for (int k = 0; k < 2; ++k) dst[n][k] = *(const PG8_LAS bf16x8*)(lds + PG8_SB(b, h) + (boff ^ (k * 64)) + n * 2048); } while (0)
#define PG8_MMA(ai, bj, At, Bt) do { __builtin_amdgcn_s_setprio(1); _Pragma("unroll") for (int m = 0; m < 4; ++m) _Pragma("unroll") for (int n = 0; n < 2; ++n) { \
        if constexpr (MT == 2) mma_f8x128(acc[ai][bj][m][n], cat8(Bt[n][0], Bt[n][1]), cat8(At[m][0], At[m][1]), mxone); \
        else { _Pragma("unroll") for (int k = 0; k < 2; ++k) acc[ai][bj][m][n] = mma16<MT>(Bt[n][k], At[m][k], acc[ai][bj][m][n]); } } __builtin_amdgcn_s_setprio(0); } while (0)
#define PG8_WAIT_V(n) asm volatile("s_waitcnt vmcnt(" #n ")" ::: "memory")
#define PG8_WAIT_L(n) asm volatile("s_waitcnt lgkmcnt(" #n ")" ::: "memory")
#define PG8_BAR __builtin_amdgcn_s_barrier()
#define PG8_SCHED __builtin_amdgcn_sched_barrier(0)
    Unit cur, nxt; int ui = 0;
    if (!S.next(0, cur)) return;
    f32x4 acc[2][2][4][2];
#pragma unroll
    for (int a = 0; a < 2; ++a)
#pragma unroll
        for (int b = 0; b < 2; ++b)
#pragma unroll
            for (int m = 0; m < 4; ++m)
#pragma unroll
                for (int n = 0; n < 2; ++n) acc[a][b][m][n] = (f32x4){0.f, 0.f, 0.f, 0.f};
    bf16x8 At[4][2], B0[2][2], B1[2][2]; const int mxone = 0x7f7f7f7f;
    const char* cA = (const char*)g.A + (size_t)cur.pm * tstep; const char* cB = (const char*)g.Bt + (size_t)(cur.pm >> g.gshift) * g.gstrideB + (size_t)cur.pn * tstep;
    S.a_ready(cur);
    if constexpr (SP2) {
        PG8_STAGE(PG8_SB(0, 0), cB, voffB); PG8_STAGE(PG8_SB(0, 1), cB + hstepB, voffB); PG8_STAGE(PG8_SA(0, 0), cA, voffA); PG8_STAGE(PG8_SA(0, 1), cA + hstep, voffA);
        if (wr == 1) PG8_BAR;
        PG8_WAIT_V(2); PG8_BAR;
        PG8_STAGE(PG8_SB(1, 0), cB + kstep, voffB); PG8_STAGE(PG8_SA(1, 0), cA + kstep, voffA); PG8_STAGE(PG8_SB(1, 1), cB + hstepB + kstep, voffB);
        PG8_WAIT_V(6); PG8_BAR;
    } else {
        PG8_STAGE(PG8_SB(0, 0), cB, voffB); PG8_STAGE(PG8_SA(0, 0), cA, voffA); PG8_STAGE(PG8_SB(0, 1), cB + hstepB, voffB); PG8_STAGE(PG8_SA(0, 1), cA + hstep, voffA);
        if (wr == 1) PG8_BAR;
        PG8_WAIT_V(4); PG8_BAR;
        PG8_STAGE(PG8_SB(1, 0), cB + kstep, voffB); PG8_STAGE(PG8_SA(1, 0), cA + kstep, voffA); PG8_STAGE(PG8_SB(1, 1), cB + hstepB + kstep, voffB);
        PG8_WAIT_V(6); PG8_BAR;
    }
    for (;;) {
        const bool has_next = S.next(ui + 1, nxt);
        const char* nA = has_next ? (const char*)g.A + (size_t)nxt.pm * tstep : cA; const char* nB = has_next ? (const char*)g.Bt + (size_t)(nxt.pm >> g.gshift) * g.gstrideB + (size_t)nxt.pn * tstep : cB;
        for (int t = 0; t < nt; t += 2) {
            const bool last = (t == nt - 2);
            if constexpr (Epi::MID_T > 0) { if (t == Epi::MID_T) { if constexpr (MT == 2) asm volatile("s_nop 15\n\ts_nop 7" ::: "memory"); E.mid(acc, cur, wr, wc, fr, fq); } }
            const char* a1 = cA + (size_t)(t + 1) * kstep;
            const char* a2 = last ? nA : cA + (size_t)(t + 2) * kstep; const char* b2 = last ? nB : cB + (size_t)(t + 2) * kstep;
            const char* a3 = a2 + kstep; const char* b3 = b2 + kstep;
            if (last && has_next) S.a_ready(nxt);
            if constexpr (SP2) {
            PG8_LDB(B0, 0, 0); PG8_LDB(B1, 0, 1); PG8_SCHED; PG8_LDA(At, 0, 0); PG8_STAGE(PG8_SA(1, 1), a1 + hstep, voffA);
            PG8_WAIT_V(8); PG8_WAIT_L(0); PG8_BAR; PG8_MMA(0, 0, At, B0); PG8_MMA(0, 1, At, B1); PG8_BAR; PG8_SCHED;
            PG8_LDA(At, 0, 1); PG8_STAGE(PG8_SB(0, 0), b2, voffB); PG8_STAGE(PG8_SB(0, 1), b2 + hstepB, voffB); PG8_STAGE(PG8_SA(0, 0), a2, voffA);
            PG8_WAIT_V(8); PG8_WAIT_L(0); PG8_BAR; PG8_MMA(1, 0, At, B0); PG8_MMA(1, 1, At, B1); PG8_BAR; PG8_SCHED;
            PG8_LDB(B0, 1, 0); PG8_LDB(B1, 1, 1); PG8_SCHED; PG8_LDA(At, 1, 0); PG8_STAGE(PG8_SA(0, 1), a2 + hstep, voffA);
            PG8_WAIT_V(8); PG8_WAIT_L(0); PG8_BAR; PG8_MMA(0, 0, At, B0); PG8_MMA(0, 1, At, B1); PG8_BAR; PG8_SCHED;
            PG8_LDA(At, 1, 1); PG8_STAGE(PG8_SB(1, 0), b3, voffB); PG8_STAGE(PG8_SB(1, 1), b3 + hstepB, voffB); PG8_STAGE(PG8_SA(1, 0), a3, voffA);
            PG8_WAIT_V(8); PG8_WAIT_L(0); PG8_BAR; PG8_MMA(1, 0, At, B0); PG8_MMA(1, 1, At, B1); PG8_BAR; PG8_SCHED;
            } else {
            PG8_LDB(B0, 0, 0); PG8_SCHED; PG8_LDA(At, 0, 0); PG8_STAGE(PG8_SA(1, 1), a1 + hstep, voffA);
            PG8_WAIT_L(8); PG8_BAR; PG8_WAIT_L(0); PG8_MMA(0, 0, At, B0); PG8_BAR; PG8_SCHED;
            PG8_LDB(B1, 0, 1); PG8_STAGE(PG8_SB(0, 0), b2, voffB);
            PG8_BAR; PG8_WAIT_L(0); PG8_MMA(0, 1, At, B1); PG8_BAR;
            PG8_LDA(At, 0, 1); PG8_STAGE(PG8_SA(0, 0), a2, voffA);
            PG8_BAR; PG8_WAIT_L(0); PG8_MMA(1, 0, At, B0); PG8_BAR; PG8_SCHED;
            PG8_STAGE(PG8_SB(0, 1), b2 + hstepB, voffB);
            PG8_WAIT_V(6); PG8_BAR; PG8_MMA(1, 1, At, B1); PG8_BAR;
            PG8_LDB(B0, 1, 0); PG8_SCHED; PG8_LDA(At, 1, 0); PG8_STAGE(PG8_SA(0, 1), a2 + hstep, voffA);
            PG8_WAIT_L(8); PG8_BAR; PG8_WAIT_L(0); PG8_MMA(0, 0, At, B0); PG8_BAR; PG8_SCHED;
            PG8_LDB(B1, 1, 1); PG8_STAGE(PG8_SB(1, 0), b3, voffB);
            PG8_BAR; PG8_WAIT_L(0); PG8_MMA(0, 1, At, B1); PG8_BAR;
            PG8_LDA(At, 1, 1); PG8_STAGE(PG8_SA(1, 0), a3, voffA);
            PG8_BAR; PG8_WAIT_L(0); PG8_MMA(1, 0, At, B0); PG8_BAR; PG8_SCHED;
            PG8_STAGE(PG8_SB(1, 1), b3 + hstepB, voffB);
            PG8_WAIT_V(6); PG8_BAR; PG8_MMA(1, 1, At, B1); PG8_BAR;
            }
        }
        if constexpr (MT == 2) asm volatile("s_nop 15\n\ts_nop 7" ::: "memory");
        if constexpr (ALIGN_EPI) { if (wr == 0) PG8_BAR; }
        if constexpr (!Epi::AFTER_DRAIN) { E(acc, cur, wr, wc, fr, fq); S.done(cur); S.after_unit(ui); }
        if (!has_next) break;
#pragma unroll
        for (int a = 0; a < 2; ++a)
#pragma unroll
            for (int b = 0; b < 2; ++b)
#pragma unroll
                for (int m = 0; m < 4; ++m)
#pragma unroll
                    for (int n = 0; n < 2; ++n) acc[a][b][m][n] = (f32x4){0.f, 0.f, 0.f, 0.f};
        cur = nxt; cA = nA; cB = nB; ++ui;
        if constexpr (ALIGN_EPI) { if (wr == 1) PG8_BAR; }
    }
    PG8_WAIT_V(0);
    if constexpr (!ALIGN_EPI) { if (wr == 0) PG8_BAR; }
    PG8_BAR;
    if constexpr (Epi::AFTER_DRAIN) { E.fused(acc, cur, wr, wc, fr, fq, lds, wid, lane); S.done(cur); }
#undef PG8_SA
#undef PG8_SB
#undef PG8_STAGE
#undef PG8_LDA
#undef PG8_LDB
#undef PG8_MMA
#undef PG8_WAIT_V
#undef PG8_WAIT_L
#undef PG8_BAR
#undef PG8_SCHED
}
}


constexpr int NWAVES = 8;
constexpr bool USE_CG_SYNC = false;
#ifndef REP_MASK
#define REP_MASK 0
#endif
constexpr int RING_OFF = 0, RING_BYTES = 131072;
constexpr int LDSCTL_OFF = RING_BYTES, MISC_OFF = LDSCTL_OFF + 320;
constexpr int LDS_BYTES = 147456;
constexpr int CW_CENSUS = 1024;
constexpr int CW_BAR = 4096;
constexpr size_t CTL_ZERO_BYTES = 1 * MiB;
constexpr int NPH_LAYER = 10, NPHASES = 1 + DEPTH * NPH_LAYER;

struct Frame {
    LAS unsigned char* lds; volatile LAS unsigned* MISC; unsigned* ctl;
    int tid, lane, wave, G, vcu, cid;
    unsigned char* ws;
};
struct Args { const float* in[13]; float* out; unsigned char* ws; int ph_lo, ph_hi, cg_seams, pad; };

__device__ __forceinline__ float wave_sum(float v) {
#pragma unroll
    for (int o = 1; o < 64; o <<= 1) v += __shfl_xor(v, o);
    return v;
}
__device__ __forceinline__ float bflo(unsigned w) { return __builtin_bit_cast(float, w << 16); }
__device__ __forceinline__ float bfhi(unsigned w) { return __builtin_bit_cast(float, w & 0xffff0000u); }

__device__ __forceinline__ unsigned q8x4(float a, float b, float c, float d) {
    const int ia = (int)__builtin_rintf(a), ib = (int)__builtin_rintf(b), ic = (int)__builtin_rintf(c), id = (int)__builtin_rintf(d);
    return (unsigned)(ia & 0xff) | ((unsigned)(ib & 0xff) << 8) | ((unsigned)(ic & 0xff) << 16) | ((unsigned)id << 24);
}
__device__ __forceinline__ float wave_max(float v) {
#pragma unroll
    for (int o = 1; o < 64; o <<= 1) v = fmaxf(v, __shfl_xor(v, o));
    return v;
}
__device__ __forceinline__ void quant_row_store(const f32x4 (&h)[4], signed char* orow, float* scale_out, int lane) {
    float m = 0.f;
#pragma unroll
    for (int j = 0; j < 4; ++j) m = fmaxf(fmaxf(m, fmaxf(fabsf(h[j].x), fabsf(h[j].y))), fmaxf(fabsf(h[j].z), fabsf(h[j].w)));
    m = wave_max(m);
    const float inv = m > 0.f ? 127.f / m : 0.f;
    unsigned* o4 = (unsigned*)orow + lane;
#pragma unroll
    for (int j = 0; j < 4; ++j) o4[64 * j] = q8x4(h[j].x * inv, h[j].y * inv, h[j].z * inv, h[j].w * inv);
    if (lane == 0) *scale_out = m * (1.f / 127.f);
}
__device__ __forceinline__ void rms_row_to_i8(const float* xrow, const float* gain, signed char* orow, float* scale_out, int lane) {
    const f32x4* xr = (const f32x4*)xrow + lane; const f32x4* gr = (const f32x4*)gain + lane;
    f32x4 v[4]; float s = 0.f;
#pragma unroll
    for (int j = 0; j < 4; ++j) { v[j] = xr[64 * j]; s += (v[j].x * v[j].x + v[j].y * v[j].y) + (v[j].z * v[j].z + v[j].w * v[j].w); }
    const float rstd = rsqrtf(wave_sum(s) * (1.f / DM) + EPS);
#pragma unroll
    for (int j = 0; j < 4; ++j) { const f32x4 g = gr[64 * j]; v[j].x *= rstd * g.x; v[j].y *= rstd * g.y; v[j].z *= rstd * g.z; v[j].w *= rstd * g.w; }
    quant_row_store(v, orow, scale_out, lane);
}
__device__ __forceinline__ void p0_q8_block_item(Frame& F, const float* W, int N, int n0, signed char* WQ, float* wsc, int mode, LAS float* red) {
    const int lane = F.lane, w = F.wave;
    const float* p = W + (size_t)(128 * w) * N + n0 + lane;
    float v[128]; float m = 0.f;
#pragma unroll
    for (int i = 0; i < 128; ++i) v[i] = __builtin_nontemporal_load(p + (size_t)i * N);
#pragma unroll
    for (int i = 0; i < 128; ++i) m = fmaxf(m, fabsf(v[i]));
    red[w * 64 + lane] = m;
    __syncthreads();
    float M = red[lane];
#pragma unroll
    for (int j = 1; j < 8; ++j) M = fmaxf(M, red[j * 64 + lane]);
    const float inv = M > 0.f ? 127.f / M : 0.f;
    const int ng = n0 + lane;
    const int np = (mode == 0) ? ng : ((ng >> 7) * 256 + ((ng >> 2) & 1) * 128 + ((ng >> 5) & 3) * 32 + (mode == 2 ? 16 : 0) + ((ng >> 3) & 3) * 4 + (ng & 3));
    v4u* o = (v4u*)(WQ + (size_t)np * 1024 + 128 * w);
#pragma unroll
    for (int i = 0; i < 8; ++i) { v4u q; q.x = q8x4(v[16 * i] * inv, v[16 * i + 1] * inv, v[16 * i + 2] * inv, v[16 * i + 3] * inv); q.y = q8x4(v[16 * i + 4] * inv, v[16 * i + 5] * inv, v[16 * i + 6] * inv, v[16 * i + 7] * inv);
        q.z = q8x4(v[16 * i + 8] * inv, v[16 * i + 9] * inv, v[16 * i + 10] * inv, v[16 * i + 11] * inv); q.w = q8x4(v[16 * i + 12] * inv, v[16 * i + 13] * inv, v[16 * i + 14] * inv, v[16 * i + 15] * inv); o[i] = q; }
    if (w == 0) wsc[np] = M * (1.f / 127.f);
    __syncthreads();
}
__device__ __forceinline__ void p0_tr16_item(const float* W, int K, int N, bf16* WT, int ldo, int koff, int item, int lane) {
    const int nblk = N / 128, kb = item / nblk, nb = item % nblk, k0 = 32 * kb, n0 = 128 * nb;
    const f32x2_t* p = (const f32x2_t*)(W + (size_t)k0 * N + n0) + lane; const size_t rstep = (size_t)N / 2;
    f32x2_t v[32];
#pragma unroll
    for (int i = 0; i < 32; ++i) v[i] = p[(size_t)i * rstep];
    v4u* o0 = (v4u*)(WT + (size_t)(n0 + 2 * lane) * ldo + koff + k0); v4u* o1 = (v4u*)(WT + (size_t)(n0 + 2 * lane + 1) * ldo + koff + k0);
#pragma unroll
    for (int i = 0; i < 4; ++i) { v4u q0, q1;
        q0.x = pk2(v[8 * i].x, v[8 * i + 1].x); q0.y = pk2(v[8 * i + 2].x, v[8 * i + 3].x); q0.z = pk2(v[8 * i + 4].x, v[8 * i + 5].x); q0.w = pk2(v[8 * i + 6].x, v[8 * i + 7].x);
        q1.x = pk2(v[8 * i].y, v[8 * i + 1].y); q1.y = pk2(v[8 * i + 2].y, v[8 * i + 3].y); q1.z = pk2(v[8 * i + 4].y, v[8 * i + 5].y); q1.w = pk2(v[8 * i + 6].y, v[8 * i + 7].y);
        o0[i] = q0; o1[i] = q1; }
}
struct TrTile { const float* W; bf16* WT; int N, ldo, koff, k0, n0, fp8; };
__device__ __forceinline__ void p0_tr_load(const TrTile& t, f32x4 (&v)[8], const int w, const int lane) {
    const float* p = t.W + (size_t)(t.k0 + 8 * w) * t.N + t.n0 + 4 * lane;
#pragma unroll
    for (int i = 0; i < 8; ++i) v[i] = __builtin_nontemporal_load((const f32x4*)(p + (size_t)i * t.N));
}
__device__ __forceinline__ void p0_tr_store(Frame& F, const TrTile& t, const f32x4 (&v)[8], LAS float* buf) {
    const int w = F.wave, lane = F.lane, tid = F.tid;
#pragma unroll
    for (int i = 0; i < 8; ++i) *(LAS f32x4*)(buf + (8 * w + i) * 256 + 4 * lane) = v[i];
    __syncthreads();
    const int n = tid & 255;
#pragma unroll
    for (int j = 0; j < 4; ++j) { const int kc = (tid >> 8) + 2 * j; const LAS float* sp = buf + (8 * kc) * 256 + n;
        v4u o; o.x = pk2(sp[0], sp[256]); o.y = pk2(sp[2 * 256], sp[3 * 256]); o.z = pk2(sp[4 * 256], sp[5 * 256]); o.w = pk2(sp[6 * 256], sp[7 * 256]);
        *(v4u*)(t.WT + (size_t)(t.n0 + n) * t.ldo + t.koff + t.k0 + 8 * kc) = o; }
}
__device__ __forceinline__ void p0_tr_store_fp8(Frame& F, const TrTile& t, const f32x4 (&v)[8], LAS float* buf) {
    const int w = F.wave, lane = F.lane;
#pragma unroll
    for (int i = 0; i < 8; ++i) *(LAS f32x4*)(buf + (8 * w + i) * 256 + 4 * (lane ^ (4 * (w >> 1)))) = v[i];
    __syncthreads();
    unsigned char* W8 = (unsigned char*)t.WT; const float lim = fp8_lim(); const int kq = lane & 3;
#pragma unroll
    for (int jj = 0; jj < 2; ++jj) { const int n = 32 * w + 16 * jj + (lane >> 2); const LAS float* sp = buf + (16 * kq) * 256 + 4 * ((n >> 2) ^ (4 * kq)) + (n & 3);
        u32x4 o;
        o.x = fp8x4(sp[0] * 64.f, sp[256] * 64.f, sp[2 * 256] * 64.f, sp[3 * 256] * 64.f, lim); o.y = fp8x4(sp[4 * 256] * 64.f, sp[5 * 256] * 64.f, sp[6 * 256] * 64.f, sp[7 * 256] * 64.f, lim);
        o.z = fp8x4(sp[8 * 256] * 64.f, sp[9 * 256] * 64.f, sp[10 * 256] * 64.f, sp[11 * 256] * 64.f, lim); o.w = fp8x4(sp[12 * 256] * 64.f, sp[13 * 256] * 64.f, sp[14 * 256] * 64.f, sp[15 * 256] * 64.f, lim);
        __builtin_nontemporal_store(o, (u32x4*)(W8 + (size_t)(t.n0 + n) * t.ldo + t.koff + t.k0 + 16 * kq)); }
}
__device__ __forceinline__ void phase_p0(Frame& F, const Args& a) {
    const int gw = F.vcu * NWAVES + F.wave, NGW = F.G * NWAVES;
    unsigned char* ws = F.ws;
    {   constexpr int B_IN = NIN / 64, B_G = FF / 64, B_TOT = DEPTH * B_IN + 2 * DEPTH * NE * B_G;
        LAS float* red = (LAS float*)(F.lds + RING_OFF);
        struct Q8Item { const float* W; signed char* WQ; float* wsc; int N, n0, mode; };
        auto decode = [&](int it, Q8Item& q) { int r = it;
            if (r < DEPTH * B_IN) { const int l = r / B_IN; r %= B_IN; q.W = a.in[1] + (size_t)l * DM * NIN; q.N = NIN; q.n0 = 64 * r; q.WQ = (signed char*)(ws + WS_WIN) + (size_t)l * NIN * DM; q.wsc = (float*)(ws + WS_WINS) + l * NIN; q.mode = 0; return; }
            r -= DEPTH * B_IN; const int which = r / (DEPTH * NE * B_G); r %= (DEPTH * NE * B_G); const int le = r / B_G; r %= B_G;
            q.W = a.in[which ? 10 : 9] + (size_t)le * DM * FF; q.N = FF; q.n0 = 64 * r; q.WQ = (signed char*)(ws + WS_WGU) + (size_t)le * 2 * FF * DM; q.wsc = (float*)(ws + WS_WGUS) + (size_t)le * 2 * FF; q.mode = which ? 2 : 1; };
        float v[128]; Q8Item cur, nxt; const int lane = F.lane, w = F.wave;
#define P0_Q8_LOAD(q_) do { const float* p_ = (q_).W + (size_t)(128 * w) * (q_).N + (q_).n0 + lane; _Pragma("unroll") for (int i = 0; i < 128; ++i) v[i] = __builtin_nontemporal_load(p_ + (size_t)i * (q_).N); } while (0)
        int it = F.vcu, par = 0;
        if (it < B_TOT) { decode(it, cur); P0_Q8_LOAD(cur); }
#pragma unroll 1
        for (; it < B_TOT; it += F.G, par ^= 1) {
            const bool more = it + F.G < B_TOT; if (more) decode(it + F.G, nxt);
            float m = 0.f;
#pragma unroll
            for (int i = 0; i < 128; ++i) m = fmaxf(m, fabsf(v[i]));
            red[par * 512 + w * 64 + lane] = m;
            __syncthreads();
            float M = red[par * 512 + lane];
#pragma unroll
            for (int j = 1; j < 8; ++j) M = fmaxf(M, red[par * 512 + j * 64 + lane]);
            const float inv = M > 0.f ? 127.f / M : 0.f;
            v4u q[8];
#pragma unroll
            for (int i = 0; i < 8; ++i) { q[i].x = q8x4(v[16 * i] * inv, v[16 * i + 1] * inv, v[16 * i + 2] * inv, v[16 * i + 3] * inv); q[i].y = q8x4(v[16 * i + 4] * inv, v[16 * i + 5] * inv, v[16 * i + 6] * inv, v[16 * i + 7] * inv);
                q[i].z = q8x4(v[16 * i + 8] * inv, v[16 * i + 9] * inv, v[16 * i + 10] * inv, v[16 * i + 11] * inv); q[i].w = q8x4(v[16 * i + 12] * inv, v[16 * i + 13] * inv, v[16 * i + 14] * inv, v[16 * i + 15] * inv); }
#define P0_NP(ng_) ((cur.mode == 0) ? (ng_) : (((ng_) >> 7) * 256 + (((ng_) >> 2) & 1) * 128 + (((ng_) >> 5) & 3) * 32 + (cur.mode == 2 ? 16 : 0) + (((ng_) >> 3) & 3) * 4 + ((ng_) & 3)))
            {   LAS unsigned char* tb = F.lds + RING_OFF + 8192 + w * (64 * 144);
#pragma unroll
                for (int i = 0; i < 8; ++i) *(LAS v4u*)(tb + lane * 144 + i * 16) = q[i];
                const int g8 = lane >> 3, j8 = lane & 7;
#pragma unroll
                for (int i = 0; i < 8; ++i) { const int c = 8 * g8 + i; const v4u r = *(const LAS v4u*)(tb + c * 144 + j8 * 16); const int ngc = cur.n0 + c, npc = P0_NP(ngc);
                    __builtin_nontemporal_store(r, (v4u*)(cur.WQ + (size_t)npc * 1024 + 128 * w + 16 * j8)); } }
            if (w == 0) { const int ng = cur.n0 + lane; cur.wsc[P0_NP(ng)] = M * (1.f / 127.f); }
#undef P0_NP
            if (more) { cur = nxt; P0_Q8_LOAD(cur); }
        }
#undef P0_Q8_LOAD
        __syncthreads();
    }
    {   constexpr int T_AO = (AW / 64) * (DM / 256), T_RO = (RW / 64) * (DM / 256), T_O = (DM / 64) * (DM / 256), T_D = (FF / 64) * (DM / 256);
        constexpr int T_LAYER = T_AO + T_RO + T_O + NE * T_D, T_TOT = DEPTH * T_LAYER;
        LAS float* buf = (LAS float*)(F.lds + RING_OFF);
        auto decode = [&](int it, TrTile& t) {
            const int l = it / T_LAYER; int r = it % T_LAYER; t.fp8 = 0;
            if (r < T_AO) { t.W = a.in[2] + (size_t)l * AW * DM; t.N = DM; t.WT = (bf16*)(ws + WS_WCAT + (size_t)l * DM * CATW); t.ldo = CATW; t.koff = 0; t.fp8 = 1; }
            else if ((r -= T_AO) < T_RO) { t.W = a.in[3] + (size_t)l * RW * DM; t.N = DM; t.WT = (bf16*)(ws + WS_WCAT + (size_t)l * DM * CATW); t.ldo = CATW; t.koff = AW; t.fp8 = 1; }
            else if ((r -= T_RO) < T_O) { t.W = a.in[4] + (size_t)l * DM * DM; t.N = DM; t.WT = (bf16*)(ws + WS_WO) + (size_t)l * DM * DM; t.ldo = DM; t.koff = 0; }
            else { r -= T_O; const int e = r / T_D; r %= T_D; const size_t le = (size_t)l * NE + e; t.W = a.in[11] + le * FF * DM; t.N = DM; t.ldo = FF; t.koff = 0;
                t.WT = (bf16*)(ws + WS_WDN + le * DM * FF); t.fp8 = 1; }
            t.k0 = 64 * (r >> 2); t.n0 = 256 * (r & 3);
        };
        TrTile cur, nx1, nx2; f32x4 v[8], v1[8], v2[8];
        GAS unsigned* qg = (GAS unsigned*)F.ctl; asm volatile("" : "+s"(qg)); unsigned* tq = (unsigned*)qg + CW_TQ; volatile LAS unsigned* aq = F.MISC + 40;
        if (F.tid == 0) { aq[0] = xb_add(tq, 1u); aq[1] = xb_add(tq, 1u); aq[2] = xb_add(tq, 1u); }
        __syncthreads();
        int i0 = __builtin_amdgcn_readfirstlane((int)aq[0]), i1 = __builtin_amdgcn_readfirstlane((int)aq[1]), i2 = __builtin_amdgcn_readfirstlane((int)aq[2]), tpar = 0;
        if (i0 < T_TOT) { decode(i0, cur); p0_tr_load(cur, v, F.wave, F.lane); }
        if (i1 < T_TOT) { decode(i1, nx1); p0_tr_load(nx1, v1, F.wave, F.lane); }
#pragma unroll 1
        while (i0 < T_TOT) {
            unsigned f = (unsigned)T_TOT; if (F.tid == 0 && i2 < T_TOT) f = xb_add(tq, 1u);
            if (i2 < T_TOT) { decode(i2, nx2); p0_tr_load(nx2, v2, F.wave, F.lane); }
            if (F.tid == 0) aq[4 + tpar] = f;
            if (cur.fp8) p0_tr_store_fp8(F, cur, v, buf + tpar * 16384); else p0_tr_store(F, cur, v, buf + tpar * 16384);
            const int i3 = __builtin_amdgcn_readfirstlane((int)aq[4 + tpar]);
            tpar ^= 1; cur = nx1; nx1 = nx2; i0 = i1; i1 = i2; i2 = i3;
#pragma unroll
            for (int i = 0; i < 8; ++i) { v[i] = v1[i]; v1[i] = v2[i]; }
        }
        __syncthreads();
    }
#pragma unroll 1
    for (int m = gw; m < T; m += 4 * NGW) {
        f32x4 xv[4][4];
#pragma unroll
        for (int r = 0; r < 4; ++r) { const int mr = (m + r * NGW < T) ? m + r * NGW : m; const f32x4* xr = (const f32x4*)(a.in[0] + (size_t)mr * DM) + F.lane;
#pragma unroll
            for (int j = 0; j < 4; ++j) xv[r][j] = xr[64 * j]; }
#pragma unroll
        for (int r = 0; r < 4; ++r) { const int mr = m + r * NGW; if (mr < T) {
            float ss = 0.f;
#pragma unroll
            for (int j = 0; j < 4; ++j) ss += (xv[r][j].x * xv[r][j].x + xv[r][j].y * xv[r][j].y) + (xv[r][j].z * xv[r][j].z + xv[r][j].w * xv[r][j].w);
            const float rstd = rsqrtf(wave_sum(ss) * (1.f / DM) + EPS); const f32x4* gr = (const f32x4*)a.in[6] + F.lane;
#pragma unroll
            for (int j = 0; j < 4; ++j) { const f32x4 g = gr[64 * j]; xv[r][j].x *= rstd * g.x; xv[r][j].y *= rstd * g.y; xv[r][j].z *= rstd * g.z; xv[r][j].w *= rstd * g.w; }
            quant_row_store(xv[r], (signed char*)(ws + WS_H) + (size_t)mr * DM, (float*)(ws + WS_HS) + mr, F.lane); } }
    }
}

struct FinIn { u32x2 yf[4], yb[4], gq[4]; float l0, l1, l2; v4u p0, p1, p2; };
__device__ __forceinline__ void fin_load(FinIn& I, const int t, const int lane, const bf16* PROJ, const bf16* YF, const bf16* YB, const bf16* ATTO, const float* LSE) {
#pragma unroll
    for (int j = 0; j < 4; ++j) { const int c = 256 * j + 4 * lane;
        I.yf[j] = __builtin_nontemporal_load((const u32x2*)(YF + (size_t)t * RW + c)); I.yb[j] = __builtin_nontemporal_load((const u32x2*)(YB + (size_t)t * RW + c)); I.gq[j] = __builtin_nontemporal_load((const u32x2*)(PROJ + PO_RG + (size_t)t * RW + c)); }
    const int hh = lane >> 3, c = 8 * lane;
    I.l0 = LSE[((size_t)0 * T + t) * 8 + hh]; I.l1 = LSE[((size_t)1 * T + t) * 8 + hh]; I.l2 = LSE[((size_t)2 * T + t) * 8 + hh];
    I.p0 = __builtin_nontemporal_load((const v4u*)(ATTO + ((size_t)0 * T + t) * AW + c)); I.p1 = __builtin_nontemporal_load((const v4u*)(ATTO + ((size_t)1 * T + t) * AW + c)); I.p2 = __builtin_nontemporal_load((const v4u*)(ATTO + ((size_t)2 * T + t) * AW + c));
}
__device__ __forceinline__ void fin_compute(const FinIn& I, const int t, const int lane, unsigned char* CAT) {
    unsigned char* crow = CAT + (size_t)t * CATW; const float lim = fp8_lim();
#pragma unroll
    for (int j = 0; j < 4; ++j) {
        const int c = 256 * j + 4 * lane; const u32x2 yf = I.yf[j], yb = I.yb[j], gq = I.gq[j];
        const float r0 = bflo(yf.x) + bflo(yb.x), r1 = bfhi(yf.x) + bfhi(yb.x), r2 = bflo(yf.y) + bflo(yb.y), r3 = bfhi(yf.y) + bfhi(yb.y);
        const float rstd = rsqrtf(wave_sum((r0 * r0 + r1 * r1) + (r2 * r2 + r3 * r3)) * (1.f / 256.f) + EPS);
        const float g0 = bflo(gq.x), g1 = bfhi(gq.x), g2 = bflo(gq.y), g3 = bfhi(gq.y);
        const float rs16 = rstd * 16.f;
        *(unsigned*)(crow + AW + c) = fp8x4(siluf_(g0) * r0 * rs16, siluf_(g1) * r1 * rs16, siluf_(g2) * r2 * rs16, siluf_(g3) * r3 * rs16, lim);
    }
    {
        const int c = 8 * lane; const float l0 = I.l0, l1 = I.l1, l2 = I.l2; const v4u p0 = I.p0, p1 = I.p1, p2 = I.p2;
        const float mx = fmaxf(l0, fmaxf(l1, l2)); float w0 = __expf(l0 - mx), w1 = __expf(l1 - mx), w2 = __expf(l2 - mx); const float inv = 16.f * __builtin_amdgcn_rcpf(w0 + w1 + w2); w0 *= inv; w1 *= inv; w2 *= inv;
        u32x2 o;
        o.x = fp8x4(w0 * bflo(p0.x) + w1 * bflo(p1.x) + w2 * bflo(p2.x), w0 * bfhi(p0.x) + w1 * bfhi(p1.x) + w2 * bfhi(p2.x), w0 * bflo(p0.y) + w1 * bflo(p1.y) + w2 * bflo(p2.y), w0 * bfhi(p0.y) + w1 * bfhi(p1.y) + w2 * bfhi(p2.y), lim);
        o.y = fp8x4(w0 * bflo(p0.z) + w1 * bflo(p1.z) + w2 * bflo(p2.z), w0 * bfhi(p0.z) + w1 * bfhi(p1.z) + w2 * bfhi(p2.z), w0 * bflo(p0.w) + w1 * bflo(p1.w) + w2 * bflo(p2.w), w0 * bfhi(p0.w) + w1 * bfhi(p1.w) + w2 * bfhi(p2.w), lim);
        *(u32x2*)(crow + c) = o;
    }
}
__device__ __forceinline__ void phase_finalize(Frame& F, const Args& a) {
    unsigned char* ws = F.ws; const bf16* PROJ = (const bf16*)(ws + WS_PROJ); const bf16* YF = (const bf16*)(ws + WS_YF); const bf16* YB = (const bf16*)(ws + WS_YB);
    const bf16* ATTO = (const bf16*)(ws + WS_ATTO); const float* LSE = (const float*)(ws + WS_LSE); unsigned char* CAT = ws + WS_CAT;
    const int gw = F.vcu * NWAVES + F.wave, NGW = F.G * NWAVES, lane = F.lane;
    const bool blk = (F.G * 64 == T); const int t0 = blk ? 64 * F.vcu + F.wave : gw, ts = blk ? NWAVES : NGW, tend = blk ? 64 * F.vcu + 64 : T;
#pragma unroll 1
    for (int t = t0; t < tend; t += 2 * ts) {
        FinIn A, B; const int t2 = t + ts; const bool two = t2 < tend;
        fin_load(A, t, lane, PROJ, YF, YB, ATTO, LSE); fin_load(B, two ? t2 : t, lane, PROJ, YF, YB, ATTO, LSE);
        fin_compute(A, t, lane, CAT); if (two) fin_compute(B, t2, lane, CAT);
    }
}

__device__ __forceinline__ void phase_norm_router(Frame& F, const Args& a, int layer) {
    unsigned char* ws = F.ws; const bf16* x = (const bf16*)(ws + WS_XB); const float* gain = a.in[7] + (size_t)layer * DM; const float* wr = a.in[8] + (size_t)layer * DM * NE;
    signed char* H8 = (signed char*)(ws + WS_H); float* HS = (float*)(ws + WS_HS); float* AFF = (float*)(ws + WS_AFF);
    LAS unsigned short* WH = (LAS unsigned short*)(F.lds + RING_OFF);
    LAS unsigned short* WL = WH + 16384;
    LAS float* GL = (LAS float*)(F.lds + RING_OFF + 65536);
    const int lane = F.lane, tq = lane & 15, kg = lane >> 4, kh = F.wave & 1, c0 = 2 * kh, c1 = 2 * kh + 1, tfirst = F.vcu * 4;
    LAS float* EX = (LAS float*)(F.lds + RING_OFF + 73728);
    v4u xa[8], xb[8];
#define RT_LOAD(buf, c) do { _Pragma("unroll") for (int s8 = 0; s8 < 8; ++s8) buf[s8] = *(const v4u*)(xr + 32 * (8 * (c) + s8)); } while (0)
#define RT_X0(r_) ((f32x4){bflo((r_).x), bfhi((r_).x), bflo((r_).y), bfhi((r_).y)})
#define RT_X1(r_) ((f32x4){bflo((r_).z), bfhi((r_).z), bflo((r_).w), bfhi((r_).w)})
#define RT_P1(buf, c) do { _Pragma("unroll") for (int s8 = 0; s8 < 8; ++s8) { const int sk = 8 * (c) + s8; \
                const f32x4 g0 = *(const LAS f32x4*)(GL + 32 * sk + 8 * kg), g1 = *(const LAS f32x4*)(GL + 32 * sk + 8 * kg + 4); \
                const f32x4 x0 = RT_X0(buf[s8]), x1 = RT_X1(buf[s8]); \
                ss += ((x0.x * x0.x + x0.y * x0.y) + (x0.z * x0.z + x0.w * x0.w)) + ((x1.x * x1.x + x1.y * x1.y) + (x1.z * x1.z + x1.w * x1.w)); \
                const f32x4 v0 = x0 * g0, v1 = x1 * g1; \
                mx = fmaxf(mx, fmaxf(fmaxf(fmaxf(fabsf(v0.x), fabsf(v0.y)), fmaxf(fabsf(v0.z), fabsf(v0.w))), fmaxf(fmaxf(fabsf(v1.x), fabsf(v1.y)), fmaxf(fabsf(v1.z), fabsf(v1.w))))); \
                v4u hi; hi.x = pk2(v0.x, v0.y); hi.y = pk2(v0.z, v0.w); hi.z = pk2(v1.x, v1.y); hi.w = pk2(v1.z, v1.w); \
                v4u lo; lo.x = pk2(v0.x - bflo(hi.x), v0.y - bfhi(hi.x)); lo.y = pk2(v0.z - bflo(hi.y), v0.w - bfhi(hi.y)); lo.z = pk2(v1.x - bflo(hi.z), v1.y - bfhi(hi.z)); lo.w = pk2(v1.z - bflo(hi.w), v1.w - bfhi(hi.w)); \
                const bf16x8 wh = *(const LAS bf16x8*)(WH + ((sk * 4 + kg) * 16 + tq) * 8), wl = *(const LAS bf16x8*)(WL + ((sk * 4 + kg) * 16 + tq) * 8); \
                const bf16x8 ah = __builtin_bit_cast(bf16x8, hi), al = __builtin_bit_cast(bf16x8, lo); \
                acc = __builtin_amdgcn_mfma_f32_16x16x32_bf16(ah, wh, acc, 0, 0, 0); acc = __builtin_amdgcn_mfma_f32_16x16x32_bf16(al, wh, acc, 0, 0, 0); acc = __builtin_amdgcn_mfma_f32_16x16x32_bf16(ah, wl, acc, 0, 0, 0); } } while (0)
#define RT_P2(buf, c) do { _Pragma("unroll") for (int s8 = 0; s8 < 8; ++s8) { const int sk = 8 * (c) + s8; \
                const f32x4 g0 = *(const LAS f32x4*)(GL + 32 * sk + 8 * kg) * qi, g1 = *(const LAS f32x4*)(GL + 32 * sk + 8 * kg + 4) * qi; \
                v4u r_ = buf[s8]; asm volatile("" : "+v"(r_.x), "+v"(r_.y), "+v"(r_.z), "+v"(r_.w));        \
                const f32x4 x0 = RT_X0(r_), x1 = RT_X1(r_); u32x2 o; o.x = q8x4(x0.x * g0.x, x0.y * g0.y, x0.z * g0.z, x0.w * g0.w); o.y = q8x4(x1.x * g1.x, x1.y * g1.y, x1.z * g1.z, x1.w * g1.w); \
                *(u32x2*)(orow + 32 * sk) = o; } } while (0)
#define SB __builtin_amdgcn_sched_barrier(0)
    if (tfirst < T / 16) { const bf16* xr = x + (size_t)(16 * (tfirst + (F.wave >> 1)) + tq) * DM + 8 * kg; RT_LOAD(xa, c0); RT_LOAD(xb, c1); }
    SB;
#pragma unroll
    for (int kh = 0; kh < 2; ++kh) {   f32x4 wv[4];
#pragma unroll
        for (int k = 0; k < 4; ++k) wv[k] = ((const f32x4*)wr)[F.tid + 512 * (4 * kh + k)];
#pragma unroll
        for (int k = 0; k < 4; ++k) { const int i4 = F.tid + 512 * (4 * kh + k), d = i4 >> 2, e0 = (i4 & 3) * 4; const int base = (((d >> 5) * 4 + ((d >> 3) & 3)) * 16) * 8 + (d & 7);
#pragma unroll
            for (int c = 0; c < 4; ++c) { const float w = wv[k][c]; const unsigned hi = pk2(w, 0.f) & 0xffffu; const float lo = w - bflo(hi);
                WH[base + (e0 + c) * 8] = (unsigned short)hi; WL[base + (e0 + c) * 8] = (unsigned short)(pk2(lo, 0.f) & 0xffffu); } } }
    for (int i = F.tid; i < DM / 4; i += NWAVES * 64) ((LAS f32x4*)GL)[i] = ((const f32x4*)gain)[i];
    __syncthreads();
#pragma unroll 1
    for (int t0 = tfirst; t0 < T / 16; t0 += F.G * 4) {
        const int tile = t0 + (F.wave >> 1), token = 16 * tile + tq; const bf16* xr = x + (size_t)token * DM + 8 * kg;
        if (t0 != tfirst) { RT_LOAD(xa, c0); RT_LOAD(xb, c1); }
        f32x4 acc = {0.f, 0.f, 0.f, 0.f}; float ss = 0.f, mx = 0.f;
        SB; RT_P1(xa, c0); SB; RT_P1(xb, c1); SB;
        ss += __shfl_xor(ss, 16); ss += __shfl_xor(ss, 32); mx = fmaxf(mx, __shfl_xor(mx, 16)); mx = fmaxf(mx, __shfl_xor(mx, 32));
        {   LAS float* ex = EX + (F.wave * 64 + lane) * 8; *(LAS f32x4*)ex = acc; *(LAS f32x2_t*)(ex + 4) = (f32x2_t){ss, mx}; }
        __syncthreads();
        {   const LAS float* ex = EX + ((F.wave ^ 1) * 64 + lane) * 8; const f32x4 pa = *(const LAS f32x4*)ex; const f32x2_t pm = *(const LAS f32x2_t*)(ex + 4); acc += pa; ss += pm.x; mx = fmaxf(mx, pm.y); }
        const float rstd = rsqrtf(ss * (1.f / DM) + EPS);
        float pv[2];
#pragma unroll
        for (int rr = 0; rr < 2; ++rr) { const int r = 2 * kh + rr; const float l = (kh ? acc[2 + rr] : acc[rr]) * __shfl(rstd, 4 * kg + r);
            float m = l; m = fmaxf(m, __shfl_xor(m, 1)); m = fmaxf(m, __shfl_xor(m, 2)); m = fmaxf(m, __shfl_xor(m, 4)); m = fmaxf(m, __shfl_xor(m, 8));
            const float p = __expf(l - m); float den = p; den += __shfl_xor(den, 1); den += __shfl_xor(den, 2); den += __shfl_xor(den, 4); den += __shfl_xor(den, 8);
            pv[rr] = p / den; }
        *(f32x2_t*)(AFF + (size_t)((tile >> 7) * NE + tq) * SEQ + 16 * (tile & 127) + 4 * kg + 2 * kh) = (f32x2_t){pv[0], pv[1]};
        const float qi = mx > 0.f ? 127.f / mx : 0.f;
        signed char* orow = H8 + (size_t)token * DM + 8 * kg;
        SB; RT_P2(xa, c0); SB; RT_P2(xb, c1);
        if (kg == 0 && kh == 0) HS[token] = mx * rstd * (1.f / 127.f);
        __syncthreads();
    }
#undef SB
#undef RT_LOAD
#undef RT_X0
#undef RT_X1
#undef RT_P1
#undef RT_P2
}

__device__ __forceinline__ int block_excl_scan(Frame& F, const int v, LAS int* wsum) {
    int inc = v;
#pragma unroll
    for (int o = 1; o < 64; o <<= 1) { const int t = __shfl_up(inc, o); if (F.lane >= o) inc += t; }
    if (F.lane == 63) wsum[F.wave] = inc;
    __syncthreads();
    int off = 0;
#pragma unroll
    for (int w = 0; w < NWAVES; ++w) off += (w < F.wave) ? wsum[w] : 0;
    __syncthreads();
    return off + inc - v;
}
constexpr int GROWS = 18;
__device__ __forceinline__ void phase_topk(Frame& F, const Args& a) {
    unsigned char* ws = F.ws; const float* AFF = (const float*)(ws + WS_AFF); const signed char* H8 = (const signed char*)(ws + WS_H); const float* HS = (const float*)(ws + WS_HS);
    int* IDX = (int*)(ws + WS_IDX); float* GW = (float*)(ws + WS_GW); int* SLOT = (int*)(ws + WS_SLOT); signed char* XIN = (signed char*)(ws + WS_XIN); float* XS = (float*)(ws + WS_XS);
    LAS int* hist = (LAS int*)(F.lds + RING_OFF);
    LAS int* res = hist + 256;
    LAS int* wsum = hist + 272;
    LAS int* cnt = hist + 288;
    LAS int* selt = hist + 512;
    LAS int* selr = hist + 1024;
    const int tid = F.tid, lane = F.lane;
#pragma unroll 1
    for (int u = F.vcu; u < NB * NE * 2; u += F.G) {
        const int half = u & 1, be = u >> 1, b = be >> 4, e = be & 15;
        unsigned key[4];
        {   const u32x4 kv = *(const u32x4*)(AFF + (size_t)(b * NE + e) * SEQ + 4 * tid);
            key[0] = kv.x; key[1] = kv.y; key[2] = kv.z; key[3] = kv.w; }
        unsigned prefix = 0; int k = CAP; int one = 1; asm volatile("" : "+v"(one));
#pragma unroll
        for (int pass = 0; pass < 4; ++pass) { const int shift = 24 - 8 * pass;
            __syncthreads();
            if (tid < 256) hist[tid] = 0;
            if (tid == 0) cnt[0] = 0;
            __syncthreads();
#pragma unroll
            for (int i = 0; i < 4; ++i) if (pass == 0 || (key[i] >> (shift + 8)) == prefix) __hip_atomic_fetch_add(&hist[(key[i] >> shift) & 255], one, __ATOMIC_RELAXED, __HIP_MEMORY_SCOPE_WORKGROUP);
            __syncthreads();
            if (F.wave == 0) {
                const int c0 = hist[4 * lane], c1 = hist[4 * lane + 1], c2 = hist[4 * lane + 2], c3 = hist[4 * lane + 3]; const int t = (c0 + c1) + (c2 + c3);
                int suf = t;
#pragma unroll
                for (int o = 1; o < 64; o <<= 1) { const int v = __shfl_down(suf, o); if (lane + o < 64) suf += v; }
                int cum = suf - t;
                if (cum < k && cum + t >= k) { int d = 3;
                    if (cum + c3 >= k) d = 3; else { cum += c3; if (cum + c2 >= k) d = 2; else { cum += c2; if (cum + c1 >= k) d = 1; else { cum += c1; d = 0; } } }
                    res[0] = 4 * lane + d; res[1] = k - cum; }
            }
            __syncthreads();
            prefix = (prefix << 8) | (unsigned)res[0]; k = res[1];
        }
        int eqc = 0;
#pragma unroll
        for (int i = 0; i < 4; ++i) eqc += (key[i] == prefix) ? 1 : 0;
        int eqpre = block_excl_scan(F, eqc, wsum);
        int selc = 0; bool sel[4];
#pragma unroll
        for (int i = 0; i < 4; ++i) { const bool eq = key[i] == prefix; sel[i] = key[i] > prefix || (eq && eqpre < k); eqpre += eq ? 1 : 0; selc += sel[i] ? 1 : 0; }
        int pre = block_excl_scan(F, selc, wsum);
        if ((tid >> 8) == half) {
            int sl[4];
#pragma unroll
            for (int i = 0; i < 4; ++i) { sl[i] = -1;
                if (sel[i]) { sl[i] = pre; const int row = (e * NB + b) * CAP + pre, tok = b * SEQ + 4 * tid + i; IDX[row] = tok; GW[row] = __uint_as_float(key[i]);
                    const int p = __hip_atomic_fetch_add(cnt, 1, __ATOMIC_RELAXED, __HIP_MEMORY_SCOPE_WORKGROUP); selt[p] = tok; selr[p] = row; ++pre; } }
            *(int4*)(SLOT + (size_t)(b * NE + e) * SEQ + 4 * tid) = make_int4(sl[0], sl[1], sl[2], sl[3]);
        }
        __syncthreads();
        const int n = cnt[0];
#pragma unroll 1
        for (int i0 = F.wave; i0 < n; i0 += GROWS * NWAVES) {
            v4u r[GROWS]; float sc[GROWS]; int row[GROWS];
#pragma unroll
            for (int j = 0; j < GROWS; ++j) { const int ii = (i0 + j * NWAVES < n) ? i0 + j * NWAVES : n - 1; const int tok = selt[ii]; row[j] = selr[ii]; r[j] = ((const v4u*)(H8 + (size_t)tok * DM))[lane]; sc[j] = HS[tok]; }
#pragma unroll
            for (int j = 0; j < GROWS; ++j) { ((v4u*)(XIN + (size_t)row[j] * DM))[lane] = r[j]; XS[row[j]] = sc[j]; }
        }
    }
    __syncthreads();
}

struct CmbIn { f32x4 v[4]; int sl; };
__device__ __forceinline__ void cmb_load(CmbIn& I, const int t, const int lane, const bf16* x, const int* SLOT) {
    const int b = t / SEQ, s = t % SEQ; const u32x2* xr = (const u32x2*)(x + (size_t)t * DM) + lane;
#pragma unroll
    for (int j = 0; j < 4; ++j) { const u32x2 r = __builtin_nontemporal_load(xr + 64 * j); I.v[j] = (f32x4){bflo(r.x), bfhi(r.x), bflo(r.y), bfhi(r.y)}; }
    I.sl = SLOT[(size_t)(b * NE + (lane & 15)) * SEQ + s];
}
__device__ __forceinline__ void cmb_add_rows(CmbIn& I, const int t, const int lane, const unsigned char* Y) {
    const int b = t / SEQ;
    unsigned m = (unsigned)(__ballot(I.sl >= 0) & 0xffffull);
    while (m) {
        const int e0 = __builtin_ctz(m); m &= m - 1; const int e1 = m ? __builtin_ctz(m) : e0; const bool two = m != 0; m &= m - 1;
        const int s0 = __builtin_amdgcn_readlane(I.sl, e0), s1 = __builtin_amdgcn_readlane(I.sl, e1);
        const unsigned* y0 = (const unsigned*)(Y + ((size_t)(e0 * NB + b) * CAP + s0) * DM) + lane; const unsigned* y1 = (const unsigned*)(Y + ((size_t)(e1 * NB + b) * CAP + s1) * DM) + lane;
        unsigned a[4], c[4];
#pragma unroll
        for (int j = 0; j < 4; ++j) { a[j] = y0[64 * j]; c[j] = y1[64 * j]; }
#pragma unroll
        for (int j = 0; j < 4; ++j) { const auto a01 = __builtin_amdgcn_cvt_pk_f32_fp8((int)a[j], false), a23 = __builtin_amdgcn_cvt_pk_f32_fp8((int)a[j], true);
            I.v[j].x += a01[0] * (1.f / 64.f); I.v[j].y += a01[1] * (1.f / 64.f); I.v[j].z += a23[0] * (1.f / 64.f); I.v[j].w += a23[1] * (1.f / 64.f);
            if (two) { const auto c01 = __builtin_amdgcn_cvt_pk_f32_fp8((int)c[j], false), c23 = __builtin_amdgcn_cvt_pk_f32_fp8((int)c[j], true);
                I.v[j].x += c01[0] * (1.f / 64.f); I.v[j].y += c01[1] * (1.f / 64.f); I.v[j].z += c23[0] * (1.f / 64.f); I.v[j].w += c23[1] * (1.f / 64.f); } }
    }
}
__device__ __forceinline__ void cmb_acc(CmbIn& I, const unsigned (&r)[4]) {
#pragma unroll
    for (int j = 0; j < 4; ++j) { const auto a01 = __builtin_amdgcn_cvt_pk_f32_fp8((int)r[j], false), a23 = __builtin_amdgcn_cvt_pk_f32_fp8((int)r[j], true);
        I.v[j].x += a01[0] * (1.f / 64.f); I.v[j].y += a01[1] * (1.f / 64.f); I.v[j].z += a23[0] * (1.f / 64.f); I.v[j].w += a23[1] * (1.f / 64.f); }
}
template <int NT, int NR> __device__ __forceinline__ void cmb_add_rowsN(CmbIn (&I)[NT], const int (&tok)[NT], const bool (&on)[NT], const int lane, const unsigned char* Y) {
    unsigned m[NT]; unsigned any = 0u;
#pragma unroll
    for (int q = 0; q < NT; ++q) { m[q] = on[q] ? (unsigned)(__ballot(I[q].sl >= 0) & 0xffffull) : 0u; any |= m[q]; }
    while (any) {
        bool h[NT][NR]; unsigned r[NT][NR][4];
#pragma unroll
        for (int q = 0; q < NT; ++q) { const int bq = tok[q] / SEQ;
#pragma unroll
            for (int k = 0; k < NR; ++k) {
                h[q][k] = m[q] != 0; const int e = h[q][k] ? __builtin_ctz(m[q]) : 0; m[q] &= m[q] - 1; const int sl = h[q][k] ? __builtin_amdgcn_readlane(I[q].sl, e) : 0;
                const unsigned* y = (const unsigned*)(Y + ((size_t)(e * NB + bq) * CAP + sl) * DM) + lane;
#pragma unroll
                for (int j = 0; j < 4; ++j) r[q][k][j] = y[64 * j]; } }
        any = 0u;
#pragma unroll
        for (int q = 0; q < NT; ++q) { any |= m[q];
#pragma unroll
            for (int k = 0; k < NR; ++k) { if (h[q][k]) cmb_acc(I[q], r[q][k]); } }
    }
}
__device__ __forceinline__ void cmb_finish(CmbIn& I, const int t, const int lane, bf16* x, float* outf, const float* gain, const bool final_, signed char* H8, float* HS) {
    u32x2* xr = (u32x2*)(x + (size_t)t * DM) + lane; f32x4* fr_ = (f32x4*)(outf + (size_t)t * DM) + lane; const f32x4* gr = (const f32x4*)gain + lane;
    float ss = 0.f;
    f32x4 gv[4];
#pragma unroll
    for (int j = 0; j < 4; ++j) gv[j] = gr[64 * j];
#pragma unroll
    for (int j = 0; j < 4; ++j) ss += (I.v[j].x * I.v[j].x + I.v[j].y * I.v[j].y) + (I.v[j].z * I.v[j].z + I.v[j].w * I.v[j].w);
    const float rstd = rsqrtf(wave_sum(ss) * (1.f / DM) + EPS);
    if (!final_) {
#pragma unroll
        for (int j = 0; j < 4; ++j) { const f32x4 g = gv[j]; u32x2 xo; xo.x = pk2(I.v[j].x, I.v[j].y); xo.y = pk2(I.v[j].z, I.v[j].w); __builtin_nontemporal_store(xo, xr + 64 * j); I.v[j].x *= rstd * g.x; I.v[j].y *= rstd * g.y; I.v[j].z *= rstd * g.z; I.v[j].w *= rstd * g.w; }
        quant_row_store(I.v, H8 + (size_t)t * DM, HS + t, lane); }
    else {
#pragma unroll
        for (int j = 0; j < 4; ++j) { const f32x4 g = gv[j]; f32x4 o; o.x = I.v[j].x * rstd * g.x; o.y = I.v[j].y * rstd * g.y; o.z = I.v[j].z * rstd * g.z; o.w = I.v[j].w * rstd * g.w; fr_[64 * j] = o; } }
}
__device__ __forceinline__ void phase_combine_norm(Frame& F, const Args& a, int layer) {
    unsigned char* ws = F.ws; bf16* x = (bf16*)(ws + WS_XB); const unsigned char* Y = ws + WS_Y; const int* SLOT = (const int*)(ws + WS_SLOT); signed char* H8 = (signed char*)(ws + WS_H); float* HS = (float*)(ws + WS_HS);
    const bool final_ = (layer + 1 == DEPTH); const float* gain = final_ ? a.in[12] : a.in[6] + (size_t)(layer + 1) * DM;
    const int gw = F.vcu * NWAVES + F.wave, NGW = F.G * NWAVES, lane = F.lane;
    const bool blk = (F.G * 64 == T); const int t0 = blk ? 64 * F.vcu + F.wave : gw, ts = blk ? NWAVES : NGW, tend = blk ? 64 * F.vcu + 64 : T;
    constexpr int CT = 4;
    CmbIn I[CT], In[CT];
    if (t0 < tend) {
#pragma unroll
        for (int q = 0; q < CT; ++q) cmb_load(I[q], (t0 + q * ts < tend) ? t0 + q * ts : t0, lane, x, SLOT); }
#pragma unroll 1
    for (int t = t0; t < tend; t += CT * ts) {
        const int tn = t + CT * ts; int tok[CT]; bool on[CT];
#pragma unroll
        for (int q = 0; q < CT; ++q) { on[q] = t + q * ts < tend; tok[q] = on[q] ? t + q * ts : t; In[q] = I[q]; }
        if (tn < tend) {
#pragma unroll
            for (int q = 0; q < CT; ++q) cmb_load(In[q], (tn + q * ts < tend) ? tn + q * ts : tn, lane, x, SLOT); }
        cmb_add_rowsN<CT, 2>(I, tok, on, lane, Y);
#pragma unroll
        for (int q = 0; q < CT; ++q) { if (on[q]) cmb_finish(I[q], tok[q], lane, x, a.out, gain, final_, H8, HS); }
#pragma unroll
        for (int q = 0; q < CT; ++q) I[q] = In[q];
    }
}

typedef short s16x4 __attribute__((ext_vector_type(4)));
constexpr int AT_ROWB = 128;
constexpr int AT_KOFF = 0, AT_VOFF = 256 * AT_ROWB, AT_BUF = 2 * 256 * AT_ROWB;
#define LDS_BAR() do { asm volatile("s_waitcnt lgkmcnt(0)" ::: "memory"); __builtin_amdgcn_s_barrier(); asm volatile("" ::: "memory"); } while (0)
struct AttnPre { v4u k[4], v[4]; bf16x8 q0, q1; };
__device__ __forceinline__ void attn_decode(const int su, int& g, int& b, int& h, int& r, int& u, int& dsh) {
    const int x = su & 15; h = (su >> 4) & 7; b = (su >> 7) & 7; g = su >> 10; dsh = 2 * g; r = x & ((1 << dsh) - 1); u = x >> dsh;
}
__device__ __forceinline__ void attn_issue(Frame& F, const int su, const bf16* __restrict__ PROJ, AttnPre& P) {
    int g, b, h, r, u, dsh; attn_decode(su, g, b, h, r, u, dsh); const int d = 1 << dsh, L = SEQ >> dsh;
    const bf16* kbase = PROJ + PO_ATT + ((((size_t)(g * 3 + 1) * 8 + b) * 8 + h) * 2048 + (size_t)r * L) * 64;
    constexpr size_t PART = (size_t)8 * 8 * 2048 * 64;
#pragma unroll
    for (int p = 0; p < 4; ++p) { const int idx = F.tid + 512 * p, kk = idx >> 3, ch = idx & 7;
        int lp = 128 * u - 64 + kk; lp = lp < 0 ? 0 : (lp > L - 1 ? L - 1 : lp);
        const bf16* src = kbase + (size_t)lp * 64 + ch * 8;
        P.k[p] = *(const v4u*)src; P.v[p] = *(const v4u*)(src + PART); }
    const int lq = 128 * u + 16 * F.wave + (F.lane & 15);
    const bf16* qp = kbase - PART + (size_t)lq * 64 + 8 * (F.lane >> 4);
    P.q0 = *(const bf16x8*)qp; P.q1 = *(const bf16x8*)(qp + 32);
}
__device__ __forceinline__ void attn_stage(Frame& F, const AttnPre& P, const int boff) {
    LAS unsigned char* Ks = F.lds + RING_OFF + boff + AT_KOFF; LAS unsigned char* Vs = F.lds + RING_OFF + boff + AT_VOFF;
#pragma unroll
    for (int p = 0; p < 4; ++p) { const int idx = F.tid + 512 * p, kk = idx >> 3, ch = idx & 7, o = kk * AT_ROWB + ((ch ^ (kk & 7)) << 4);
        *(LAS v4u*)(Ks + o) = P.k[p]; *(LAS v4u*)(Vs + o) = P.v[p]; }
}
__device__ __forceinline__ void attn_compute(Frame& F, const int su, const bf16x8 qf0, const bf16x8 qf1, bf16* __restrict__ ATTO, float* __restrict__ LSEb, const int boff) {
    int g, b, h, r, u, dsh; attn_decode(su, g, b, h, r, u, dsh); const int d = 1 << dsh, L = SEQ >> dsh;
    const int lane = F.lane, w = F.wave, q = lane & 15, kg = lane >> 4;
    LAS unsigned char* Ks = F.lds + RING_OFF + boff + AT_KOFF; LAS unsigned char* Vs = F.lds + RING_OFF + boff + AT_VOFF;
    const int lq = 128 * u + 16 * w + q; const size_t tokq = (size_t)(b * SEQ + lq * d + r);
    f32x4 sc[9];
    {   const LAS unsigned char* kp = Ks + (16 * w + q) * AT_ROWB; const int ko0 = (kg ^ (q & 7)) << 4, ko1 = ko0 ^ 64;
#pragma unroll
        for (int hb = 0; hb < 2; ++hb) { bf16x8 kf[5][2];
#pragma unroll
            for (int i = 0; i < 5; ++i) if (5 * hb + i < 9) { kf[i][0] = *(const LAS bf16x8*)(kp + (5 * hb + i) * 16 * AT_ROWB + ko0); kf[i][1] = *(const LAS bf16x8*)(kp + (5 * hb + i) * 16 * AT_ROWB + ko1); }
            __builtin_amdgcn_sched_barrier(0);
#pragma unroll
            for (int i = 0; i < 5; ++i) if (5 * hb + i < 9) sc[5 * hb + i] = __builtin_amdgcn_mfma_f32_16x16x32_bf16(kf[i][0], qf0, (f32x4){0.f, 0.f, 0.f, 0.f}, 0, 0, 0);
#pragma unroll
            for (int i = 0; i < 5; ++i) if (5 * hb + i < 9) sc[5 * hb + i] = __builtin_amdgcn_mfma_f32_16x16x32_bf16(kf[i][1], qf1, sc[5 * hb + i], 0, 0, 0);
            __builtin_amdgcn_sched_barrier(0); } }
    const float c1 = 0.125f * 1.4426950408889634f, c2 = __builtin_amdgcn_exp2f(-(float)(h + 1)) * (float)d * 1.4426950408889634f;
    f32x2_t ce2[2], ae2[2]; bool ge0[4], le0[4];
#pragma unroll
    for (int rr = 0; rr < 4; ++rr) { const int e = 4 * kg + rr - q; ce2[rr >> 1][rr & 1] = c2 * (float)e; ae2[rr >> 1][rr & 1] = -c2 * (float)(e < 0 ? -e : e); ge0[rr] = e >= 0; le0[rr] = e <= 0; }
    const f32x2_t c1v = {c1, c1};
    float mx = -INFINITY;
#pragma unroll
    for (int i = 0; i < 9; ++i) { const bool ok = (unsigned)(128 * u - 64 + 16 * (w + i)) < (unsigned)L;
        const float ki = ok ? -c2 * (float)(i < 4 ? 64 - 16 * i : (i == 4 ? 0 : 16 * i - 64)) : -INFINITY; const f32x2_t kiv = {ki, ki};
#pragma unroll
        for (int pr = 0; pr < 2; ++pr) { const f32x2_t bias = (i < 4) ? kiv + ce2[pr] : (i == 4) ? kiv + ae2[pr] : kiv - ce2[pr];
            f32x2_t v = (f32x2_t){sc[i][2 * pr], sc[i][2 * pr + 1]} * c1v + bias;
            if (i == 0) { v[0] = ge0[2 * pr] ? v[0] : -INFINITY; v[1] = ge0[2 * pr + 1] ? v[1] : -INFINITY; }
            if (i == 8) { v[0] = le0[2 * pr] ? v[0] : -INFINITY; v[1] = le0[2 * pr + 1] ? v[1] : -INFINITY; }
            sc[i][2 * pr] = v[0]; sc[i][2 * pr + 1] = v[1]; mx = fmaxf(mx, fmaxf(v[0], v[1])); } }
    mx = fmaxf(mx, __shfl_xor(mx, 16)); mx = fmaxf(mx, __shfl_xor(mx, 32));
    float sum = 0.f; s16x4 pf[9]; const f32x2_t nmx = {-mx, -mx}; f32x2_t sum2 = {0.f, 0.f};
#pragma unroll
    for (int i = 0; i < 9; ++i) { const f32x2_t d0 = (f32x2_t){sc[i][0], sc[i][1]} + nmx, d1 = (f32x2_t){sc[i][2], sc[i][3]} + nmx;
        const f32x2_t p01 = {__builtin_amdgcn_exp2f(d0[0]), __builtin_amdgcn_exp2f(d0[1])}, p23 = {__builtin_amdgcn_exp2f(d1[0]), __builtin_amdgcn_exp2f(d1[1])};
        sum2 += p01 + p23; const unsigned lo = pk2(p01[0], p01[1]), hi = pk2(p23[0], p23[1]);
        pf[i] = (s16x4){(short)(lo & 0xffff), (short)(lo >> 16), (short)(hi & 0xffff), (short)(hi >> 16)}; }
    sum = sum2[0] + sum2[1];
    sum += __shfl_xor(sum, 16); sum += __shfl_xor(sum, 32);
    const float inv = 1.f / sum;
    const LAS unsigned char* vp = Vs + (16 * w + 4 * kg + (q >> 2)) * AT_ROWB + 8 * (q & 1); const int vm = (4 * kg + (q >> 2)) & 7, vc = (q & 3) >> 1;
    bf16* op = ATTO + ((size_t)g * T + tokq) * AW + h * 64 + 4 * kg;
#pragma unroll
    for (int dh = 0; dh < 2; ++dh) { s16x4 vf[2][9];
#pragma unroll
        for (int dd = 0; dd < 2; ++dd)
#pragma unroll
            for (int i = 0; i < 9; ++i) vf[dd][i] = __builtin_bit_cast(s16x4, __builtin_amdgcn_ds_read_tr16_b64_v4i16((LAS s16x4*)(vp + i * 16 * AT_ROWB + (((2 * (2 * dh + dd) + vc) ^ vm) << 4))));
        __builtin_amdgcn_sched_barrier(0);
        f32x4 acc[2] = {{0.f, 0.f, 0.f, 0.f}, {0.f, 0.f, 0.f, 0.f}};
#pragma unroll
        for (int i = 0; i < 9; ++i) { acc[0] = __builtin_amdgcn_mfma_f32_16x16x16bf16_1k(vf[0][i], pf[i], acc[0], 0, 0, 0); acc[1] = __builtin_amdgcn_mfma_f32_16x16x16bf16_1k(vf[1][i], pf[i], acc[1], 0, 0, 0); }
#pragma unroll
        for (int dd = 0; dd < 2; ++dd) { u32x2 o; o.x = pk2(acc[dd][0] * inv, acc[dd][1] * inv); o.y = pk2(acc[dd][2] * inv, acc[dd][3] * inv);
            *(u32x2*)(op + 16 * (2 * dh + dd)) = o; } }
    if (kg == 0) LSEb[((size_t)g * T + tokq) * 8 + h] = (mx + __log2f(sum)) * 0.6931471805599453f;
}
__device__ __forceinline__ void phase_attn(Frame& F, const Args& a, const int layer, const bool dyn) {
    unsigned char* ws = F.ws; const bf16* PROJ = (const bf16*)(ws + WS_PROJ);
    constexpr int NSU = 3 * NB * 8 * 16;
    AttnPre P;
    bf16x8 qc0, qc1;
    if (dyn) {
        constexpr int NQ = 3 * 8 * 16;
        GAS unsigned* qg = (GAS unsigned*)F.ctl; asm volatile("" : "+s"(qg)); unsigned* qctr = (unsigned*)qg + CW_AQ + 64 * (unsigned)__builtin_amdgcn_readfirstlane((int)F.MISC[3]) + layer;
        const int xb = F.vcu >> 5; volatile LAS unsigned* aq = F.MISC + 32;
        auto su_of = [&](int li) { return ((li >> 7) << 10) | (xb << 7) | (li & 127); };
        if (F.tid == 0) { aq[0] = xb_add(qctr, 1u); aq[1] = xb_add(qctr, 1u); aq[2] = xb_add(qctr, 1u); }
        __syncthreads();
        int u0 = __builtin_amdgcn_readfirstlane((int)aq[0]), u1 = __builtin_amdgcn_readfirstlane((int)aq[1]), u2 = __builtin_amdgcn_readfirstlane((int)aq[2]);
        if (u0 < NQ) { attn_issue(F, su_of(u0), PROJ, P); attn_stage(F, P, 0); qc0 = P.q0; qc1 = P.q1; if (u1 < NQ) attn_issue(F, su_of(u1), PROJ, P); }
        LDS_BAR();
#pragma unroll 1
        for (int par = 0; u0 < NQ; par ^= 1) {
            unsigned f = (unsigned)NQ; if (F.tid == 0 && u2 < NQ) f = xb_add(qctr, 1u);
            bf16x8 qn0 = qc0, qn1 = qc1;
            if (u1 < NQ) { attn_stage(F, P, (par ^ 1) * AT_BUF); qn0 = P.q0; qn1 = P.q1; if (u2 < NQ) attn_issue(F, su_of(u2), PROJ, P); }
            attn_compute(F, su_of(u0), qc0, qc1, (bf16*)(ws + WS_ATTO), (float*)(ws + WS_LSE), par * AT_BUF);
            if (F.tid == 0) aq[4 + par] = f;
            LDS_BAR();
            const int u3 = __builtin_amdgcn_readfirstlane((int)aq[4 + par]);
            u0 = u1; u1 = u2; u2 = u3; qc0 = qn0; qc1 = qn1;
        }
        __syncthreads();
        return;
    }
    if (F.vcu < NSU) { attn_issue(F, F.vcu, PROJ, P); attn_stage(F, P, 0); qc0 = P.q0; qc1 = P.q1; if (F.vcu + F.G < NSU) attn_issue(F, F.vcu + F.G, PROJ, P); }
    LDS_BAR();
#pragma unroll 1
    for (int su = F.vcu, par = 0; su < NSU; su += F.G, par ^= 1) {
        bf16x8 qn0 = qc0, qn1 = qc1;
        if (su + F.G < NSU) { attn_stage(F, P, (par ^ 1) * AT_BUF); qn0 = P.q0; qn1 = P.q1;
            if (su + 2 * F.G < NSU) attn_issue(F, su + 2 * F.G, PROJ, P); }
        attn_compute(F, su, qc0, qc1, (bf16*)(ws + WS_ATTO), (float*)(ws + WS_LSE), par * AT_BUF);
        LDS_BAR();
        qc0 = qn0; qc1 = qn1;
    }
    __syncthreads();
}
constexpr int RT_ROWB = 528, RT_ROWS = 144, RT_KB = 64 * RT_ROWB, RT_VB = 64 * RT_ROWS;
constexpr int RT_K = 0, RT_S = 2 * RT_KB, RT_V = 3 * RT_KB, RT_P = RT_V + 2 * RT_VB, RT_END = RT_P + RT_VB;
static_assert(RT_END <= RING_BYTES, "retention LDS map");
__device__ __forceinline__ void ret_unit(Frame& F, const int unit, const bf16* __restrict__ PROJ, const float* __restrict__ dlog, bf16* __restrict__ YF, bf16* __restrict__ YB) {
    const int dvs = unit & 3, dir = (unit >> 2) & 1, h = (unit >> 3) & 3, b = unit >> 5;
    const int tid = F.tid, lane = F.lane, w = F.wave, fr = lane & 15, kg = lane >> 4;
    LAS unsigned char* L0 = F.lds + RING_OFF;
    const float lg = -log1pf(expf(-dlog[dir * 4 + h]));
    const float gC = __expf(lg * 64.f);
    const int srow = tid >> 5, sch = tid & 31, vrow = tid >> 3, vch = tid & 7;
    float zeta[4];
#pragma unroll
    for (int p = 0; p < 4; ++p) { const int m = srow + 16 * p; zeta[p] = __expf(lg * (float)(dir ? m : 63 - m)); }
    const int qt = w >> 1, half = w & 1;
    const int nq = 16 * qt + fr;
    const float rho = __expf(lg * (float)(dir ? -nq : nq - 63)) * 0.0625f;
    const bf16* qbase = PROJ + PO_RQK + ((size_t)(b * 4 + h) * 2048 + nq) * 256 + 8 * kg;
    const bf16* colk = PROJ + PO_RQK + (size_t)T * RW + ((size_t)(b * 4 + h) * 2048) * 256 + sch * 8; const bf16* colv = PROJ + PO_RV + (((size_t)(b * 4 + h) * 4 + dvs) * 2048) * 64 + vch * 8;
    bf16* Yo = (dir ? YB : YF) + h * 256 + dvs * 64;
    __syncthreads();
    { unsigned z = 0u; asm volatile("" : "+v"(z));
      for (int i = tid; i < 64 * RT_ROWB / 16; i += NWAVES * 64) ((LAS v4u*)(L0 + RT_S))[i] = (v4u){z, z, z, z}; }
    f32x4 st[2][4];
#pragma unroll
    for (int a = 0; a < 2; ++a)
#pragma unroll
        for (int c = 0; c < 4; ++c) st[a][c] = (f32x4){0.f, 0.f, 0.f, 0.f};
    v4u pk[4], pv; bf16x8 qc[8], qn[8];
#define RET_LOADKV(ci_) do { const size_t t0_ = (size_t)64 * (ci_); _Pragma("unroll") for (int p = 0; p < 4; ++p) pk[p] = *(const v4u*)(colk + (t0_ + srow + 16 * p) * 256); pv = *(const v4u*)(colv + (t0_ + vrow) * 64); } while (0)
#define RET_LOADQ(dst, ci_) do { const bf16* qg_ = qbase + ((size_t)64 * (ci_)) * 256; _Pragma("unroll") for (int s = 0; s < 8; ++s) dst[s] = *(const bf16x8*)(qg_ + 32 * s); } while (0)
#define RET_STAGE(bf_) do { LAS unsigned char* kb_ = L0 + RT_K + (bf_) * RT_KB; _Pragma("unroll") for (int p = 0; p < 4; ++p) { const int row = srow + 16 * p; const float z = zeta[p]; v4u kk = pk[p]; \
            kk.x = pk2(bflo(kk.x) * z, bfhi(kk.x) * z); kk.y = pk2(bflo(kk.y) * z, bfhi(kk.y) * z); kk.z = pk2(bflo(kk.z) * z, bfhi(kk.z) * z); kk.w = pk2(bflo(kk.w) * z, bfhi(kk.w) * z); \
            *(LAS v4u*)(kb_ + row * RT_ROWB + sch * 16) = kk; } \
        LAS unsigned short* vt = (LAS unsigned short*)(L0 + RT_V + (bf_) * RT_VB) + vrow; \
        vt[(8 * vch + 0) * 72] = (unsigned short)(pv.x & 0xffff); vt[(8 * vch + 1) * 72] = (unsigned short)(pv.x >> 16); \
        vt[(8 * vch + 2) * 72] = (unsigned short)(pv.y & 0xffff); vt[(8 * vch + 3) * 72] = (unsigned short)(pv.y >> 16); \
        vt[(8 * vch + 4) * 72] = (unsigned short)(pv.z & 0xffff); vt[(8 * vch + 5) * 72] = (unsigned short)(pv.z >> 16); \
        vt[(8 * vch + 6) * 72] = (unsigned short)(pv.w & 0xffff); vt[(8 * vch + 7) * 72] = (unsigned short)(pv.w >> 16); } while (0)
    {   const int cf = dir ? 31 : 0, cs = dir ? 30 : 1;
        RET_LOADKV(cf); RET_LOADQ(qc, cf); RET_STAGE(0); RET_LOADKV(cs); }
    LDS_BAR();
#pragma unroll 1
    for (int step = 0; step < 32; ++step) {
        const int ci = dir ? 31 - step : step, cur = step & 1;
        const LAS unsigned char* Kc = L0 + RT_K + cur * RT_KB; const LAS unsigned char* Vc = L0 + RT_V + cur * RT_VB;
        if (step + 1 < 32) { RET_STAGE(cur ^ 1); if (step + 2 < 32) RET_LOADKV(dir ? ci - 2 : ci + 2); RET_LOADQ(qn, dir ? ci - 1 : ci + 1); }
        {   const LAS unsigned char* kp = Kc + (32 * half + fr) * RT_ROWB + 16 * kg;
            f32x4 acc[2] = {{0.f, 0.f, 0.f, 0.f}, {0.f, 0.f, 0.f, 0.f}};
#pragma unroll
            for (int hs = 0; hs < 2; ++hs) { bf16x8 kf[2][4];
#pragma unroll
                for (int s = 0; s < 4; ++s) { kf[0][s] = *(const LAS bf16x8*)(kp + 64 * (4 * hs + s)); kf[1][s] = *(const LAS bf16x8*)(kp + 16 * RT_ROWB + 64 * (4 * hs + s)); }
                __builtin_amdgcn_sched_barrier(0);
#pragma unroll
                for (int s = 0; s < 4; ++s) { acc[0] = __builtin_amdgcn_mfma_f32_16x16x32_bf16(kf[0][s], qc[4 * hs + s], acc[0], 0, 0, 0); acc[1] = __builtin_amdgcn_mfma_f32_16x16x32_bf16(kf[1][s], qc[4 * hs + s], acc[1], 0, 0, 0); }
                __builtin_amdgcn_sched_barrier(0); }
#pragma unroll
            for (int j = 0; j < 2; ++j) { const int m0 = 32 * half + 16 * j + 4 * kg;
                float p0 = acc[j][0], p1 = acc[j][1], p2 = acc[j][2], p3 = acc[j][3];
                if (dir) { p0 = (m0 + 0 > nq) ? p0 : 0.f; p1 = (m0 + 1 > nq) ? p1 : 0.f; p2 = (m0 + 2 > nq) ? p2 : 0.f; p3 = (m0 + 3 > nq) ? p3 : 0.f; }
                else     { p0 = (m0 + 0 <= nq) ? p0 : 0.f; p1 = (m0 + 1 <= nq) ? p1 : 0.f; p2 = (m0 + 2 <= nq) ? p2 : 0.f; p3 = (m0 + 3 <= nq) ? p3 : 0.f; }
                u32x2 o; o.x = pk2(p0, p1); o.y = pk2(p2, p3);
                *(LAS u32x2*)(L0 + RT_P + nq * RT_ROWS + m0 * 2) = o; } }
        {   bf16x8 vf[4][2], kf[2][2];
#pragma unroll
            for (int c = 0; c < 4; ++c)
#pragma unroll
                for (int s = 0; s < 2; ++s) vf[c][s] = *(const LAS bf16x8*)(Vc + (16 * c + fr) * RT_ROWS + 64 * s + 16 * kg);
#pragma unroll
            for (int a = 0; a < 2; ++a)
#pragma unroll
                for (int s = 0; s < 2; ++s) {
                    const LAS unsigned char* tp = Kc + (32 * s + 8 * kg + (fr >> 2)) * RT_ROWB + (16 * (2 * w + a) + 4 * (fr & 3)) * 2;
                    const s16x4 lo = __builtin_bit_cast(s16x4, __builtin_amdgcn_ds_read_tr16_b64_v4i16((LAS s16x4*)tp));
                    const s16x4 hi = __builtin_bit_cast(s16x4, __builtin_amdgcn_ds_read_tr16_b64_v4i16((LAS s16x4*)(tp + 4 * RT_ROWB)));
                    kf[a][s] = (bf16x8){lo[0], lo[1], lo[2], lo[3], hi[0], hi[1], hi[2], hi[3]}; }
            __builtin_amdgcn_sched_barrier(0);
#pragma unroll
            for (int s = 0; s < 2; ++s)
#pragma unroll
                for (int a = 0; a < 2; ++a)
#pragma unroll
                    for (int c = 0; c < 4; ++c) st[a][c] = __builtin_amdgcn_mfma_f32_16x16x32_bf16(kf[a][s], vf[c][s], st[a][c], 0, 0, 0); }
        LDS_BAR();
        {   bf16x8 pf[2], vf[2][2];
            const LAS unsigned char* pp = L0 + RT_P + (16 * qt + fr) * RT_ROWS + 16 * kg; pf[0] = *(const LAS bf16x8*)pp; pf[1] = *(const LAS bf16x8*)(pp + 64);
            const LAS unsigned char* vp = Vc + (32 * half + fr) * RT_ROWS + 16 * kg;
            const LAS unsigned char* sp = L0 + RT_S + (32 * half + fr) * RT_ROWB + 16 * kg;
#pragma unroll
            for (int j = 0; j < 2; ++j) { vf[j][0] = *(const LAS bf16x8*)(vp + j * 16 * RT_ROWS); vf[j][1] = *(const LAS bf16x8*)(vp + j * 16 * RT_ROWS + 64); }
            f32x4 acc[2] = {{0.f, 0.f, 0.f, 0.f}, {0.f, 0.f, 0.f, 0.f}};
#pragma unroll
            for (int hs = 0; hs < 2; ++hs) { bf16x8 sf[2][4];
#pragma unroll
                for (int s = 0; s < 4; ++s) { sf[0][s] = *(const LAS bf16x8*)(sp + 64 * (4 * hs + s)); sf[1][s] = *(const LAS bf16x8*)(sp + 16 * RT_ROWB + 64 * (4 * hs + s)); }
                __builtin_amdgcn_sched_barrier(0);
                if (hs == 0) {
#pragma unroll
                    for (int s = 0; s < 2; ++s) { acc[0] = __builtin_amdgcn_mfma_f32_16x16x32_bf16(vf[0][s], pf[s], acc[0], 0, 0, 0); acc[1] = __builtin_amdgcn_mfma_f32_16x16x32_bf16(vf[1][s], pf[s], acc[1], 0, 0, 0); } }
#pragma unroll
                for (int s = 0; s < 4; ++s) { acc[0] = __builtin_amdgcn_mfma_f32_16x16x32_bf16(sf[0][s], qc[4 * hs + s], acc[0], 0, 0, 0); acc[1] = __builtin_amdgcn_mfma_f32_16x16x32_bf16(sf[1][s], qc[4 * hs + s], acc[1], 0, 0, 0); }
                __builtin_amdgcn_sched_barrier(0); }
            const size_t tok = (size_t)b * SEQ + 64 * ci + nq;
#pragma unroll
            for (int j = 0; j < 2; ++j) { u32x2 o; o.x = pk2(acc[j][0] * rho, acc[j][1] * rho); o.y = pk2(acc[j][2] * rho, acc[j][3] * rho);
                *(u32x2*)(Yo + tok * RW + 16 * (2 * half + j) + 4 * kg) = o; } }
        LDS_BAR();
#pragma unroll
        for (int a = 0; a < 2; ++a)
#pragma unroll
            for (int c = 0; c < 4; ++c) { st[a][c] *= gC; u32x2 o; o.x = pk2(st[a][c][0], st[a][c][1]); o.y = pk2(st[a][c][2], st[a][c][3]);
                *(LAS u32x2*)(L0 + RT_S + (16 * c + fr) * RT_ROWB + (16 * (2 * w + a) + 4 * kg) * 2) = o; }
        if (step + 1 < 32) {
#pragma unroll
            for (int s = 0; s < 8; ++s) qc[s] = qn[s]; }
    }
#undef RET_LOADKV
#undef RET_LOADQ
#undef RET_STAGE
    __syncthreads();
}
__device__ __forceinline__ void phase_mix(Frame& F, const Args& a, int layer) {
    unsigned char* ws = F.ws; const bf16* PROJ = (const bf16*)(ws + WS_PROJ);
#ifndef REP_RET
#define REP_RET 1
#define REP_ATTN 1
#endif
#pragma unroll 1
    for (int rr = 0; rr < REP_RET; ++rr)
#pragma unroll 1
    for (int unit = F.vcu; unit < NB * 4 * 4 * 2; unit += F.G) ret_unit(F, unit, PROJ, a.in[5] + layer * 8, (bf16*)(ws + WS_YF), (bf16*)(ws + WS_YB));
    const bool dyn = __builtin_amdgcn_readfirstlane((int)F.MISC[2]) != 0 && F.G == 256 && REP_MASK == 0 && REP_RET == 1 && REP_ATTN == 1;
#pragma unroll 1
    for (int rr = 0; rr < REP_ATTN; ++rr) phase_attn(F, a, layer, dyn);
}


constexpr int popc10(int m) { int c = 0; for (int k = 0; k < 10; ++k) c += (m >> k) & 1; return c; }
constexpr int REP0 = (REP_MASK >> 10) & 1, SLOTS_LAYER = NPH_LAYER + popc10(REP_MASK), NSLOTS = 1 + REP0 + DEPTH * SLOTS_LAYER;
__device__ __forceinline__ int slot_phase(int slot) {
#if REP_MASK
    if (slot <= REP0) return 0;
    const int s = slot - 1 - REP0, layer = s / SLOTS_LAYER; int j = s % SLOTS_LAYER, k = 0;
    for (;;) { const int n = 1 + ((REP_MASK >> k) & 1); if (j < n) break; j -= n; ++k; }
    return 1 + layer * NPH_LAYER + k;
#else
    return slot;
#endif
}
__global__ void __launch_bounds__(NWAVES * 64, 2) mega(Args args) {
    extern __shared__ __attribute__((aligned(16))) unsigned char lds[];
    Frame F;
    F.lds = (LAS unsigned char*)lds; F.MISC = (volatile LAS unsigned*)(F.lds + MISC_OFF);
    F.tid = threadIdx.x; F.lane = F.tid & 63; F.wave = __builtin_amdgcn_readfirstlane(F.tid >> 6);
    F.G = gridDim.x;
    unsigned char* ws = args.ws; F.ctl = (unsigned*)(ws + WS_CTL);
    for (int u = F.tid; u < (LDS_BYTES - LDSCTL_OFF) / 4; u += NWAVES * 64) ((LAS unsigned*)(F.lds + LDSCTL_OFF))[u] = 0u;
    __syncthreads();
    if (F.tid == 0) {
        unsigned* cen = F.ctl + CW_CENSUS; const unsigned x = xb_xcc_id(); const unsigned slot = xb_add(&cen[64 * x], 1u);
        unsigned cnt[16]; unsigned sum = 0, sp = 0;
        for (;;) { sum = 0;
#pragma unroll
            for (int j = 0; j < 16; ++j) { cnt[j] = xb_ld(&cen[64 * j]); sum += cnt[j]; }
            if (sum == (unsigned)F.G || ++sp > (1u << 20)) break; __builtin_amdgcn_s_sleep(1); }
        unsigned pop = 0, ord = 0; bool even = (sum == (unsigned)F.G) && (F.G % 8 == 0);
#pragma unroll
        for (int j = 0; j < 16; ++j) { if (cnt[j]) { ++pop; if ((unsigned)j < x) ++ord; if (cnt[j] != (unsigned)F.G / 8) even = false; } }
        even = even && pop == 8;
        F.MISC[0] = even ? slot * 8 + ord : blockIdx.x;
        F.MISC[1] = even ? ord * (F.G / 8) + slot : blockIdx.x;
        F.MISC[2] = even ? 1u : 0u; F.MISC[3] = x;
    }
    __syncthreads();
    const int cid0 = __builtin_amdgcn_readfirstlane((int)F.MISC[0]), vcu0 = __builtin_amdgcn_readfirstlane((int)F.MISC[1]); F.cid = cid0; F.vcu = vcu0;
    const bool multi = !USE_CG_SYNC && (args.ph_hi - args.ph_lo) > 1;
    XcdBarrier bar; bar.bar = F.ctl + CW_BAR; bar.x = 0; bar.st = nullptr;
    if (multi) bar = xcd_barrier_post(F.ctl + CW_BAR, F.MISC + 8);
#pragma unroll 1
    for (int slot = args.ph_lo; slot < args.ph_hi; ++slot) {
        const int ph = slot_phase(slot);
        GAS unsigned char* wsg = (GAS unsigned char*)args.ws; asm volatile("" : "+s"(wsg)); unsigned char* ws = (unsigned char*)wsg; F.ws = ws;
        { int v_ = vcu0, c_ = cid0, g_ = (int)gridDim.x; asm volatile("" : "+s"(v_), "+s"(c_), "+s"(g_)); F.vcu = v_; F.cid = c_; F.G = g_; }
        { int tid_ = threadIdx.x; asm volatile("" : "+v"(tid_)); F.tid = tid_; F.lane = tid_ & 63; F.wave = __builtin_amdgcn_readfirstlane(tid_ >> 6); }
        {
        if (ph == 0) phase_p0(F, args);
        else {
            const int layer = (ph - 1) / NPH_LAYER, k = (ph - 1) % NPH_LAYER;
            if (k == 0) {
                pg8::Gemm g{(const pg8::bf16_t*)(ws + WS_H), (const pg8::bf16_t*)(ws + WS_WIN) + (size_t)layer * NIN * (DM / 2), T, NIN, DM / 2, 30, 0}; pg8::StaticOrder S; S.init(T, NIN, F.G, F.cid);
                pg8::EpiStoreI8 E{(pg8::bf16_t*)(ws + WS_PROJ), NIN, (const float*)(ws + WS_HS), (const float*)(ws + WS_WINS) + (size_t)layer * NIN};
                if (__builtin_amdgcn_readfirstlane((int)F.MISC[2]) != 0 && F.G == 256 && REP_MASK == 0 && REP_RET == 1 && REP_ATTN == 1) { GAS unsigned* cp = (GAS unsigned*)F.ctl; asm volatile("" : "+s"(cp));
                    S.sync_ui = 8; S.sctl = (unsigned*)cp; S.sx = (unsigned)__builtin_amdgcn_readfirstlane((int)F.MISC[3]); S.snloc = (unsigned)F.G / 8u; S.stmo = (unsigned*)cp + CW_BAR; }
                pg8::gemm_phase<pg8::EpiStoreI8, pg8::StaticOrder, true, true, 1>(F.lds + RING_OFF, g, S, E, F.tid);
            } else if (k == 1) phase_mix(F, args, layer); else if (k == 2) phase_finalize(F, args);
            else if (k == 3) {
                pg8::Gemm g{(const pg8::bf16_t*)(ws + WS_CAT), (const pg8::bf16_t*)(ws + WS_WCAT + (size_t)layer * DM * CATW), T, DM, CATW / 2, 30, 0}; pg8::StaticOrder S; S.init(T, DM, F.G, F.cid);
                pg8::EpiMerge E{(const pg8::bf16_t*)(ws + WS_PROJ), (pg8::bf16_t*)(ws + WS_MERGED), 1.f / 1024.f};
                pg8::gemm_phase<pg8::EpiMerge, pg8::StaticOrder, true, true, 2>(F.lds + RING_OFF, g, S, E, F.tid);
            } else if (k == 4) {
                pg8::Gemm g{(const pg8::bf16_t*)(ws + WS_MERGED), (const pg8::bf16_t*)(ws + WS_WO) + (size_t)layer * DM * DM, T, DM, DM, 30, 0}; pg8::StaticOrder S; S.init(T, DM, F.G, F.cid);
                if (layer == 0) { pg8::EpiResidB<true> E{(const void*)args.in[0], (pg8::bf16_t*)(ws + WS_XB), 1.f}; pg8::gemm_phase<pg8::EpiResidB<true>, pg8::StaticOrder, true, true>(F.lds + RING_OFF, g, S, E, F.tid); }
                else { pg8::EpiResidB<false> E{(const void*)(ws + WS_XB), (pg8::bf16_t*)(ws + WS_XB), 1.f}; pg8::gemm_phase<pg8::EpiResidB<false>, pg8::StaticOrder, true, true>(F.lds + RING_OFF, g, S, E, F.tid); }
            } else if (k == 5) phase_norm_router(F, args, layer);
            else if (k == 6) phase_topk(F, args);
            else if (k == 7) {
                pg8::Gemm g{(const pg8::bf16_t*)(ws + WS_XIN), (const pg8::bf16_t*)(ws + WS_WGU) + (size_t)layer * NE * 2 * FF * (DM / 2), NROWS_E, 2 * FF, DM / 2, 3, (size_t)2 * FF * DM}; pg8::StaticOrder S; S.init(NROWS_E, 2 * FF, F.G, F.cid);
                pg8::EpiSwigluI8 E{(pg8::bf16_t*)(ws + WS_ACT), (const float*)(ws + WS_XS), (const float*)(ws + WS_WGUS) + (size_t)layer * NE * 2 * FF, 1};
                pg8::gemm_phase<pg8::EpiSwigluI8, pg8::StaticOrder, true, true, 1>(F.lds + RING_OFF, g, S, E, F.tid);
            } else if (k == 8) {
                pg8::StaticOrder S; S.init(NROWS_E, DM, F.G, F.cid);
                {   pg8::Gemm g{(const pg8::bf16_t*)(ws + WS_ACT), (const pg8::bf16_t*)(ws + WS_WDN + (size_t)layer * NE * DM * FF), NROWS_E, DM, FF / 2, 3, (size_t)DM * FF};
                    pg8::EpiDown E{(const float*)(ws + WS_GW), (pg8::bf16_t*)(ws + WS_Y), 64.f / 1024.f};
                    pg8::gemm_phase<pg8::EpiDown, pg8::StaticOrder, true, true, 2>(F.lds + RING_OFF, g, S, E, F.tid); }
            } else phase_combine_norm(F, args, layer);
        }
        }
        const int kk_ = (ph - 1) % NPH_LAYER; const bool local_seam = __builtin_amdgcn_readfirstlane((int)F.MISC[2]) != 0 && ph > 0 && (kk_ == 3 || kk_ == 4 || kk_ == 5 || kk_ == 7 || (F.G == 256 && (kk_ == 1 || kk_ == 2 || kk_ == 9))) && slot + 1 < args.ph_hi && slot_phase(slot + 1) == ph + 1;
        const bool no_seam = ph > 0 && kk_ == 0 && __builtin_amdgcn_readfirstlane((int)F.MISC[2]) != 0 && F.G == 256 && REP_MASK == 0 && REP_RET == 1 && REP_ATTN == 1;
        if (slot + 1 < args.ph_hi && !no_seam) { if (USE_CG_SYNC || slot - args.ph_lo < args.cg_seams) cooperative_groups::this_grid().sync(); else if (local_seam) { GAS unsigned* cp = (GAS unsigned*)F.ctl; asm volatile("" : "+s"(cp)); xcc_local_barrier((unsigned*)cp, (unsigned)__builtin_amdgcn_readfirstlane((int)F.MISC[3]), (unsigned)F.G / 8u, (unsigned*)cp + CW_BAR); } else { XcdBarrier bb = bar; GAS unsigned* bp = (GAS unsigned*)bb.bar; asm volatile("" : "+s"(bp)); bb.bar = (unsigned*)bp; xcd_barrier(bb); } }
    }
}


extern "C" void kernel_launch(void* const* d_in, const int* in_sizes, int n_in, void* d_out, int out_size, void* d_ws, size_t ws_size, hipStream_t stream) {
    static int grid = 0;
    if (grid == 0) {
        if (n_in != 13 || in_sizes[0] != T * DM || out_size != T * DM || ws_size < WS_END) { fprintf(stderr, "kernel_launch: unexpected shapes (n_in %d, ws %zu)\n", n_in, ws_size); grid = -1; return; }
        if (hipFuncSetAttribute((const void*)mega, hipFuncAttributeMaxDynamicSharedMemorySize, LDS_BYTES) != hipSuccess) { fprintf(stderr, "kernel_launch: hipFuncSetAttribute failed\n"); grid = -1; return; }
        int dev = 0, cus = 0, per_cu = 0;
        if (hipGetDevice(&dev) != hipSuccess || hipDeviceGetAttribute(&cus, hipDeviceAttributeMultiprocessorCount, dev) != hipSuccess) { grid = -1; return; }
        if (hipOccupancyMaxActiveBlocksPerMultiprocessor(&per_cu, (const void*)mega, NWAVES * 64, LDS_BYTES) != hipSuccess || per_cu < 1) { fprintf(stderr, "kernel_launch: occupancy query says %d blocks per CU; nothing launched\n", per_cu); grid = -1; return; }
        (void)hipGetLastError();
        grid = cus;
    }
    if (grid < 0) return;
    unsigned char* ws = (unsigned char*)d_ws;
    hipMemsetAsync(ws + WS_CTL, 0, CTL_ZERO_BYTES, stream);
    Args a{};
    for (int i = 0; i < 13; ++i) a.in[i] = (const float*)d_in[i];
    a.out = (float*)d_out; a.ws = ws; a.ph_lo = 0; a.ph_hi = NSLOTS; a.cg_seams = 0; a.pad = 0;
    void* kargs[] = {&a};
    hipError_t e = hipLaunchCooperativeKernel((const void*)mega, dim3(grid), dim3(NWAVES * 64), kargs, LDS_BYTES, stream);
    if (e != hipSuccess) fprintf(stderr, "kernel_launch: cooperative launch failed: %s (grid %d)\n", hipGetErrorString(e), grid);
}
```
